# Optimizing an MI355X kernel written in HIP

```python
import math
import jax, jax.numpy as jnp
from jax import lax
import numpy as np

D_MODEL = 2048
BATCH = 1
SEQ = 16384
DEPTH = 4

N_MIXERS = 2
NSA_HEADS = 16
NSA_GROUPS = 4
NSA_HEAD_DIM = 128
NSA_REP = NSA_HEADS // NSA_GROUPS
CMP_LEN = 32
CMP_STRIDE = 16
SEL_BLOCK = 64
N_SELECT = 16
WINDOW = 512
Q_BLOCK = 128
NSA_IN = NSA_HEADS * NSA_HEAD_DIM + 6 * NSA_GROUPS * NSA_HEAD_DIM + 3 * NSA_HEADS
ML_HEADS = 8
ML_V_DIM = D_MODEL // ML_HEADS
ML_QK_DIM = ML_V_DIM // 2
ML_CHUNK = 64
ML_IN = 2 * ML_HEADS * ML_QK_DIM + 2 * ML_HEADS * ML_V_DIM + 2 * ML_HEADS
D_FF = -(-8 * D_MODEL // (3 * 256)) * 256
EPS = 1e-6
NEG_INIT = -1e30

kernel_name = 'hybrid_nsa_mlstm_swiglu_trunk'


def rms_norm(x, g):
    x32 = x.astype(jnp.float32)
    y = x32 * lax.rsqrt(jnp.mean(x32 * x32, axis=-1, keepdims=True) + EPS)
    return (y * g.astype(jnp.float32)).astype(x.dtype)


def masked_softmax(s, mask):
    s = jnp.where(mask, s.astype(jnp.float32), -jnp.inf)
    m = jnp.max(s, axis=-1, keepdims=True)
    m = jnp.where(jnp.isfinite(m), m, 0.0)
    p = jnp.exp(s - m)
    return p / jnp.maximum(jnp.sum(p, axis=-1, keepdims=True), 1e-30)


def compress_kv(kv, pos, w1, b1, w2):
    B, S, G, dh = kv.shape
    n_cmp = (S - CMP_LEN) // CMP_STRIDE + 1
    idx = jnp.arange(n_cmp)[:, None] * CMP_STRIDE + jnp.arange(CMP_LEN)[None, :]
    blocks = kv[:, idx] + pos[None, None, :, None, :]
    blocks = jnp.transpose(blocks, (0, 1, 3, 2, 4)).reshape(B, n_cmp, G, CMP_LEN * dh)
    hdn = jax.nn.gelu(blocks @ w1 + b1)
    return hdn @ w2


def nsa_mixer(h, w_in, b_gate, q_g, k_g, cmp_pos, cmp_w1, cmp_b1, cmp_w2, w_out):
    B, S, _ = h.shape
    G, R, dh = NSA_GROUPS, NSA_REP, NSA_HEAD_DIM
    qd, kvd = NSA_HEADS * dh, G * dh
    proj = h @ w_in
    q = rms_norm(proj[..., :qd].reshape(B, S, G, R, dh), q_g)
    kv = proj[..., qd:qd + 6 * kvd].reshape(B, S, 6, G, dh)
    gates = jax.nn.sigmoid(proj[..., qd + 6 * kvd:] + b_gate).reshape(B, S, G, R, 3)
    k_cmp = rms_norm(compress_kv(kv[:, :, 0], cmp_pos[0], cmp_w1[0], cmp_b1[0], cmp_w2[0]), k_g[0])
    v_cmp = compress_kv(kv[:, :, 1], cmp_pos[1], cmp_w1[1], cmp_b1[1], cmp_w2[1])
    k_sel = rms_norm(kv[:, :, 2], k_g[1])
    v_sel = kv[:, :, 3]
    k_win = rms_norm(kv[:, :, 4], k_g[2])
    v_win = kv[:, :, 5]

    n_cmp = k_cmp.shape[1]
    n_sel = S // SEL_BLOCK
    k_top = min(N_SELECT, n_sel)
    cmp_start = jnp.arange(n_cmp) * CMP_STRIDE
    cmp_end = cmp_start + CMP_LEN - 1
    sel_start = jnp.arange(n_sel) * SEL_BLOCK
    overlap = ((cmp_start[:, None] < sel_start[None, :] + SEL_BLOCK)
               & (cmp_start[:, None] + CMP_LEN > sel_start[None, :])).astype(jnp.float32)
    ks_blk = jnp.transpose(k_sel.reshape(B, n_sel, SEL_BLOCK, G, dh), (0, 3, 1, 2, 4))
    vs_blk = jnp.transpose(v_sel.reshape(B, n_sel, SEL_BLOCK, G, dh), (0, 3, 1, 2, 4))
    kw_pad = jnp.pad(k_win, ((0, 0), (WINDOW, 0), (0, 0), (0, 0)))
    vw_pad = jnp.pad(v_win, ((0, 0), (WINDOW, 0), (0, 0), (0, 0)))
    scale = dh ** -0.5
    bi = jnp.arange(B)[:, None, None, None]
    gi = jnp.arange(G)[None, :, None, None]
    jj = jnp.arange(n_sel)

    def block(qb):
        s0 = qb * Q_BLOCK
        t = s0 + jnp.arange(Q_BLOCK)
        qx = lax.dynamic_slice_in_dim(q, s0, Q_BLOCK, axis=1)
        gx = lax.dynamic_slice_in_dim(gates, s0, Q_BLOCK, axis=1)
        s = jnp.einsum('bqgrd,bcgd->bgrqc', qx, k_cmp) * scale
        p_cmp = masked_softmax(s, cmp_end[None, :] <= t[:, None])
        o_cmp = jnp.einsum('bgrqc,bcgd->bqgrd', p_cmp.astype(v_cmp.dtype), v_cmp)
        imp = jnp.einsum('bgrqc,cj->bgqj', p_cmp, overlap)
        cur = t // SEL_BLOCK
        valid = jj[None, :] <= cur[:, None]
        forced = (jj[None, :] == 0) | (jj[None, :] == cur[:, None]) | (jj[None, :] == cur[:, None] - 1)
        score = jnp.where(valid, jnp.where(forced, jnp.inf, imp), -jnp.inf)
        top_val, top_idx = lax.top_k(score, k_top)
        blk_ok = top_val > -jnp.inf
        kg = ks_blk[bi, gi, top_idx]
        vg = vs_blk[bi, gi, top_idx]
        s = jnp.einsum('bqgrd,bgqknd->bgrqkn', qx, kg) * scale
        key_pos = top_idx[..., None] * SEL_BLOCK + jnp.arange(SEL_BLOCK)
        smask = blk_ok[..., None] & (key_pos <= t[None, None, :, None, None])
        nk = k_top * SEL_BLOCK
        p = masked_softmax(s.reshape(B, G, R, Q_BLOCK, nk), smask.reshape(B, G, 1, Q_BLOCK, nk))
        o_sel = jnp.einsum('bgrqm,bgqmd->bqgrd', p.astype(vg.dtype), vg.reshape(B, G, Q_BLOCK, nk, dh))
        kw = lax.dynamic_slice_in_dim(kw_pad, s0, WINDOW + Q_BLOCK, axis=1)
        vw = lax.dynamic_slice_in_dim(vw_pad, s0, WINDOW + Q_BLOCK, axis=1)
        pos = s0 - WINDOW + jnp.arange(WINDOW + Q_BLOCK)
        wmask = (pos[None, :] >= 0) & (pos[None, :] <= t[:, None]) & (t[:, None] - pos[None, :] < WINDOW)
        s = jnp.einsum('bqgrd,bkgd->bgrqk', qx, kw) * scale
        p = masked_softmax(s, wmask)
        o_win = jnp.einsum('bgrqk,bkgd->bqgrd', p.astype(vw.dtype), vw)
        return gx[..., 0:1] * o_cmp + gx[..., 1:2] * o_sel + gx[..., 2:3] * o_win

    out = lax.map(block, jnp.arange(S // Q_BLOCK))
    out = jnp.moveaxis(out, 0, 1).reshape(B, S, NSA_HEADS * dh)
    return out @ w_out


def mlstm_mixer(h, w_in, b_if, out_g, w_out):
    B, S, _ = h.shape
    H, dk, dv, L = ML_HEADS, ML_QK_DIM, ML_V_DIM, ML_CHUNK
    nc = S // L
    proj = (h @ w_in).astype(jnp.float32)
    cuts = [H * dk, 2 * H * dk, 2 * H * dk + H * dv, 2 * H * dk + 2 * H * dv, 2 * H * dk + 2 * H * dv + H]
    q, k, v, o, ig, fg = jnp.split(proj, cuts, axis=-1)
    b_if = b_if.astype(jnp.float32)
    ig = ig + b_if[:H]
    lf = jax.nn.log_sigmoid(fg + b_if[H:])

    def chunks(a, d):
        return jnp.transpose(a.reshape(B, nc, L, H, d), (1, 0, 3, 2, 4))

    qc = chunks(q, dk)
    kc = chunks(k * dk ** -0.5, dk)
    vc = chunks(v, dv)
    igc = jnp.transpose(ig.reshape(B, nc, L, H), (1, 0, 3, 2))
    lfc = jnp.transpose(lf.reshape(B, nc, L, H), (1, 0, 3, 2))
    tril = jnp.tril(jnp.ones((L, L), dtype=bool))

    def step(carry, xs):
        C, n, m = carry
        qx, kx, vx, ix, fx = xs
        b = jnp.cumsum(fx, axis=-1)
        D = jnp.where(tril, b[..., :, None] - b[..., None, :] + ix[..., None, :], -jnp.inf)
        m_inter = b + m[..., None]
        m_t = jnp.maximum(m_inter, jnp.max(D, axis=-1))
        A = jnp.exp(D - m_t[..., None]) * jnp.einsum('bhtd,bhsd->bhts', qx, kx)
        dec = jnp.exp(m_inter - m_t)
        num = jnp.einsum('bhts,bhsv->bhtv', A, vx) + dec[..., None] * jnp.einsum('bhtd,bhdv->bhtv', qx, C)
        den = jnp.sum(A, axis=-1) + dec * jnp.einsum('bhtd,bhd->bht', qx, n)
        hx = num / jnp.maximum(jnp.abs(den), jnp.exp(-m_t))[..., None]
        b_last = b[..., -1]
        g = b_last[..., None] - b + ix
        m_new = jnp.maximum(b_last + m, jnp.max(g, axis=-1))
        w = jnp.exp(g - m_new[..., None])
        cd = jnp.exp(b_last + m - m_new)
        C = cd[..., None, None] * C + jnp.einsum('bhs,bhsd,bhsv->bhdv', w, kx, vx)
        n = cd[..., None] * n + jnp.einsum('bhs,bhsd->bhd', w, kx)
        return (C, n, m_new), hx

    init = (jnp.zeros((B, H, dk, dv), jnp.float32), jnp.zeros((B, H, dk), jnp.float32),
            jnp.full((B, H), NEG_INIT, jnp.float32))
    _, hs = lax.scan(step, init, (qc, kc, vc, igc, lfc))
    hs = jnp.transpose(hs, (1, 0, 3, 2, 4)).reshape(B, S, H, dv)
    hs = rms_norm(hs, out_g.reshape(H, dv)).reshape(B, S, H * dv)
    y = jax.nn.sigmoid(o) * hs
    return y.astype(h.dtype) @ w_out


def swiglu(h, wg, wu, wd):
    return (jax.nn.silu(h @ wg) * (h @ wu)) @ wd


def setup_inputs(seed: int = 0) -> dict:
    key = jax.random.key(seed)
    ks = jax.random.split(key, 24)
    n_nsa = sum(1 for i in range(DEPTH) if i % N_MIXERS == 0)
    n_ml = sum(1 for i in range(DEPTH) if i % N_MIXERS == 1)
    dh = NSA_HEAD_DIM
    f32 = jnp.float32

    def nrm(k, shape, scale):
        return jax.random.normal(k, shape, f32) * scale

    f_bias = jnp.linspace(3.0, 6.0, ML_HEADS, dtype=f32)
    b_if = jnp.concatenate([nrm(ks[14], (n_ml, ML_HEADS), 0.1),
                            f_bias[None, :] + nrm(ks[15], (n_ml, ML_HEADS), 0.1)], axis=-1)
    return {
        'x': nrm(ks[0], (BATCH, SEQ, D_MODEL), 1.0),
        'norm_mix_g': 1.0 + nrm(ks[1], (DEPTH, D_MODEL), 0.02),
        'norm_ffn_g': 1.0 + nrm(ks[2], (DEPTH, D_MODEL), 0.02),
        'nsa_w_in': nrm(ks[3], (n_nsa, D_MODEL, NSA_IN), D_MODEL ** -0.5),
        'nsa_b_gate': nrm(ks[4], (n_nsa, 3 * NSA_HEADS), 0.1),
        'nsa_q_norm_g': 1.0 + nrm(ks[5], (n_nsa, dh), 0.02),
        'nsa_k_norm_g': 1.0 + nrm(ks[6], (n_nsa, 3, dh), 0.02),
        'nsa_cmp_pos': nrm(ks[7], (n_nsa, 2, CMP_LEN, dh), 0.1),
        'nsa_cmp_w1': nrm(ks[8], (n_nsa, 2, CMP_LEN * dh, dh), (CMP_LEN * dh) ** -0.5),
        'nsa_cmp_b1': nrm(ks[9], (n_nsa, 2, dh), 0.02),
        'nsa_cmp_w2': nrm(ks[10], (n_nsa, 2, dh, dh), dh ** -0.5),
        'nsa_w_out': nrm(ks[11], (n_nsa, NSA_HEADS * dh, D_MODEL), (NSA_HEADS * dh) ** -0.5),
        'ml_w_in': nrm(ks[12], (n_ml, D_MODEL, ML_IN), D_MODEL ** -0.5),
        'ml_b_if': b_if,
        'ml_out_norm_g': 1.0 + nrm(ks[13], (n_ml, ML_HEADS * ML_V_DIM), 0.02),
        'ml_w_out': nrm(ks[16], (n_ml, ML_HEADS * ML_V_DIM, D_MODEL), (ML_HEADS * ML_V_DIM) ** -0.5),
        'ffn_w_gate': nrm(ks[17], (DEPTH, D_MODEL, D_FF), D_MODEL ** -0.5),
        'ffn_w_up': nrm(ks[18], (DEPTH, D_MODEL, D_FF), D_MODEL ** -0.5),
        'ffn_w_down': nrm(ks[19], (DEPTH, D_FF, D_MODEL), D_FF ** -0.5),
    }


def reference(x, norm_mix_g, norm_ffn_g, nsa_w_in, nsa_b_gate, nsa_q_norm_g, nsa_k_norm_g,
              nsa_cmp_pos, nsa_cmp_w1, nsa_cmp_b1, nsa_cmp_w2, nsa_w_out,
              ml_w_in, ml_b_if, ml_out_norm_g, ml_w_out,
              ffn_w_gate, ffn_w_up, ffn_w_down):
    for i in range(DEPTH):
        j = i // N_MIXERS
        h = rms_norm(x, norm_mix_g[i])
        if i % N_MIXERS == 0:
            x = x + nsa_mixer(h, nsa_w_in[j], nsa_b_gate[j], nsa_q_norm_g[j], nsa_k_norm_g[j],
                              nsa_cmp_pos[j], nsa_cmp_w1[j], nsa_cmp_b1[j], nsa_cmp_w2[j], nsa_w_out[j])
        else:
            x = x + mlstm_mixer(h, ml_w_in[j], ml_b_if[j], ml_out_norm_g[j], ml_w_out[j])
        h = rms_norm(x, norm_ffn_g[i])
        x = x + swiglu(h, ffn_w_gate[i], ffn_w_up[i], ffn_w_down[i])
    return x
```

```cpp
#include <hip/hip_runtime.h>
#include <hip/hip_cooperative_groups.h>
#include <cstdio>
#include <cstdint>
#define ONE_LAUNCH 1
namespace pg8 {
#define PG8_LAS __attribute__((address_space(3)))
typedef unsigned short bf16_t;
typedef short bf16x8 __attribute__((ext_vector_type(8)));
typedef float f32x4 __attribute__((ext_vector_type(4)));
typedef unsigned u32x4 __attribute__((ext_vector_type(4)));
constexpr int BM = 256, BK = 64, HALF = 128, HTB = HALF * BK * 2  , STAGE_BYTES = 8 * HTB, NXCD = 8, WGM = 2;

__host__ __device__ __forceinline__ int lds_byte(int r, int c) { const int st = (r >> 4) * 2 + (c >> 5), rr = r & 15, cc = c & 31, ob = rr * 64 + cc * 2; return st * 1024 + (ob ^ (((ob >> 9) & 1) << 5)); }
__host__ __device__ __forceinline__ void stage_rc(int b, int& R, int& C) { const int st = b / 1024, sb = b % 1024, swz = sb ^ (((sb >> 9) & 1) << 5); R = (st >> 1) * 16 + swz / 64; C = (st & 1) * 32 + (swz % 64) / 2; }
__host__ __device__ __forceinline__ int perm32(int rho) { const int n = rho >> 4, i = rho & 15; return 8 * (i >> 2) + 4 * n + (i & 3); }

struct Unit { int pm, pn; };
struct Gemm { const bf16_t* A; const bf16_t* Bt; int M, N, K; };

struct StaticOrder {
    int nM, nN, nwg, G, c;
    __host__ __device__ void init(int M, int N, int G_, int c_) { nM = M / BM; nN = N / BM; nwg = nM * nN; G = G_; c = c_; }
    __host__ __device__ bool next(int i, Unit& u) const {
        const long L = (long)i * G + c; if (L >= nwg) return false;
        int wgid = (int)L; { const int q = nwg / NXCD, r = nwg % NXCD, xcd = wgid % NXCD, off = wgid / NXCD; wgid = (xcd < r ? xcd * (q + 1) : r * (q + 1) + (xcd - r) * q) + off; }
        const int nig = WGM * nN, gid = wgid / nig, fm = gid * WGM, gsz = (nM - fm) < WGM ? (nM - fm) : WGM;
        u.pm = fm + ((wgid % nig) % gsz); u.pn = (wgid % nig) / gsz; return true;
    }
    __device__ __forceinline__ void a_ready(const Unit&) const {}
    __device__ __forceinline__ void done(const Unit&) const {}
};
__device__ __forceinline__ unsigned cvt_pk_bf16(float lo, float hi) { unsigned r; asm volatile("v_cvt_pk_bf16_f32 %0, %1, %2" : "=v"(r) : "v"(lo), "v"(hi)); return r; }
typedef float f32x2e __attribute__((ext_vector_type(2))); typedef __bf16 bf16x2e __attribute__((ext_vector_type(2)));
__device__ __forceinline__ unsigned pk2(float lo, float hi) { f32x2e v = {lo, hi}; bf16x2e b = __builtin_convertvector(v, bf16x2e); return __builtin_bit_cast(unsigned, b); }
struct EpiStore {
    static constexpr bool PERM = true, AFTER_DRAIN = false;
    bf16_t* O; int ldc;
    __device__ __forceinline__ void operator()(const f32x4 (&acc)[2][2][4][2], const Unit& u, int wr, int wc, int fr, int fq) const {
        const int row0 = u.pm * BM + wr * 64 + fr, col0 = u.pn * BM + wc * 32 + 8 * fq;
#pragma unroll
        for (int ai = 0; ai < 2; ++ai)
#pragma unroll
            for (int m = 0; m < 4; ++m) { bf16_t* rowp = O + (size_t)(row0 + ai * HALF + m * 16) * ldc + col0;
#pragma unroll
                for (int bj = 0; bj < 2; ++bj) { const f32x4 v0 = acc[ai][bj][m][0], v1 = acc[ai][bj][m][1];
                    u32x4 w; w.x = pk2(v0[0], v0[1]); w.y = pk2(v0[2], v0[3]); w.z = pk2(v1[0], v1[1]); w.w = pk2(v1[2], v1[3]);
                    *(u32x4*)(rowp + bj * HALF) = w; } }
    }
};
struct EpiSwiglu {
    static constexpr bool PERM = true, AFTER_DRAIN = false;
    bf16_t* H; int ldc;
    __device__ __forceinline__ void operator()(const f32x4 (&acc)[2][2][4][2], const Unit& u, int wr, int wc, int fr, int fq) const {
        const int row0 = u.pm * BM + wr * 64 + fr, col0 = u.pn * HALF + wc * 32 + 8 * fq;
#pragma unroll
        for (int ai = 0; ai < 2; ++ai)
#pragma unroll
            for (int m = 0; m < 4; ++m) { bf16_t* rowp = H + (size_t)(row0 + ai * HALF + m * 16) * ldc + col0;
                float h[8];
#pragma unroll
                for (int n = 0; n < 2; ++n)
#pragma unroll
                    for (int e = 0; e < 4; ++e) { const float g = acc[ai][0][m][n][e], up = acc[ai][1][m][n][e];
                        h[n * 4 + e] = g * up * __builtin_amdgcn_rcpf(1.0f + __builtin_amdgcn_exp2f(-1.4426950408889634f * g)); }
                u32x4 w; w.x = pk2(h[0], h[1]); w.y = pk2(h[2], h[3]); w.z = pk2(h[4], h[5]); w.w = pk2(h[6], h[7]);
                *(u32x4*)rowp = w; }
    }
};
struct EpiResid {
    static constexpr bool PERM = false, AFTER_DRAIN = false;
    float* X; int ldc;
    __device__ __forceinline__ void operator()(const f32x4 (&acc)[2][2][4][2], const Unit& u, int wr, int wc, int fr, int fq) const {
        const int row0 = u.pm * BM + wr * 64 + fr, col0 = u.pn * BM + wc * 32 + 4 * fq;
#pragma unroll
        for (int ai = 0; ai < 2; ++ai)
#pragma unroll
            for (int mp = 0; mp < 2; ++mp) {
                f32x4 pre[2][2][2];
#pragma unroll
                for (int mm = 0; mm < 2; ++mm) { const float* rowp = X + (size_t)(row0 + ai * HALF + (2 * mp + mm) * 16) * ldc + col0;
#pragma unroll
                    for (int bj = 0; bj < 2; ++bj)
#pragma unroll
                        for (int n = 0; n < 2; ++n) pre[mm][bj][n] = *(const f32x4*)(rowp + bj * HALF + n * 16); }
#pragma unroll
                for (int mm = 0; mm < 2; ++mm) { float* rowp = X + (size_t)(row0 + ai * HALF + (2 * mp + mm) * 16) * ldc + col0;
#pragma unroll
                    for (int bj = 0; bj < 2; ++bj)
#pragma unroll
                        for (int n = 0; n < 2; ++n) *(f32x4*)(rowp + bj * HALF + n * 16) = pre[mm][bj][n] + acc[ai][bj][2 * mp + mm][n]; }
                asm volatile("" ::: "memory");
            }
    }
};
template <class Epi, class Sched, bool ALIGN_EPI = false, bool SP2 = false>
__device__ __forceinline__ void gemm_phase(PG8_LAS unsigned char* lds, const Gemm g, const Sched& S, const Epi& E, int tid_in) {
    int tid_l = tid_in; asm volatile("" : "+v"(tid_l)); const int tid = tid_l, wid = __builtin_amdgcn_readfirstlane(tid >> 6), lane = tid & 63, wr = wid >> 2, wc = wid & 3, fr = lane & 15, fq = lane >> 4;
    const int K = g.K, nt = K / BK;
    unsigned voffA[2], voffB[2];
#pragma unroll
    for (int i = 0; i < 2; ++i) { int R, C; stage_rc(tid * 16 + i * 8192, R, C); const int Rb = Epi::PERM ? ((R & ~31) + perm32(R & 31)) : R;
        voffA[i] = (unsigned)(R * K + C) * 2u; voffB[i] = (unsigned)(Rb * K + C) * 2u; }
    const size_t kstep = (size_t)(BK * 2);
    const size_t hstep = (size_t)HALF * K * 2;
    const size_t tstep = 2 * hstep;
    const unsigned ldsw = (unsigned)wid * 1024u;
    const int aoff = lds_byte(wr * 64 + fr, fq * 8), boff = lds_byte(wc * 32 + fr, fq * 8);
#define PG8_SA(b, h) (((b) * 2 + (h)) * HTB)
#define PG8_SB(b, h) ((4 + (b) * 2 + (h)) * HTB)
#define PG8_STAGE(bufoff, gbase, voff) do { _Pragma("unroll") for (int _i = 0; _i < 2; ++_i) \
        __builtin_amdgcn_global_load_lds((const unsigned*)((const char*)(gbase) + (voff)[_i]), (PG8_LAS unsigned*)(lds + (bufoff) + ldsw + _i * 8192), 16, 0, 0); } while (0)
#define PG8_LDA(dst, b, h) do { _Pragma("unroll") for (int m = 0; m < 4; ++m) _Pragma("unroll") for (int k = 0; k < 2; ++k) dst[m][k] = *(const PG8_LAS bf16x8*)(lds + PG8_SA(b, h) + aoff + m * 2048 + k * 1024); } while (0)
#define PG8_LDB(dst, b, h) do { _Pragma("unroll") for (int n = 0; n < 2; ++n) _Pragma("unroll") for (int k = 0; k < 2; ++k) dst[n][k] = *(const PG8_LAS bf16x8*)(lds + PG8_SB(b, h) + boff + n * 2048 + k * 1024); } while (0)
#define PG8_MMA(ai, bj, At, Bt) do { __builtin_amdgcn_s_setprio(1); _Pragma("unroll") for (int m = 0; m < 4; ++m) _Pragma("unroll") for (int n = 0; n < 2; ++n) _Pragma("unroll") for (int k = 0; k < 2; ++k) \
        acc[ai][bj][m][n] = __builtin_amdgcn_mfma_f32_16x16x32_bf16(Bt[n][k], At[m][k], acc[ai][bj][m][n], 0, 0, 0); __builtin_amdgcn_s_setprio(0); } while (0)
#define PG8_WAIT_V(n) asm volatile("s_waitcnt vmcnt(" #n ")" ::: "memory")
#define PG8_WAIT_L(n) asm volatile("s_waitcnt lgkmcnt(" #n ")" ::: "memory")
#define PG8_BAR __builtin_amdgcn_s_barrier()
#define PG8_SCHED __builtin_amdgcn_sched_barrier(0)
    Unit cur, nxt; int ui = 0;
    if (!S.next(0, cur)) return;
    f32x4 acc[2][2][4][2];
#pragma unroll
    for (int a = 0; a < 2; ++a)
#pragma unroll
        for (int b = 0; b < 2; ++b)
#pragma unroll
            for (int m = 0; m < 4; ++m)
#pragma unroll
                for (int n = 0; n < 2; ++n) acc[a][b][m][n] = (f32x4){0.f, 0.f, 0.f, 0.f};
    bf16x8 At[4][2], B0[2][2], B1[2][2];
    const char* cA = (const char*)g.A + (size_t)cur.pm * tstep; const char* cB = (const char*)g.Bt + (size_t)cur.pn * tstep;
    S.a_ready(cur);
    if constexpr (SP2) {
        PG8_STAGE(PG8_SB(0, 0), cB, voffB); PG8_STAGE(PG8_SB(0, 1), cB + hstep, voffB); PG8_STAGE(PG8_SA(0, 0), cA, voffA); PG8_STAGE(PG8_SA(0, 1), cA + hstep, voffA);
        if (wr == 1) PG8_BAR;
        PG8_WAIT_V(2); PG8_BAR;
        PG8_STAGE(PG8_SB(1, 0), cB + kstep, voffB); PG8_STAGE(PG8_SA(1, 0), cA + kstep, voffA); PG8_STAGE(PG8_SB(1, 1), cB + hstep + kstep, voffB);
        PG8_WAIT_V(6); PG8_BAR;
    } else {
        PG8_STAGE(PG8_SB(0, 0), cB, voffB); PG8_STAGE(PG8_SA(0, 0), cA, voffA); PG8_STAGE(PG8_SB(0, 1), cB + hstep, voffB); PG8_STAGE(PG8_SA(0, 1), cA + hstep, voffA);
        if (wr == 1) PG8_BAR;
        PG8_WAIT_V(4); PG8_BAR;
        PG8_STAGE(PG8_SB(1, 0), cB + kstep, voffB); PG8_STAGE(PG8_SA(1, 0), cA + kstep, voffA); PG8_STAGE(PG8_SB(1, 1), cB + hstep + kstep, voffB);
        PG8_WAIT_V(6); PG8_BAR;
    }
    for (;;) {
        const bool has_next = S.next(ui + 1, nxt);
        const char* nA = has_next ? (const char*)g.A + (size_t)nxt.pm * tstep : cA; const char* nB = has_next ? (const char*)g.Bt + (size_t)nxt.pn * tstep : cB;
        for (int t = 0; t < nt; t += 2) {
            const bool last = (t == nt - 2);
            const char* a1 = cA + (size_t)(t + 1) * kstep;
            const char* a2 = last ? nA : cA + (size_t)(t + 2) * kstep; const char* b2 = last ? nB : cB + (size_t)(t + 2) * kstep;
            const char* a3 = a2 + kstep; const char* b3 = b2 + kstep;
            if (last && has_next) S.a_ready(nxt);
            if constexpr (SP2) {
            PG8_LDB(B0, 0, 0); PG8_LDB(B1, 0, 1); PG8_SCHED; PG8_LDA(At, 0, 0); PG8_STAGE(PG8_SA(1, 1), a1 + hstep, voffA);
            PG8_WAIT_V(8); PG8_WAIT_L(0); PG8_BAR; PG8_MMA(0, 0, At, B0); PG8_MMA(0, 1, At, B1); PG8_BAR; PG8_SCHED;
            PG8_LDA(At, 0, 1); PG8_STAGE(PG8_SB(0, 0), b2, voffB); PG8_STAGE(PG8_SB(0, 1), b2 + hstep, voffB); PG8_STAGE(PG8_SA(0, 0), a2, voffA);
            PG8_WAIT_V(8); PG8_WAIT_L(0); PG8_BAR; PG8_MMA(1, 0, At, B0); PG8_MMA(1, 1, At, B1); PG8_BAR; PG8_SCHED;
            PG8_LDB(B0, 1, 0); PG8_LDB(B1, 1, 1); PG8_SCHED; PG8_LDA(At, 1, 0); PG8_STAGE(PG8_SA(0, 1), a2 + hstep, voffA);
            PG8_WAIT_V(8); PG8_WAIT_L(0); PG8_BAR; PG8_MMA(0, 0, At, B0); PG8_MMA(0, 1, At, B1); PG8_BAR; PG8_SCHED;
            PG8_LDA(At, 1, 1); PG8_STAGE(PG8_SB(1, 0), b3, voffB); PG8_STAGE(PG8_SB(1, 1), b3 + hstep, voffB); PG8_STAGE(PG8_SA(1, 0), a3, voffA);
            PG8_WAIT_V(8); PG8_WAIT_L(0); PG8_BAR; PG8_MMA(1, 0, At, B0); PG8_MMA(1, 1, At, B1); PG8_BAR; PG8_SCHED;
            } else {
            PG8_LDB(B0, 0, 0); PG8_SCHED; PG8_LDA(At, 0, 0); PG8_STAGE(PG8_SA(1, 1), a1 + hstep, voffA);
            PG8_WAIT_L(8); PG8_BAR; PG8_WAIT_L(0); PG8_MMA(0, 0, At, B0); PG8_BAR; PG8_SCHED;
            PG8_LDB(B1, 0, 1); PG8_STAGE(PG8_SB(0, 0), b2, voffB);
            PG8_BAR; PG8_WAIT_L(0); PG8_MMA(0, 1, At, B1); PG8_BAR;
            PG8_LDA(At, 0, 1); PG8_STAGE(PG8_SA(0, 0), a2, voffA);
            PG8_BAR; PG8_WAIT_L(0); PG8_MMA(1, 0, At, B0); PG8_BAR; PG8_SCHED;
            PG8_STAGE(PG8_SB(0, 1), b2 + hstep, voffB);
            PG8_WAIT_V(6); PG8_BAR; PG8_MMA(1, 1, At, B1); PG8_BAR;
            PG8_LDB(B0, 1, 0); PG8_SCHED; PG8_LDA(At, 1, 0); PG8_STAGE(PG8_SA(0, 1), a2 + hstep, voffA);
            PG8_WAIT_L(8); PG8_BAR; PG8_WAIT_L(0); PG8_MMA(0, 0, At, B0); PG8_BAR; PG8_SCHED;
            PG8_LDB(B1, 1, 1); PG8_STAGE(PG8_SB(1, 0), b3, voffB);
            PG8_BAR; PG8_WAIT_L(0); PG8_MMA(0, 1, At, B1); PG8_BAR;
            PG8_LDA(At, 1, 1); PG8_STAGE(PG8_SA(1, 0), a3, voffA);
            PG8_BAR; PG8_WAIT_L(0); PG8_MMA(1, 0, At, B0); PG8_BAR; PG8_SCHED;
            PG8_STAGE(PG8_SB(1, 1), b3 + hstep, voffB);
            PG8_WAIT_V(6); PG8_BAR; PG8_MMA(1, 1, At, B1); PG8_BAR;
            }
        }
        if constexpr (ALIGN_EPI) { if (wr == 0) PG8_BAR; }
        if constexpr (!Epi::AFTER_DRAIN) { E(acc, cur, wr, wc, fr, fq); S.done(cur); }
        if (!has_next) break;
#pragma unroll
        for (int a = 0; a < 2; ++a)
#pragma unroll
            for (int b = 0; b < 2; ++b)
#pragma unroll
                for (int m = 0; m < 4; ++m)
#pragma unroll
                    for (int n = 0; n < 2; ++n) acc[a][b][m][n] = (f32x4){0.f, 0.f, 0.f, 0.f};
        cur = nxt; cA = nA; cB = nB; ++ui;
        if constexpr (ALIGN_EPI) { if (wr == 1) PG8_BAR; }
    }
    PG8_WAIT_V(0);
    if constexpr (!ALIGN_EPI) { if (wr == 0) PG8_BAR; }
    PG8_BAR;
    if constexpr (Epi::AFTER_DRAIN) { E.fused(acc, cur, wr, wc, fr, fq, lds, wid, lane); S.done(cur); }
#undef PG8_SA
#undef PG8_SB
#undef PG8_STAGE
#undef PG8_LDA
#undef PG8_LDB
#undef PG8_MMA
#undef PG8_WAIT_V
#undef PG8_WAIT_L
#undef PG8_BAR
#undef PG8_SCHED
}
}
namespace cg = cooperative_groups;
#define LAS __attribute__((address_space(3)))
typedef unsigned short bf16_t;
typedef short bf16x8 __attribute__((ext_vector_type(8)));
typedef float f32x4 __attribute__((ext_vector_type(4)));
typedef unsigned u32x4 __attribute__((ext_vector_type(4)));
typedef unsigned u32x2 __attribute__((ext_vector_type(2)));
#define MFMA16(a, b, c) __builtin_amdgcn_mfma_f32_16x16x32_bf16((a), (b), (c), 0, 0, 0)
using pg8::pk2;

constexpr int S_ = 16384, D_ = 2048, DFF = 5632;
constexpr int NSA_N = 5376, NSA_IN = 5168, ML_N = 6400, ML_IN = 6160;
constexpr float EPS = 1e-6f;
constexpr float QSCALE = 0.08838834764831845f * 1.4426950408889634f;
constexpr float NEG = -1e30f;
constexpr int NWAVES = 8, NTHR = 512, LDS_BYTES = 147456;
constexpr int NPH = 34;

constexpr size_t MiB = 1u << 20;
constexpr size_t WS_MISC = 0, WS_FFN = 1 * MiB, WS_NSAW = 265 * MiB, WS_MLW = 329 * MiB, WS_XN = 400 * MiB, WS_PROJ = 464 * MiB, WS_EXT = 664 * MiB, WS_END = 800 * MiB;
constexpr size_t FFN_STRIDE = 66 * MiB, FFN_WD = 44 * MiB;
constexpr size_t NSAW_STRIDE = 32 * MiB, NSAW_OUT = 21 * MiB, NSAW_W1 = 29 * MiB, NSAW_W2 = 31 * MiB;
constexpr size_t MLW_STRIDE = 34 * MiB, MLW_OUT = 25 * MiB;
constexpr size_t EXT_KS = 0, EXT_KW = 16 * MiB, EXT_VTS = 32 * MiB, EXT_VTW = 48 * MiB, EXT_KC = 64 * MiB, EXT_VTC = 65 * MiB;
constexpr size_t EXT_CT = 0, EXT_NT = 128 * MiB, EXT_CI = 129 * MiB, EXT_MC = 129 * MiB + 65536;

struct Args { const float* in[19]; float* out; unsigned char* ws; int ph_lo, ph_hi; };

__device__ __forceinline__ float bf2f(unsigned short b) { return __uint_as_float(((unsigned)b) << 16); }
__device__ __forceinline__ float bflo(unsigned w) { return __uint_as_float(w << 16); }
__device__ __forceinline__ float bfhi(unsigned w) { return __uint_as_float(w & 0xffff0000u); }
__device__ __forceinline__ float wave_sum(float v) {
#pragma unroll
    for (int o = 1; o < 64; o <<= 1) v += __shfl_xor(v, o);
    return v;
}
__device__ __forceinline__ float wave_max(float v) {
#pragma unroll
    for (int o = 1; o < 64; o <<= 1) v = fmaxf(v, __shfl_xor(v, o));
    return v;
}
__device__ __forceinline__ float quad_sum(float v) {
    v += __builtin_bit_cast(float, __builtin_amdgcn_mov_dpp(__builtin_bit_cast(int, v), 0xB1, 0xF, 0xF, true));
    v += __builtin_bit_cast(float, __builtin_amdgcn_mov_dpp(__builtin_bit_cast(int, v), 0x4E, 0xF, 0xF, true));
    return v;
}
__device__ __forceinline__ float fq_sum(float v) { v += __shfl_xor(v, 16); v += __shfl_xor(v, 32); return v; }
__device__ __forceinline__ float fq_max(float v) { v = fmaxf(v, __shfl_xor(v, 16)); v = fmaxf(v, __shfl_xor(v, 32)); return v; }
__device__ __forceinline__ float ex2(float x) { return __builtin_amdgcn_exp2f(x); }
__device__ __forceinline__ float sigmoidf_(float x) { return __builtin_amdgcn_rcpf(1.0f + ex2(-1.4426950408889634f * x)); }

__device__ __forceinline__ void tr_item(const float* __restrict__ W, int K, int N, bf16_t* __restrict__ WT, int mode, int off, LAS float* scr, int item, int lane) {
    const int nblk = (N + 63) >> 6, kb = item / nblk, nb = item - kb * nblk, k0 = 64 * kb, n0 = 64 * nb;
    const int c4 = (lane & 15) * 4, nn = n0 + c4;
    f32x4 v[16];
#pragma unroll
    for (int i = 0; i < 16; ++i) { const int kk = 4 * i + (lane >> 4); v[i] = nn < N ? *(const f32x4*)(W + (size_t)(k0 + kk) * N + nn) : (f32x4){0.f, 0.f, 0.f, 0.f}; }
#pragma unroll
    for (int i = 0; i < 16; ++i) { const int kk = 4 * i + (lane >> 4); LAS float* d = scr + kk * 65 + c4; d[0] = v[i].x; d[1] = v[i].y; d[2] = v[i].z; d[3] = v[i].w; }
    asm volatile("s_waitcnt lgkmcnt(0)" ::: "memory");
    const int c = lane & 7;
#pragma unroll
    for (int j = 0; j < 8; ++j) { const int nl = (lane >> 3) + 8 * j, n = n0 + nl; const LAS float* s = scr + (8 * c) * 65 + nl;
        u32x4 o; o.x = pk2(s[0 * 65], s[1 * 65]); o.y = pk2(s[2 * 65], s[3 * 65]); o.z = pk2(s[4 * 65], s[5 * 65]); o.w = pk2(s[6 * 65], s[7 * 65]);
        const int drow = mode ? ((n >> 7) * 256 + (n & 127) + off) : (n + off);
        if (n < N) *(u32x4*)(WT + (size_t)drow * K + k0 + 8 * c) = o; }
    asm volatile("s_waitcnt lgkmcnt(0)" ::: "memory");
}
__device__ __forceinline__ void tr_matrix(const float* W, int K, int N, bf16_t* WT, int mode, int off, LAS float* scr, int gw, int NGW, int lane, int& rot) {
    const int nblk = (N + 63) >> 6, nitems = (K >> 6) * nblk;
    int first = gw - rot; if (first < 0) first += NGW;
    for (int it = first; it < nitems; it += NGW) tr_item(W, K, N, WT, mode, off, scr, it, lane);
    rot = (rot + nitems) % NGW;
}
__device__ __forceinline__ void rmsnorm_phase(const float* __restrict__ x, const float* __restrict__ g, bf16_t* __restrict__ XN, float* xcopy, int gw, int NGW, int lane) {
    for (int m = gw; m < S_; m += NGW) {
        const f32x4* xr = (const f32x4*)(x + (size_t)m * D_) + lane;
        f32x4 v[8]; float s = 0.f;
#pragma unroll
        for (int j = 0; j < 8; ++j) { v[j] = xr[64 * j]; s += (v[j].x * v[j].x + v[j].y * v[j].y) + (v[j].z * v[j].z + v[j].w * v[j].w); }
        s = wave_sum(s);
        const float rs = 1.0f / sqrtf(s * (1.0f / D_) + EPS);
        if (xcopy) {
            f32x4* xc = (f32x4*)(xcopy + (size_t)m * D_) + lane;
#pragma unroll
            for (int j = 0; j < 8; ++j) xc[64 * j] = v[j];
        }
        u32x2* o8 = (u32x2*)(XN + (size_t)m * D_) + lane;
#pragma unroll
        for (int j = 0; j < 8; ++j) { const f32x4 gg = ((const f32x4*)g)[lane + 64 * j]; u32x2 w; w.x = pk2(v[j].x * rs * gg.x, v[j].y * rs * gg.y); w.y = pk2(v[j].z * rs * gg.z, v[j].w * rs * gg.w); o8[64 * j] = w; }
    }
}

template <int NT>
__device__ __forceinline__ void gate_gemm(const bf16_t* __restrict__ XNp, const bf16_t* __restrict__ Wt, bf16_t* __restrict__ OUT, int ld, int col0, int tb, LAS unsigned char* lds, int tid, int wave, int lane) {
    const int fr = lane & 15, fq = lane >> 4, rt = wave & 3, kh = wave >> 2;
    const bf16_t* ap = XNp + (size_t)(64 * tb + 16 * rt + fr) * D_ + kh * 1024 + 8 * fq;
    const bf16_t* bp = Wt + (size_t)fr * D_ + kh * 1024 + 8 * fq;
    f32x4 acc[NT];
#pragma unroll
    for (int nt = 0; nt < NT; ++nt) acc[nt] = (f32x4){0.f, 0.f, 0.f, 0.f};
    constexpr int KB = NT == 1 ? 16 : 8;
    for (int k0 = 0; k0 < 32; k0 += KB) {
        bf16x8 a[KB], b[KB][NT];
#pragma unroll
        for (int u = 0; u < KB; ++u) {
            a[u] = *(const bf16x8*)(ap + 32 * (k0 + u));
#pragma unroll
            for (int nt = 0; nt < NT; ++nt) b[u][nt] = *(const bf16x8*)(bp + (size_t)(16 * nt) * D_ + 32 * (k0 + u));
        }
#pragma unroll
        for (int u = 0; u < KB; ++u)
#pragma unroll
            for (int nt = 0; nt < NT; ++nt) acc[nt] = MFMA16(b[u][nt], a[u], acc[nt]);
    }
    LAS float* P = (LAS float*)lds;
#pragma unroll
    for (int nt = 0; nt < NT; ++nt) *(LAS f32x4*)(P + ((kh * 64 + 16 * rt + fr) * (NT * 16) + 16 * nt + 4 * fq)) = acc[nt];
    __syncthreads();
    for (int idx = tid; idx < 64 * NT * 16; idx += NTHR) {
        const int tok = idx / (NT * 16), n = idx - tok * (NT * 16);
        const float v = P[idx] + P[64 * NT * 16 + idx];
        OUT[(size_t)(64 * tb + tok) * ld + col0 + n] = (bf16_t)(pk2(v, v) & 0xffffu);
    }
    __syncthreads();
}

__device__ __forceinline__ void nsa_prep_unit(int tb, bf16_t* PROJ, const float* qg, const float* kg, bf16_t* KS, bf16_t* KW, bf16_t* VTS, bf16_t* VTW, int tid) {
    const int sub = tid & 15;
    for (int it0 = 0; it0 < 48; it0 += 8) {
        u32x4 raw4[8];
#pragma unroll
        for (int u = 0; u < 8; ++u) {
            const int task = (it0 + u) * 32 + (tid >> 4), tok = task / 24, v = task - tok * 24, t = tb * 64 + tok;
            const int col = v < 16 ? v * 128 : v < 20 ? 2048 + (2 * 4 + (v - 16)) * 128 : 2048 + (4 * 4 + (v - 20)) * 128;
            raw4[u] = *(const u32x4*)(PROJ + (size_t)t * NSA_N + col + 8 * sub);
        }
#pragma unroll
        for (int u = 0; u < 8; ++u) {
            const int task = (it0 + u) * 32 + (tid >> 4), tok = task / 24, v = task - tok * 24, t = tb * 64 + tok;
            const float* gain; float gs = 1.0f; bf16_t* dst;
            if (v < 16) { gain = qg; gs = QSCALE; dst = PROJ + (size_t)t * NSA_N + v * 128; }
            else if (v < 20) { const int g = v - 16; gain = kg + 128; dst = KS + ((size_t)g * S_ + t) * 128; }
            else { const int g = v - 20; gain = kg + 256; dst = KW + ((size_t)g * S_ + t) * 128; }
            const u32x4 raw = raw4[u];
            float x[8] = {bflo(raw.x), bfhi(raw.x), bflo(raw.y), bfhi(raw.y), bflo(raw.z), bfhi(raw.z), bflo(raw.w), bfhi(raw.w)};
            float ss = 0.f;
#pragma unroll
            for (int e = 0; e < 8; ++e) ss += x[e] * x[e];
            ss += __shfl_xor(ss, 1); ss += __shfl_xor(ss, 2); ss += __shfl_xor(ss, 4); ss += __shfl_xor(ss, 8);
            const float rs = gs / sqrtf(ss * (1.0f / 128.0f) + EPS);
            const f32x4 g0 = *(const f32x4*)(gain + 8 * sub), g1 = *(const f32x4*)(gain + 8 * sub + 4);
            u32x4 o; o.x = pk2(x[0] * rs * g0.x, x[1] * rs * g0.y); o.y = pk2(x[2] * rs * g0.z, x[3] * rs * g0.w); o.z = pk2(x[4] * rs * g1.x, x[5] * rs * g1.y); o.w = pk2(x[6] * rs * g1.z, x[7] * rs * g1.w);
            *(u32x4*)(dst + 8 * sub) = o;
        }
    }
    for (int it0 = 0; it0 < 16; it0 += 4) {
        unsigned short e[4][8];
#pragma unroll
        for (int u = 0; u < 4; ++u) {
            const int task = (it0 + u) * 512 + tid, tile = task >> 10, rem = task & 1023, kc = rem >> 7, d = rem & 127, which = tile >> 2, g = tile & 3;
            const bf16_t* src = PROJ + (size_t)(tb * 64 + 8 * kc) * NSA_N + 2048 + ((which ? 5 : 3) * 4 + g) * 128 + d;
#pragma unroll
            for (int i = 0; i < 8; ++i) e[u][i] = src[(size_t)i * NSA_N];
        }
#pragma unroll
        for (int u = 0; u < 4; ++u) {
            const int task = (it0 + u) * 512 + tid, tile = task >> 10, rem = task & 1023, kc = rem >> 7, d = rem & 127, which = tile >> 2, g = tile & 3;
            u32x4 o; o.x = e[u][0] | ((unsigned)e[u][1] << 16); o.y = e[u][2] | ((unsigned)e[u][3] << 16); o.z = e[u][4] | ((unsigned)e[u][5] << 16); o.w = e[u][6] | ((unsigned)e[u][7] << 16);
            bf16_t* VT = which ? VTW : VTS;
            *(u32x4*)(VT + (((size_t)g * 256 + tb) * 128 + d) * 64 + 8 * kc) = o;
        }
    }
}

__device__ __forceinline__ float gelu_tanh(float x) {
    const float u = 0.7978845608028654f * (x + 0.044715f * x * x * x);
    const float t = 1.0f - 2.0f * __builtin_amdgcn_rcpf(1.0f + ex2(2.0f * 1.4426950408889634f * u));
    return 0.5f * x * (1.0f + t);
}
__device__ __forceinline__ void nsa_compress_unit(int task, const bf16_t* PROJ, const float* pos, const bf16_t* W1t, const float* b1, const bf16_t* W2t, const float* kg0,
                                                  bf16_t* KC, bf16_t* VTC, LAS unsigned char* lds, int tid, int wave, int lane) {
    const int kv = task >> 7, g = (task >> 5) & 3, ct = task & 31, c0 = 32 * ct, fr = lane & 15, fq = lane >> 4;
    LAS float* part = (LAS float*)lds;
    LAS bf16_t* hS = (LAS bf16_t*)(lds + 131072);
    const int crow0 = (c0 + fr) < 1023 ? (c0 + fr) : 1022, crow1 = (c0 + 16 + fr) < 1023 ? (c0 + 16 + fr) : 1022;
    const bf16_t* abase0 = PROJ + (size_t)(16 * crow0) * NSA_N + 2048 + (kv * 4 + g) * 128 + 8 * fq;
    const bf16_t* abase1 = PROJ + (size_t)(16 * crow1) * NSA_N + 2048 + (kv * 4 + g) * 128 + 8 * fq;
    const bf16_t* wbase = W1t + (size_t)kv * 128 * 4096 + (size_t)fr * 4096 + 8 * fq;
    const float* pbase = pos + (size_t)kv * 32 * 128 + 8 * fq;
    f32x4 acc[2][8];
#pragma unroll
    for (int r2 = 0; r2 < 2; ++r2)
#pragma unroll
        for (int i = 0; i < 8; ++i) acc[r2][i] = (f32x4){0.f, 0.f, 0.f, 0.f};
    for (int li = 0; li < 4; ++li) {
        const int l = 4 * wave + li;
#pragma unroll
        for (int dd = 0; dd < 4; ++dd) {
            const u32x4 raw0 = *(const u32x4*)(abase0 + (size_t)l * NSA_N + 32 * dd), raw1 = *(const u32x4*)(abase1 + (size_t)l * NSA_N + 32 * dd);
            const f32x4 p0 = *(const f32x4*)(pbase + l * 128 + 32 * dd), p1 = *(const f32x4*)(pbase + l * 128 + 32 * dd + 4);
            u32x4 a; a.x = pk2(bflo(raw0.x) + p0.x, bfhi(raw0.x) + p0.y); a.y = pk2(bflo(raw0.y) + p0.z, bfhi(raw0.y) + p0.w);
            a.z = pk2(bflo(raw0.z) + p1.x, bfhi(raw0.z) + p1.y); a.w = pk2(bflo(raw0.w) + p1.z, bfhi(raw0.w) + p1.w);
            u32x4 b; b.x = pk2(bflo(raw1.x) + p0.x, bfhi(raw1.x) + p0.y); b.y = pk2(bflo(raw1.y) + p0.z, bfhi(raw1.y) + p0.w);
            b.z = pk2(bflo(raw1.z) + p1.x, bfhi(raw1.z) + p1.y); b.w = pk2(bflo(raw1.w) + p1.z, bfhi(raw1.w) + p1.w);
            const bf16x8 af0 = __builtin_bit_cast(bf16x8, a), af1 = __builtin_bit_cast(bf16x8, b);
#pragma unroll
            for (int nt = 0; nt < 8; ++nt) { const bf16x8 bfr = *(const bf16x8*)(wbase + (size_t)nt * 16 * 4096 + l * 128 + 32 * dd); acc[0][nt] = MFMA16(bfr, af0, acc[0][nt]); acc[1][nt] = MFMA16(bfr, af1, acc[1][nt]); }
        }
    }
#pragma unroll
    for (int r2 = 0; r2 < 2; ++r2)
#pragma unroll
        for (int nt = 0; nt < 8; ++nt) *(LAS f32x4*)(part + (wave * 32 + 16 * r2 + fr) * 128 + 16 * nt + 4 * fq) = acc[r2][nt];
    __syncthreads();
    {
        const int c = tid >> 4, n8 = (tid & 15) * 8;
        f32x4 s0 = *(const f32x4*)(b1 + kv * 128 + n8), s1 = *(const f32x4*)(b1 + kv * 128 + n8 + 4);
#pragma unroll
        for (int w = 0; w < 8; ++w) { s0 = s0 + *(LAS f32x4*)(part + (w * 32 + c) * 128 + n8); s1 = s1 + *(LAS f32x4*)(part + (w * 32 + c) * 128 + n8 + 4); }
        u32x4 o; o.x = pk2(gelu_tanh(s0.x), gelu_tanh(s0.y)); o.y = pk2(gelu_tanh(s0.z), gelu_tanh(s0.w)); o.z = pk2(gelu_tanh(s1.x), gelu_tanh(s1.y)); o.w = pk2(gelu_tanh(s1.z), gelu_tanh(s1.w));
        *(LAS u32x4*)(hS + c * 136 + n8) = o;
    }
    __syncthreads();
    {
        f32x4 a2[2] = {(f32x4){0.f, 0.f, 0.f, 0.f}, (f32x4){0.f, 0.f, 0.f, 0.f}};
#pragma unroll
        for (int ks = 0; ks < 4; ++ks) {
            const bf16x8 wf = *(const bf16x8*)(W2t + (size_t)kv * 128 * 128 + (size_t)(16 * wave + fr) * 128 + 32 * ks + 8 * fq);
#pragma unroll
            for (int r2 = 0; r2 < 2; ++r2) { const bf16x8 hf = *(LAS bf16x8*)(hS + (16 * r2 + fr) * 136 + 32 * ks + 8 * fq); a2[r2] = MFMA16(wf, hf, a2[r2]); }
        }
#pragma unroll
        for (int r2 = 0; r2 < 2; ++r2) *(LAS f32x4*)(part + (16 * r2 + fr) * 128 + 16 * wave + 4 * fq) = a2[r2];
    }
    __syncthreads();
    if (kv == 0) {
        const int c = tid >> 4, sub = tid & 15;
        const f32x4 x0 = *(LAS f32x4*)(part + c * 128 + 8 * sub), x1 = *(LAS f32x4*)(part + c * 128 + 8 * sub + 4);
        float ss = (x0.x * x0.x + x0.y * x0.y) + (x0.z * x0.z + x0.w * x0.w) + (x1.x * x1.x + x1.y * x1.y) + (x1.z * x1.z + x1.w * x1.w);
        ss += __shfl_xor(ss, 1); ss += __shfl_xor(ss, 2); ss += __shfl_xor(ss, 4); ss += __shfl_xor(ss, 8);
        float rs = 1.0f / sqrtf(ss * (1.0f / 128.0f) + EPS);
        if (c0 + c >= 1023) rs = 0.f;
        const f32x4 g0 = *(const f32x4*)(kg0 + 8 * sub), g1 = *(const f32x4*)(kg0 + 8 * sub + 4);
        u32x4 o; o.x = pk2(x0.x * rs * g0.x, x0.y * rs * g0.y); o.y = pk2(x0.z * rs * g0.z, x0.w * rs * g0.w); o.z = pk2(x1.x * rs * g1.x, x1.y * rs * g1.y); o.w = pk2(x1.z * rs * g1.z, x1.w * rs * g1.w);
        *(u32x4*)(KC + ((size_t)g * 1024 + c0 + c) * 128 + 8 * sub) = o;
    } else {
        if (tid < 256) {
            const int d = tid & 127, hh = tid >> 7; float v[16];
#pragma unroll
            for (int c = 0; c < 16; ++c) v[c] = (c0 + 16 * hh + c < 1023) ? part[(16 * hh + c) * 128 + d] : 0.f;
            u32x4 o0, o1; o0.x = pk2(v[0], v[1]); o0.y = pk2(v[2], v[3]); o0.z = pk2(v[4], v[5]); o0.w = pk2(v[6], v[7]);
            o1.x = pk2(v[8], v[9]); o1.y = pk2(v[10], v[11]); o1.z = pk2(v[12], v[13]); o1.w = pk2(v[14], v[15]);
            bf16_t* dst = VTC + (((size_t)g * 16 + (ct >> 1)) * 128 + d) * 64 + 32 * (ct & 1) + 16 * hh;
            *(u32x4*)dst = o0; *(u32x4*)(dst + 8) = o1;
        }
    }
    __syncthreads();
}

__device__ __forceinline__ unsigned long long shfl_xor_u64(unsigned long long v, int m) {
    const unsigned lo = __shfl_xor((unsigned)v, m), hi = __shfl_xor((unsigned)(v >> 32), m);
    return ((unsigned long long)hi << 32) | lo;
}

struct QuadState { bf16x8 qf[4]; f32x4 o[8]; float l; };
constexpr int AT_STAGE = 32768, AT_V = 16384;
constexpr int AT_IMP = 2 * AT_STAGE;
constexpr int AT_SELM = AT_IMP + 65536;
static_assert(AT_SELM + 2048 + 512 <= LDS_BYTES, "attention LDS map");

template <bool WV>
__device__ __forceinline__ void at_dma(LAS unsigned char* st, const bf16_t* __restrict__ Kb, const bf16_t* __restrict__ Vb, int wave, int lane) {
#pragma unroll
    for (int i = 0; i < 2; ++i) {
        const int k = 2 * wave + i;
        const int rho = 4 * k + (lane >> 4), sg = lane & 15, key = (rho & 32) + ((rho >> 2) & 3) * 8 + ((rho >> 4) & 1) * 4 + (rho & 3);
        __builtin_amdgcn_global_load_lds((const unsigned*)(Kb + key * 128 + 8 * (sg ^ (rho & 15))), (LAS unsigned*)(st + 1024 * k), 16, 0, 0);
    }
    if (WV) {
#pragma unroll
        for (int i = 0; i < 2; ++i) {
            const int k = 2 * wave + i;
            const int d = 8 * k + (lane >> 3), sg = lane & 7;
            __builtin_amdgcn_global_load_lds((const unsigned*)(Vb + d * 64 + 8 * (sg ^ ((d >> 1) & 7))), (LAS unsigned*)(st + AT_V + 1024 * k), 16, 0, 0);
        }
    }
}
template <int MODE, bool DUAL>
__device__ __forceinline__ void at_block(const LAS unsigned char* st, QuadState& A, QuadState& B, bool domask, float biasA, float biasB, int pos0, int loA, int hiA, int loB, int hiB, float invlA, float invlB,
                                         float& carryA, float& carryB, LAS float* impA, LAS float* impB, int lane, int fr, int fq) {
    f32x4 sA[4], sB[4];
#pragma unroll
    for (int T = 0; T < 4; ++T) { sA[T] = (f32x4){biasA, biasA, biasA, biasA}; sB[T] = (f32x4){biasB, biasB, biasB, biasB}; }
    bf16x8 vpre[8];
    if (!DUAL && MODE != 0) {
#pragma unroll
        for (int dt = 0; dt < 8; ++dt) vpre[dt] = *(const LAS bf16x8*)(st + AT_V + (16 * dt + fr) * 128 + 16 * ((fq) ^ ((fr >> 1) & 7)));
    }
#pragma unroll
    for (int ks = 0; ks < 4; ++ks) {
        bf16x8 kf[4];
#pragma unroll
        for (int T = 0; T < 4; ++T) kf[T] = *(const LAS bf16x8*)(st + (32 * (T >> 1) + 16 * (T & 1) + fr) * 256 + 16 * ((4 * fq + ks) ^ fr));
#pragma unroll
        for (int T = 0; T < 4; ++T) { sA[T] = MFMA16(kf[T], A.qf[ks], sA[T]); if (DUAL) sB[T] = MFMA16(kf[T], B.qf[ks], sB[T]); }
        if (DUAL) __builtin_amdgcn_sched_barrier(0);
    }
    float la = 0.f, lb = 0.f;
    if (domask) {
#pragma unroll
        for (int T = 0; T < 4; ++T)
#pragma unroll
            for (int i = 0; i < 4; ++i) {
                const int pos = pos0 + 32 * (T >> 1) + 8 * fq + 4 * (T & 1) + i;
                if (!(pos >= loA && pos <= hiA)) sA[T][i] = NEG;
                if (DUAL) { if (!(pos >= loB && pos <= hiB)) sB[T][i] = NEG; }
            }
    }
#pragma unroll
    for (int T = 0; T < 4; ++T)
#pragma unroll
        for (int i = 0; i < 4; ++i) {
            float e = ex2(sA[T][i]); if (MODE == 2) e *= invlA; sA[T][i] = e; la += e;
            if (DUAL) { float f = ex2(sB[T][i]); if (MODE == 2) f *= invlB; sB[T][i] = f; lb += f; }
        }
    if (MODE != 2) { A.l += la; if (DUAL) B.l += lb; }
    if (MODE == 2) {
        const int src = (lane + 48) & 63;
        {
            const float r0 = __shfl(sA[1][3], src), r1 = __shfl(sA[3][3], src);
            const float pv0 = fq ? r0 : carryA, pv1 = fq ? r1 : r0; carryA = r1;
            float i00 = (sA[0][0] + sA[0][1]) + (sA[0][2] + sA[0][3]) + pv0, i01 = (sA[1][0] + sA[1][1]) + (sA[1][2] + sA[1][3]) + sA[0][3];
            float i10 = (sA[2][0] + sA[2][1]) + (sA[2][2] + sA[2][3]) + pv1, i11 = (sA[3][0] + sA[3][1]) + (sA[3][2] + sA[3][3]) + sA[2][3];
            i00 = quad_sum(i00); i01 = quad_sum(i01); i10 = quad_sum(i10); i11 = quad_sum(i11);
            if ((fr & 3) == 0) { impA[2 * fq] = i00; impA[2 * fq + 1] = i01; impA[8 + 2 * fq] = i10; impA[8 + 2 * fq + 1] = i11; }
        }
        if (DUAL) {
            const float r0 = __shfl(sB[1][3], src), r1 = __shfl(sB[3][3], src);
            const float pv0 = fq ? r0 : carryB, pv1 = fq ? r1 : r0; carryB = r1;
            float i00 = (sB[0][0] + sB[0][1]) + (sB[0][2] + sB[0][3]) + pv0, i01 = (sB[1][0] + sB[1][1]) + (sB[1][2] + sB[1][3]) + sB[0][3];
            float i10 = (sB[2][0] + sB[2][1]) + (sB[2][2] + sB[2][3]) + pv1, i11 = (sB[3][0] + sB[3][1]) + (sB[3][2] + sB[3][3]) + sB[2][3];
            i00 = quad_sum(i00); i01 = quad_sum(i01); i10 = quad_sum(i10); i11 = quad_sum(i11);
            if ((fr & 3) == 0) { impB[2 * fq] = i00; impB[2 * fq + 1] = i01; impB[8 + 2 * fq] = i10; impB[8 + 2 * fq + 1] = i11; }
        }
    }
    if (MODE != 0) {
        bf16x8 pfA[2], pfB[2];
#pragma unroll
        for (int u = 0; u < 2; ++u) {
            u32x4 w; w.x = pk2(sA[2 * u][0], sA[2 * u][1]); w.y = pk2(sA[2 * u][2], sA[2 * u][3]); w.z = pk2(sA[2 * u + 1][0], sA[2 * u + 1][1]); w.w = pk2(sA[2 * u + 1][2], sA[2 * u + 1][3]); pfA[u] = __builtin_bit_cast(bf16x8, w);
            if (DUAL) { u32x4 x; x.x = pk2(sB[2 * u][0], sB[2 * u][1]); x.y = pk2(sB[2 * u][2], sB[2 * u][3]); x.z = pk2(sB[2 * u + 1][0], sB[2 * u + 1][1]); x.w = pk2(sB[2 * u + 1][2], sB[2 * u + 1][3]); pfB[u] = __builtin_bit_cast(bf16x8, x); }
        }
#pragma unroll
        for (int u = 0; u < 2; ++u) {
#pragma unroll
            for (int dt = 0; dt < 8; ++dt) {
                const bf16x8 vf = (DUAL || u == 1) ? *(const LAS bf16x8*)(st + AT_V + (16 * dt + fr) * 128 + 16 * ((4 * u + fq) ^ ((fr >> 1) & 7))) : vpre[dt];
                A.o[dt] = MFMA16(vf, pfA[u], A.o[dt]); if (DUAL) B.o[dt] = MFMA16(vf, pfB[u], B.o[dt]);
                if (DUAL && (dt & 3) == 3) __builtin_amdgcn_sched_barrier(0);
            }
        }
    }
}
template <int MODE, bool SEL, int NST>
__device__ __forceinline__ void at_run(LAS unsigned char* lds, const bf16_t* Kg, const bf16_t* Vg, int first, int last, QuadState& A, QuadState& B, int loA, int hiA, int loB, int hiB,
                                       float invlA, float invlB, LAS float* impA, LAS float* impB, const LAS unsigned* uni, const LAS unsigned* selmA, const LAS unsigned* selmB,
                                       int tid, int lane, int fr, int fq, int nm_lo = 1, int nm_hi = 0) {
    constexpr bool WV = MODE != 0;
    constexpr int BPS = NST / 2;
    const int wave = __builtin_amdgcn_readfirstlane(tid >> 6);
    const int sb0 = first / BPS, sb1 = last / BPS;
    float carryA = 0.f, carryB = 0.f;
#define AT_DMA_SB(sb) do { _Pragma("unroll") for (int h_ = 0; h_ < BPS; ++h_) { const int blk_ = (sb) * BPS + h_; if (blk_ >= first && blk_ <= last) \
        at_dma<WV>(lds + ((((sb) & 1) * BPS + h_) * AT_STAGE), Kg + (size_t)blk_ * 8192, Vg + (size_t)blk_ * 8192, wave, lane); } } while (0)
    AT_DMA_SB(sb0);
    unsigned wa = 0u, wb = 0u;
    for (int sb = sb0; sb <= sb1; ++sb) {
        asm volatile("s_waitcnt vmcnt(0)" ::: "memory");
        __syncthreads();
        if (sb < sb1) AT_DMA_SB(sb + 1);
#pragma unroll
        for (int h = 0; h < BPS; ++h) {
            const int idx = sb * BPS + h;
            if (idx < first || idx > last) continue;
            const LAS unsigned char* st = lds + (((sb & 1) * BPS + h) * AT_STAGE);
            if (SEL) {
                if ((idx & 31) == 0 || idx == first) { wa = (unsigned)__builtin_amdgcn_readfirstlane((int)uni[idx >> 5]); wb = (unsigned)__builtin_amdgcn_readfirstlane((int)uni[8 + (idx >> 5)]); }
                const bool actA = (wa >> (idx & 31)) & 1u, actB = (wb >> (idx & 31)) & 1u;
                if (actA) { const float bA = ((selmA[idx >> 5] >> (idx & 31)) & 1u) ? 0.f : NEG; at_block<1, false>(st, A, A, idx == last, bA, bA, 64 * idx, 0, hiA, 0, hiA, 0.f, 0.f, carryA, carryA, nullptr, nullptr, lane, fr, fq); }
                if (actB) { const float bB = ((selmB[idx >> 5] >> (idx & 31)) & 1u) ? 0.f : NEG; at_block<1, false>(st, B, B, idx == last, bB, bB, 64 * idx, 0, hiB, 0, hiB, 0.f, 0.f, carryB, carryB, nullptr, nullptr, lane, fr, fq); }
            } else {
                at_block<MODE, true>(st, A, B, idx < nm_lo || idx > nm_hi, 0.f, 0.f, 64 * idx, loA, hiA, loB, hiB, invlA, invlB, carryA, carryB, impA + 16 * idx, impB + 16 * idx, lane, fr, fq);
            }
        }
    }
#undef AT_DMA_SB
    asm volatile("s_waitcnt vmcnt(0)" ::: "memory");
    __syncthreads();
}
__device__ __forceinline__ void y_accum(bf16_t* yp, const f32x4 (&o)[8], float sc, bool first) {
    u32x2 old[8];
    if (!first) {
#pragma unroll
        for (int dt = 0; dt < 8; ++dt) old[dt] = *(const u32x2*)(yp + 16 * dt);
    }
#pragma unroll
    for (int dt = 0; dt < 8; ++dt) {
        float a0 = o[dt][0] * sc, a1 = o[dt][1] * sc, a2 = o[dt][2] * sc, a3 = o[dt][3] * sc;
        if (!first) { a0 += bflo(old[dt].x); a1 += bfhi(old[dt].x); a2 += bflo(old[dt].y); a3 += bfhi(old[dt].y); }
        u32x2 w; w.x = pk2(a0, a1); w.y = pk2(a2, a3); *(u32x2*)(yp + 16 * dt) = w;
    }
}
__device__ __forceinline__ void nsa_attn_wg(int qb, int g, const bf16_t* PROJ, const float* bgate, const bf16_t* KC, const bf16_t* VTC, const bf16_t* KS, const bf16_t* VTS,
                                            const bf16_t* KW, const bf16_t* VTW, bf16_t* Y, LAS unsigned char* lds, int tid, int wave, int lane) {
    const int fr = lane & 15, fq = lane >> 4, a = fr >> 2, r = fr & 3, cur = qb;
    const int tlA = 8 * wave + a, tlB = tlA + 4, tA = 64 * qb + tlA, tB = 64 * qb + tlB;
    LAS float* IMP = (LAS float*)(lds + AT_IMP); LAS unsigned* SELM = (LAS unsigned*)(lds + AT_SELM); LAS unsigned* UNI = SELM + 512;
    QuadState A, B;
    {
        const bf16x8* qa = (const bf16x8*)(PROJ + (size_t)tA * NSA_N + (4 * g + r) * 128 + 32 * fq); const bf16x8* qbp = (const bf16x8*)(PROJ + (size_t)tB * NSA_N + (4 * g + r) * 128 + 32 * fq);
#pragma unroll
        for (int ks = 0; ks < 4; ++ks) { A.qf[ks] = qa[ks]; B.qf[ks] = qbp[ks]; }
    }
#define gpA (PROJ + (size_t)tA * NSA_N + 5120 + (4 * g + r) * 3)
#define gpB (PROJ + (size_t)tB * NSA_N + 5120 + (4 * g + r) * 3)
#define bg (bgate + (4 * g + r) * 3)
#define ypA (Y + (size_t)tA * D_ + (4 * g + r) * 128 + 4 * fq)
#define ypB (Y + (size_t)tB * D_ + (4 * g + r) * 128 + 4 * fq)
    {
        const int cmA = (tA - 31) >> 4, cmB = (tB - 31) >> 4, nb = ((4 * qb + 2) >> 6) + 1;
        const bf16_t* KCg = KC + (size_t)g * 1024 * 128; const bf16_t* VCg = VTC + (size_t)g * 16 * 8192;
        A.l = 0.f; B.l = 0.f;
        at_run<0, false, 2>(lds, KCg, VCg, 0, nb - 1, A, B, 0, cmA, 0, cmB, 0.f, 0.f, nullptr, nullptr, nullptr, nullptr, nullptr, tid, lane, fr, fq, 0, (4 * qb - 65) >> 6);
        const float lA = fq_sum(A.l), lB = fq_sum(B.l);
        const float invlA = lA > 0.f ? 1.0f / lA : 0.f, invlB = lB > 0.f ? 1.0f / lB : 0.f;
#pragma unroll
        for (int i = 0; i < 8; ++i) { A.o[i] = (f32x4){0.f, 0.f, 0.f, 0.f}; B.o[i] = (f32x4){0.f, 0.f, 0.f, 0.f}; }
        at_run<2, false, 2>(lds, KCg, VCg, 0, nb - 1, A, B, 0, cmA, 0, cmB, invlA, invlB, IMP + tlA * 256, IMP + tlB * 256, nullptr, nullptr, nullptr, tid, lane, fr, fq, 0, (4 * qb - 65) >> 6);
        y_accum(ypA, A.o, sigmoidf_(bf2f(gpA[0]) + bg[0]), true);
        y_accum(ypB, B.o, sigmoidf_(bf2f(gpB[0]) + bg[0]), true);
    }
    asm volatile("s_waitcnt lgkmcnt(0)" ::: "memory");
    {
        float val[8][4]; unsigned selb[8];
#pragma unroll
        for (int ta = 0; ta < 8; ++ta) {
            selb[ta] = 0u;
#pragma unroll
            for (int q = 0; q < 4; ++q) {
                const int j = lane + 64 * q;
                if ((j <= cur) && (j == 0 || j >= cur - 1 || cur <= 15)) selb[ta] |= 1u << q;
                val[ta][q] = (cur > 15 && j >= 1 && j <= cur - 2) ? IMP[(8 * wave + ta) * 256 + j] : -1.0f;
            }
        }
        if (cur > 15) {
            for (int it = 0; it < 13; ++it) {
                unsigned long long best[8];
#pragma unroll
                for (int ta = 0; ta < 8; ++ta) {
                    unsigned long long b = 0ull;
#pragma unroll
                    for (int q = 0; q < 4; ++q) if (val[ta][q] >= 0.f) { const unsigned long long k = ((unsigned long long)__float_as_uint(val[ta][q]) << 32) | (unsigned)(256 - (lane + 64 * q)); b = k > b ? k : b; }
                    best[ta] = b;
                }
#pragma unroll
                for (int m = 1; m < 64; m <<= 1) {
#pragma unroll
                    for (int ta = 0; ta < 8; ++ta) { const unsigned long long ot = shfl_xor_u64(best[ta], m); best[ta] = ot > best[ta] ? ot : best[ta]; }
                }
#pragma unroll
                for (int ta = 0; ta < 8; ++ta) {
                    const int jw = 256 - (int)(best[ta] & 0x1ffu);
#pragma unroll
                    for (int q = 0; q < 4; ++q) if (lane + 64 * q == jw) { val[ta][q] = -1.0f; selb[ta] |= 1u << q; }
                }
            }
        }
#pragma unroll
        for (int ta = 0; ta < 8; ++ta)
#pragma unroll
            for (int q = 0; q < 4; ++q) {
                const unsigned long long m = __ballot((selb[ta] >> q) & 1u);
                if (lane == 0) { SELM[(8 * wave + ta) * 8 + 2 * q] = (unsigned)m; SELM[(8 * wave + ta) * 8 + 2 * q + 1] = (unsigned)(m >> 32); }
            }
    }
    asm volatile("s_waitcnt lgkmcnt(0)" ::: "memory");
    if (lane < 16) {
        const int qd = lane >> 3, wd = lane & 7;
        UNI[16 * wave + lane] = SELM[(8 * wave + 4 * qd + 0) * 8 + wd] | SELM[(8 * wave + 4 * qd + 1) * 8 + wd] | SELM[(8 * wave + 4 * qd + 2) * 8 + wd] | SELM[(8 * wave + 4 * qd + 3) * 8 + wd];
    }
    asm volatile("s_waitcnt lgkmcnt(0)" ::: "memory");
    __syncthreads();
    {
#pragma unroll
        for (int i = 0; i < 8; ++i) { A.o[i] = (f32x4){0.f, 0.f, 0.f, 0.f}; B.o[i] = (f32x4){0.f, 0.f, 0.f, 0.f}; }
        A.l = 0.f; B.l = 0.f;
        at_run<1, true, 4>(lds, KS + (size_t)g * S_ * 128, VTS + (size_t)g * 256 * 8192, 0, cur, A, B, 0, tA, 0, tB, 0.f, 0.f, nullptr, nullptr, UNI + 16 * wave, SELM + tlA * 8, SELM + tlB * 8, tid, lane, fr, fq);
        const float lA = fq_sum(A.l), lB = fq_sum(B.l);
        y_accum(ypA, A.o, lA > 0.f ? sigmoidf_(bf2f(gpA[1]) + bg[1]) / lA : 0.f, false);
        y_accum(ypB, B.o, lB > 0.f ? sigmoidf_(bf2f(gpB[1]) + bg[1]) / lB : 0.f, false);
    }
    {
#pragma unroll
        for (int i = 0; i < 8; ++i) { A.o[i] = (f32x4){0.f, 0.f, 0.f, 0.f}; B.o[i] = (f32x4){0.f, 0.f, 0.f, 0.f}; }
        A.l = 0.f; B.l = 0.f;
        const int jlo = qb >= 8 ? qb - 8 : 0;
        at_run<1, false, 4>(lds, KW + (size_t)g * S_ * 128, VTW + (size_t)g * 256 * 8192, jlo, cur, A, B, tA - 511, tA, tB - 511, tB, 0.f, 0.f, nullptr, nullptr, nullptr, nullptr, nullptr, tid, lane, fr, fq, qb - 7, qb - 1);
        const float lA = fq_sum(A.l), lB = fq_sum(B.l);
        y_accum(ypA, A.o, lA > 0.f ? sigmoidf_(bf2f(gpA[2]) + bg[2]) / lA : 0.f, false);
        y_accum(ypB, B.o, lB > 0.f ? sigmoidf_(bf2f(gpB[2]) + bg[2]) / lB : 0.f, false);
    }
#undef gpA
#undef gpB
#undef bg
#undef ypA
#undef ypB
}

__device__ __forceinline__ float log_sigmoid(float x) { return fminf(x, 0.f) - log1pf(__expf(-fabsf(x))); }
__device__ __forceinline__ void ml_stage_load(const bf16_t* PROJ, int h, int c, bool do_k, int tid, u32x4 (&rk)[2], u32x4 (&rv)[4]) {
    if (do_k) {
#pragma unroll
        for (int i = 0; i < 2; ++i) { const int idx = tid + 512 * i, s = (idx & 3) + 4 * (idx >> 6), ch = (idx >> 2) & 15; rk[i] = *(const u32x4*)(PROJ + (size_t)(64 * c + s) * ML_N + 1024 + h * 128 + 8 * ch); }
    }
#pragma unroll
    for (int i = 0; i < 4; ++i) { const int i2 = tid + 512 * i, s = (i2 & 3) + 4 * (i2 >> 7), ch = (i2 >> 2) & 31; rv[i] = *(const u32x4*)(PROJ + (size_t)(64 * c + s) * ML_N + 2048 + h * 256 + 8 * ch); }
}
__device__ __forceinline__ void ml_stage_store(LAS bf16_t* kT, LAS bf16_t* vT, const LAS float* wS, bool do_k, int tid, const u32x4 (&rk)[2], const u32x4 (&rv)[4]) {
    if (do_k) {
#pragma unroll
        for (int i = 0; i < 2; ++i) {
            const int idx = tid + 512 * i, s = (idx & 3) + 4 * (idx >> 6), ch = (idx >> 2) & 15, col = (s + 8 * ch) & 63;
            const float w = wS[s] * 0.08838834764831845f;
            const unsigned ww[4] = {rk[i].x, rk[i].y, rk[i].z, rk[i].w};
#pragma unroll
            for (int e = 0; e < 4; ++e) { const unsigned pkd = pk2(bflo(ww[e]) * w, bfhi(ww[e]) * w); kT[(8 * ch + 2 * e) * 72 + col] = (bf16_t)(pkd & 0xffffu); kT[(8 * ch + 2 * e + 1) * 72 + col] = (bf16_t)(pkd >> 16); }
        }
    }
#pragma unroll
    for (int i = 0; i < 4; ++i) {
        const int i2 = tid + 512 * i, s = (i2 & 3) + 4 * (i2 >> 7), ch = (i2 >> 2) & 31, col = (s + 8 * ch) & 63;
        const unsigned ww[4] = {rv[i].x, rv[i].y, rv[i].z, rv[i].w};
#pragma unroll
        for (int e = 0; e < 4; ++e) { vT[(8 * ch + 2 * e) * 72 + col] = (bf16_t)(ww[e] & 0xffffu); vT[(8 * ch + 2 * e + 1) * 72 + col] = (bf16_t)(ww[e] >> 16); }
    }
}
__device__ __forceinline__ void ml_local_phase(int first, int step, const bf16_t* PROJ, const float* bif, bf16_t* CT, float* NT, float* CI, LAS unsigned char* lds, int tid, int wave, int lane) {
    const int fr = lane & 15, fq = lane >> 4;
    LAS bf16_t* kT = (LAS bf16_t*)lds;
    LAS bf16_t* vT = (LAS bf16_t*)(lds + 18432);
    LAS float* wS = (LAS float*)(lds + 18432 + 36864);
    u32x4 rk[2], rv[4]; unsigned short gi = 0, gf = 0;
    if (first < 2048) {
        ml_stage_load(PROJ, first >> 8, first & 255, true, tid, rk, rv);
        if (wave == 0) { const bf16_t* gp = PROJ + (size_t)(64 * (first & 255) + lane) * ML_N + 6144 + (first >> 8); gi = gp[0]; gf = gp[8]; }
    }
    for (int unit = first; unit < 2048; unit += step) {
        const int h = unit >> 8, c = unit & 255;
        if (wave == 0) {
            const float ig = bf2f(gi) + bif[h], lf = log_sigmoid(bf2f(gf) + bif[8 + h]);
            float b = lf;
#pragma unroll
            for (int o = 1; o < 64; o <<= 1) { const float u = __shfl_up(b, o); if (lane >= o) b += u; }
            const float blast = __shfl(b, 63), gs = blast - b + ig, gmax = wave_max(gs);
            wS[lane] = __expf(gs - gmax);
            if (lane == 0) { CI[(h * 256 + c) * 2] = blast; CI[(h * 256 + c) * 2 + 1] = gmax; }
        }
        __syncthreads();
        ml_stage_store(kT, vT, wS, true, tid, rk, rv);
        __syncthreads();
        const int un = unit + step;
        if (un < 2048) {
            ml_stage_load(PROJ, un >> 8, un & 255, true, tid, rk, rv);
            if (wave == 0) { const bf16_t* gp = PROJ + (size_t)(64 * (un & 255) + lane) * ML_N + 6144 + (un >> 8); gi = gp[0]; gf = gp[8]; }
        }
        f32x4 acc[16];
#pragma unroll
        for (int i = 0; i < 16; ++i) acc[i] = (f32x4){0.f, 0.f, 0.f, 0.f};
#pragma unroll
        for (int ks = 0; ks < 2; ++ks) {
            const bf16x8 af = *(LAS bf16x8*)(kT + (16 * wave + fr) * 72 + 8 * ((4 * ks + fq + 2 * wave + (fr >> 3)) & 7));
#pragma unroll
            for (int nt = 0; nt < 16; ++nt) { const bf16x8 bfr = *(LAS bf16x8*)(vT + (16 * nt + fr) * 72 + 8 * ((4 * ks + fq + 2 * nt + (fr >> 3)) & 7)); acc[nt] = MFMA16(af, bfr, acc[nt]); }
        }
        LAS bf16_t* tS = (LAS bf16_t*)(lds + 57344);
#pragma unroll
        for (int nt = 0; nt < 16; ++nt) { u32x2 w; w.x = pk2(acc[nt][0], acc[nt][1]); w.y = pk2(acc[nt][2], acc[nt][3]); *(LAS u32x2*)(tS + (16 * nt + fr) * 136 + 16 * wave + 4 * fq) = w; }
        if (tid < 128) { float s = 0.f; for (int i = 0; i < 64; ++i) s += bf2f(kT[tid * 72 + i]); NT[(size_t)(h * 256 + c) * 128 + tid] = s; }
        __syncthreads();
        {
            bf16_t* ct = CT + ((size_t)(h * 256 + c) * 256) * 128;
#pragma unroll
            for (int i = 0; i < 8; ++i) { const int q = tid + 512 * i, row = q >> 4, c16 = q & 15; *(u32x4*)(ct + (size_t)row * 128 + 8 * c16) = *(LAS u32x4*)(tS + row * 136 + 8 * c16); }
        }
    }
}
__device__ __forceinline__ void ml_scan_unit(int unit, bf16_t* CT, float* NT, const float* CI, float* MC, LAS unsigned char* lds, int tid) {
    const int h = unit >> 5, part = unit & 31;
    LAS float* cdS = (LAS float*)lds; LAS float* eS = cdS + 256; LAS float* blS = eS + 256; LAS float* gmS = blS + 256; LAS float* mS = gmS + 256;
    if (tid < 256) { blS[tid] = CI[(h * 256 + tid) * 2]; gmS[tid] = CI[(h * 256 + tid) * 2 + 1]; }
    __syncthreads();
    {
        float B = 0.f, Gm = 0.f;
        if (tid < 256) { B = blS[tid]; Gm = gmS[tid]; }
        for (int off = 1; off < 256; off <<= 1) {
            if (tid < 256) { cdS[tid] = B; eS[tid] = Gm; }
            __syncthreads();
            if (tid < 256 && tid >= off) { const float B1 = cdS[tid - off], G1 = eS[tid - off]; Gm = fmaxf(G1 + B, Gm); B = B1 + B; }
            __syncthreads();
        }
        if (tid < 256) mS[tid + 1] = fmaxf(NEG + B, Gm);
        if (tid == 0) mS[0] = NEG;
    }
    __syncthreads();
    if (tid < 256) {
        const float m = mS[tid], mn = mS[tid + 1];
        cdS[tid] = __expf(blS[tid] + m - mn); eS[tid] = __expf(gmS[tid] - mn);
        if (part == 0) MC[h * 256 + tid] = m;
    }
    __syncthreads();
    {
        unsigned* p = (unsigned*)(CT + (size_t)h * 256 * 32768) + part * 512 + tid;
        float r0 = 0.f, r1 = 0.f;
        unsigned d[16], dn[16];
#pragma unroll
        for (int i = 0; i < 16; ++i) d[i] = p[(size_t)i * 16384];
        for (int c0 = 0; c0 < 256; c0 += 16) {
            if (c0 + 16 < 256) {
#pragma unroll
                for (int i = 0; i < 16; ++i) dn[i] = p[(size_t)(c0 + 16 + i) * 16384];
            }
#pragma unroll
            for (int i = 0; i < 16; ++i) { p[(size_t)(c0 + i) * 16384] = pk2(r0, r1); const float cd = cdS[c0 + i], e = eS[c0 + i]; r0 = cd * r0 + e * bflo(d[i]); r1 = cd * r1 + e * bfhi(d[i]); }
#pragma unroll
            for (int i = 0; i < 16; ++i) d[i] = dn[i];
        }
    }
    if (part == 0 && tid < 128) {
        float* p = NT + (size_t)h * 256 * 128 + tid; float r = 0.f;
        for (int c0 = 0; c0 < 256; c0 += 16) {
            float d[16];
#pragma unroll
            for (int i = 0; i < 16; ++i) d[i] = p[(c0 + i) * 128];
#pragma unroll
            for (int i = 0; i < 16; ++i) { p[(c0 + i) * 128] = r; r = cdS[c0 + i] * r + eS[c0 + i] * d[i]; }
        }
    }
    __syncthreads();
}
__device__ __forceinline__ void ml_out_unit(int unit, const bf16_t* PROJ, const float* bif, const float* outg, const bf16_t* CT, const float* NT, const float* MC, bf16_t* Y,
                                            LAS unsigned char* lds, int tid, int wave, int lane) {
    const int h = unit >> 8, c = unit & 255, fr = lane & 15, fq = lane >> 4, tt = wave & 3, dvh = wave >> 2;
    LAS bf16_t* vT = (LAS bf16_t*)(lds + 18432);
    LAS float* dS = (LAS float*)(lds + 18432 + 36864);
    LAS float* pmS = dS + 64;
    LAS float* bS = pmS + 64;
    LAS float* nS = bS + 64;
    LAS float* ssS = nS + 128;
    u32x4 rk[2], rv[4];
    ml_stage_load(PROJ, h, c, false, tid, rk, rv);
    if (wave == 0) {
        const bf16_t* gp = PROJ + (size_t)(64 * c + lane) * ML_N + 6144 + h;
        const float ig = bf2f(gp[0]) + bif[h], lf = log_sigmoid(bf2f(gp[8]) + bif[8 + h]);
        float b = lf;
#pragma unroll
        for (int o = 1; o < 64; o <<= 1) { const float u = __shfl_up(b, o); if (lane >= o) b += u; }
        const float d = ig - b; float pm = d;
#pragma unroll
        for (int o = 1; o < 64; o <<= 1) { const float u = __shfl_up(pm, o); if (lane >= o) pm = fmaxf(pm, u); }
        dS[lane] = d; pmS[lane] = pm; bS[lane] = b;
    }
    if (tid >= 64 && tid < 192) nS[tid - 64] = NT[(size_t)(h * 256 + c) * 128 + tid - 64];
    const int trow = 16 * tt + fr;
    const float mc = MC[h * 256 + c];
    bf16x8 qf[4], kfr[4][4], ctf[4][4];
    {
        const bf16_t* qp = PROJ + (size_t)(64 * c + trow) * ML_N + h * 128 + 8 * fq;
#pragma unroll
        for (int ks = 0; ks < 4; ++ks) qf[ks] = *(const bf16x8*)(qp + 32 * ks);
#pragma unroll
        for (int T = 0; T < 4; ++T) {
            const int s_ = 32 * (T >> 1) + 8 * (fr >> 2) + 4 * (T & 1) + (fr & 3);
            const bf16_t* kp = PROJ + (size_t)(64 * c + s_) * ML_N + 1024 + h * 128 + 8 * fq;
#pragma unroll
            for (int ks = 0; ks < 4; ++ks) kfr[T][ks] = *(const bf16x8*)(kp + 32 * ks);
        }
    }
    const bf16_t* ctp = CT + ((size_t)(h * 256 + c) * 256 + 128 * dvh + fr) * 128 + 8 * fq;
#pragma unroll
    for (int dt = 0; dt < 4; ++dt)
#pragma unroll
        for (int ks = 0; ks < 4; ++ks) ctf[dt][ks] = *(const bf16x8*)(ctp + (size_t)(16 * dt) * 128 + 32 * ks);
    ml_stage_store(nullptr, vT, nullptr, false, tid, rk, rv);
    __syncthreads();
    const float Mt = fmaxf(mc, pmS[trow]), bt = bS[trow], dec = __expf(mc - Mt);
    float A[4][4]; float rsum = 0.f;
#pragma unroll
    for (int T = 0; T < 4; ++T) {
        f32x4 a = (f32x4){0.f, 0.f, 0.f, 0.f};
#pragma unroll
        for (int ks = 0; ks < 4; ++ks) a = MFMA16(kfr[T][ks], qf[ks], a);
#pragma unroll
        for (int i = 0; i < 4; ++i) { const int ss = 32 * (T >> 1) + 8 * fq + 4 * (T & 1) + i; const float v = ss <= trow ? __expf(dS[ss] - Mt) * a[i] * 0.08838834764831845f : 0.f; A[T][i] = v; rsum += v; }
    }
    bf16x8 ctg[4][4];
#pragma unroll
    for (int dt = 0; dt < 4; ++dt)
#pragma unroll
        for (int ks = 0; ks < 4; ++ks) ctg[dt][ks] = *(const bf16x8*)(ctp + (size_t)(16 * (dt + 4)) * 128 + 32 * ks);
    rsum = fq_sum(rsum);
    bf16x8 af[2];
#pragma unroll
    for (int u = 0; u < 2; ++u) { u32x4 w; w.x = pk2(A[2 * u][0], A[2 * u][1]); w.y = pk2(A[2 * u][2], A[2 * u][3]); w.z = pk2(A[2 * u + 1][0], A[2 * u + 1][1]); w.w = pk2(A[2 * u + 1][2], A[2 * u + 1][3]); af[u] = __builtin_bit_cast(bf16x8, w); }
    float qn = 0.f;
#pragma unroll
    for (int ks = 0; ks < 4; ++ks) { const u32x4 w = __builtin_bit_cast(u32x4, qf[ks]); const LAS float* np = nS + 32 * ks + 8 * fq;
        qn += bflo(w.x) * np[0] + bfhi(w.x) * np[1] + bflo(w.y) * np[2] + bfhi(w.y) * np[3] + bflo(w.z) * np[4] + bfhi(w.z) * np[5] + bflo(w.w) * np[6] + bfhi(w.w) * np[7]; }
    qn = fq_sum(qn);
    const float den = rsum + dec * qn, dnm = fmaxf(fabsf(den), __expf(-(bt + Mt))), inv = 1.0f / dnm;
    f32x4 acc[8];
    float ssq = 0.f;
#pragma unroll
    for (int dt = 0; dt < 8; ++dt) {
        f32x4 a = (f32x4){0.f, 0.f, 0.f, 0.f};
#pragma unroll
        for (int ks = 0; ks < 4; ++ks) a = MFMA16(dt < 4 ? ctf[dt][ks] : ctg[dt - 4 < 0 ? 0 : dt - 4][ks], qf[ks], a);
        a = a * dec;
#pragma unroll
        for (int u = 0; u < 2; ++u) a = MFMA16(*(LAS bf16x8*)(vT + (128 * dvh + 16 * dt + fr) * 72 + 8 * ((4 * u + fq + 2 * dt + (fr >> 3)) & 7)), af[u], a);
        a = a * inv;
        ssq += (a[0] * a[0] + a[1] * a[1]) + (a[2] * a[2] + a[3] * a[3]);
        acc[dt] = a;
    }
    ssq = fq_sum(ssq);
    if (fq == 0) ssS[wave * 16 + fr] = ssq;
    const size_t trg = (size_t)(64 * c + trow);
    f32x4 ggv[8]; u32x2 owv[8];
#pragma unroll
    for (int dt = 0; dt < 8; ++dt) { const int dv = 128 * dvh + 16 * dt + 4 * fq; ggv[dt] = *(const f32x4*)(outg + h * 256 + dv); owv[dt] = *(const u32x2*)(PROJ + trg * ML_N + 4096 + h * 256 + dv); }
    __syncthreads();
    const float tot = ssS[wave * 16 + fr] + ssS[(wave ^ 4) * 16 + fr];
    const float rs = 1.0f / sqrtf(tot * (1.0f / 256.0f) + EPS);
#pragma unroll
    for (int dt = 0; dt < 8; ++dt) {
        const int dv = 128 * dvh + 16 * dt + 4 * fq;
        const f32x4 gg = ggv[dt];
        const u32x2 ow = owv[dt];
        const float y0 = acc[dt][0] * rs * gg.x * sigmoidf_(bflo(ow.x)), y1 = acc[dt][1] * rs * gg.y * sigmoidf_(bfhi(ow.x));
        const float y2 = acc[dt][2] * rs * gg.z * sigmoidf_(bflo(ow.y)), y3 = acc[dt][3] * rs * gg.w * sigmoidf_(bfhi(ow.y));
        u32x2 w; w.x = pk2(y0, y1); w.y = pk2(y2, y3);
        *(u32x2*)(Y + trg * D_ + h * 256 + dv) = w;
    }
    __syncthreads();
}

#define GAS __attribute__((address_space(1)))
#define XB_TMO      128
#define XB_XCNT(j)  (256  + 64 * (j))
#define XB_XSUB(j)  (1280 + 64 * (j))
#define XB_XGEN(j)  (2304 + 64 * (j))
#define XB_TOP      3328
#define XB_TOPGEN   3392
#define XCD_BAR_WORDS 3456
#define XB_SPIN_CAP (1u << 18)

__device__ __forceinline__ unsigned xb_ld(unsigned* p)              { return __hip_atomic_load(p, __ATOMIC_RELAXED, __HIP_MEMORY_SCOPE_AGENT); }
__device__ __forceinline__ unsigned xb_add(unsigned* p, unsigned v) { return __hip_atomic_fetch_add(p, v, __ATOMIC_RELAXED, __HIP_MEMORY_SCOPE_AGENT); }
__device__ __forceinline__ unsigned xb_xcc_id() { return (unsigned)__builtin_amdgcn_s_getreg((3 << 11) | 20) & 0xFu; }
#define XB_SPIN(cond, bar) do { unsigned _sp = 0; while (cond) { __builtin_amdgcn_s_sleep(1); \
    if ((++_sp & 255u) == 0u) { if (xb_ld(&(bar)[XB_TMO])) break; if (_sp > XB_SPIN_CAP) { atomicAdd(&(bar)[XB_TMO], 1u); break; } } } } while (0)

struct XcdBarrier {
    unsigned* bar; unsigned x;
    volatile LAS unsigned* st;
};

__device__ __forceinline__ XcdBarrier xcd_barrier_post(unsigned* bar, volatile LAS unsigned* st) {
    XcdBarrier b; b.bar = bar; b.x = xb_xcc_id(); b.st = st;
    if (threadIdx.x == 0) (void)xb_add(&bar[XB_XCNT(b.x)], 1u);
    return b;
}
__device__ __forceinline__ void xcd_barrier_complete(unsigned* bar, unsigned x, unsigned& nloc, unsigned& nx) {
    const unsigned G = gridDim.x * gridDim.y * gridDim.z;
    unsigned sum, cnt, mine, sp = 0u;
    for (;;) {
        sum = 0u; cnt = 0u; mine = 0u;
#pragma unroll
        for (unsigned j = 0; j < 16; ++j) { const unsigned c = xb_ld(&bar[XB_XCNT(j)]); sum += c; cnt += (c > 0u) ? 1u : 0u; mine = (j == x) ? c : mine; }
        if (sum == G) break;
        __builtin_amdgcn_s_sleep(1);
        if ((++sp & 255u) == 0u) { if (xb_ld(&bar[XB_TMO])) break; if (sp > XB_SPIN_CAP) { atomicAdd(&bar[XB_TMO], 1u); break; } }
    }
    nloc = mine > 0u ? mine : 1u; nx = cnt > 0u ? cnt : 1u;
}

__device__ __forceinline__ void xcd_barrier(const XcdBarrier& b) {
    asm volatile("s_waitcnt vmcnt(0)" ::: "memory");
    __syncthreads();
    if (threadIdx.x == 0) {
        unsigned* bar = b.bar;
        __builtin_amdgcn_s_waitcnt(0);
        unsigned nloc = b.st[0], nx = b.st[1];
        if (nloc == 0u) { xcd_barrier_complete(bar, b.x, nloc, nx); b.st[0] = nloc; b.st[1] = nx; }
        const unsigned old = xb_add(&bar[XB_XSUB(b.x)], 1u);
        const unsigned gen = old / nloc;
        if (old + 1u == (gen + 1u) * nloc) {
            __builtin_amdgcn_fence(__ATOMIC_RELEASE, "agent");
            asm volatile("s_waitcnt vmcnt(0)" ::: "memory");
            const unsigned og = xb_add(&bar[XB_TOP], 1u);
            const unsigned tg = og / nx;
            if (og + 1u == (tg + 1u) * nx) xb_add(&bar[XB_TOPGEN], 1u);
            else XB_SPIN(xb_ld(&bar[XB_TOPGEN]) == tg, bar);
            __builtin_amdgcn_fence(__ATOMIC_ACQUIRE, "agent");
            xb_add(&bar[XB_XGEN(b.x)], 1u);
            asm volatile("s_waitcnt vmcnt(0)" ::: "memory");
        } else {
            XB_SPIN(xb_ld(&bar[XB_XGEN(b.x)]) == gen, bar);
            __builtin_amdgcn_fence(__ATOMIC_ACQUIRE, "agent");
            asm volatile("s_waitcnt vmcnt(0)" ::: "memory");
        }
    }
    __syncthreads();
}

#ifndef REP_UP
#define REP_UP 1
#endif
#ifndef REP_P0
#define REP_P0 1
#endif
#ifndef REP_CMP
#define REP_CMP 1
#endif
#ifndef REP_ATTN
#define REP_ATTN 1
#endif
#ifndef REP_MLL
#define REP_MLL 1
#endif
#ifndef REP_MLO
#define REP_MLO 1
#endif
__global__ void __launch_bounds__(NTHR, 2) fwd_kernel(Args args) {
    extern __shared__ __attribute__((aligned(16))) unsigned char lds_raw[];
    LAS unsigned char* lds = (LAS unsigned char*)lds_raw;
    cg::grid_group grid = cg::this_grid();
    volatile LAS unsigned* bar_st = (volatile LAS unsigned*)(lds + LDS_BYTES - 64);
    if (threadIdx.x == 0) { bar_st[0] = 0u; bar_st[1] = 0u; }
    __syncthreads();
    XcdBarrier xbar; xbar.bar = (unsigned*)(args.ws + WS_MISC); xbar.x = 0; xbar.st = nullptr;
    if (args.ph_hi - args.ph_lo > 1) xbar = xcd_barrier_post((unsigned*)(args.ws + WS_MISC), bar_st);
    const int wave0 = __builtin_amdgcn_readfirstlane((int)(threadIdx.x >> 6));
    const int G0 = gridDim.x, bid0 = blockIdx.x;
    const int lo = args.ph_lo, hi = args.ph_hi;
#define X (args.out)
#define XN ((bf16_t*)(ws + WS_XN))
#define Yb ((bf16_t*)(ws + WS_XN))
#define PROJ ((bf16_t*)(ws + WS_PROJ))
#define Hb ((bf16_t*)(ws + WS_PROJ))
#define nb (ws + WS_NSAW + j * NSAW_STRIDE)
#define mb (ws + WS_MLW + j * MLW_STRIDE)
#define KS ((bf16_t*)(ws + WS_EXT + EXT_KS))
#define KW ((bf16_t*)(ws + WS_EXT + EXT_KW))
#define VTS ((bf16_t*)(ws + WS_EXT + EXT_VTS))
#define VTW ((bf16_t*)(ws + WS_EXT + EXT_VTW))
#define KC ((bf16_t*)(ws + WS_EXT + EXT_KC))
#define VTC ((bf16_t*)(ws + WS_EXT + EXT_VTC))
#define CT ((bf16_t*)(ws + WS_EXT + EXT_CT))
#define NT ((float*)(ws + WS_EXT + EXT_NT))
#define CI ((float*)(ws + WS_EXT + EXT_CI))
#define MC ((float*)(ws + WS_EXT + EXT_MC))
#define bif (args.in[13] + j * 16)
    int ph = 0;
#define PHASE_BEGIN if (lo <= ph && ph < hi) { int bid = bid0, G = G0; asm volatile("" : "+s"(bid), "+s"(G)); const int NGW = G * NWAVES; int tid = wave0 * 64 + (int)__builtin_amdgcn_mbcnt_hi(~0u, __builtin_amdgcn_mbcnt_lo(~0u, 0u)); asm volatile("" : "+v"(tid)); const int lane = tid & 63; const int wave = __builtin_amdgcn_readfirstlane(tid >> 6); const int gw = bid * NWAVES + wave; unsigned char* ws = args.ws; asm volatile("" : "+s"(ws));
#define PHASE_END if (ph + 1 < hi) { if (hi == 0x7fffffff) grid.sync(); else xcd_barrier(xbar); } } ++ph;

    PHASE_BEGIN
    {
        LAS float* scr = (LAS float*)(lds + wave * 17408);
        for (int rep_ = 0; rep_ < REP_P0; ++rep_) {
        int rot = 0;
#pragma unroll 1
        for (int l = 0; l < 4; ++l) {
            bf16_t* wgu = (bf16_t*)(ws + WS_FFN + l * FFN_STRIDE); bf16_t* wd = (bf16_t*)(ws + WS_FFN + l * FFN_STRIDE + FFN_WD);
            tr_matrix(args.in[16] + (size_t)l * D_ * DFF, D_, DFF, wgu, 1, 0, scr, gw, NGW, lane, rot);
            tr_matrix(args.in[17] + (size_t)l * D_ * DFF, D_, DFF, wgu, 1, 128, scr, gw, NGW, lane, rot);
            tr_matrix(args.in[18] + (size_t)l * DFF * D_, DFF, D_, wd, 0, 0, scr, gw, NGW, lane, rot);
        }
#pragma unroll 1
        for (int j = 0; j < 2; ++j) {
            tr_matrix(args.in[3] + (size_t)j * D_ * NSA_IN, D_, NSA_IN, (bf16_t*)nb, 0, 0, scr, gw, NGW, lane, rot);
            tr_matrix(args.in[11] + (size_t)j * D_ * D_, D_, D_, (bf16_t*)(nb + NSAW_OUT), 0, 0, scr, gw, NGW, lane, rot);
            tr_matrix(args.in[8] + (size_t)(j * 2 + 0) * 4096 * 128, 4096, 128, (bf16_t*)(nb + NSAW_W1), 0, 0, scr, gw, NGW, lane, rot);
            tr_matrix(args.in[8] + (size_t)(j * 2 + 1) * 4096 * 128, 4096, 128, (bf16_t*)(nb + NSAW_W1) + 128 * 4096, 0, 0, scr, gw, NGW, lane, rot);
            tr_matrix(args.in[10] + (size_t)(j * 2 + 0) * 128 * 128, 128, 128, (bf16_t*)(nb + NSAW_W2), 0, 0, scr, gw, NGW, lane, rot);
            tr_matrix(args.in[10] + (size_t)(j * 2 + 1) * 128 * 128, 128, 128, (bf16_t*)(nb + NSAW_W2) + 128 * 128, 0, 0, scr, gw, NGW, lane, rot);
            tr_matrix(args.in[12] + (size_t)j * D_ * ML_IN, D_, ML_IN, (bf16_t*)mb, 0, 0, scr, gw, NGW, lane, rot);
            tr_matrix(args.in[15] + (size_t)j * D_ * D_, D_, D_, (bf16_t*)(mb + MLW_OUT), 0, 0, scr, gw, NGW, lane, rot);
        }
        }
        rmsnorm_phase(args.in[0], args.in[1], XN, X, gw, NGW, lane);
    }
    PHASE_END

#pragma unroll 1
    for (int i = 0; i < 4; ++i) {
        const int j = i >> 1;
        if (i > 0) {
            PHASE_BEGIN
            rmsnorm_phase(X, args.in[1] + i * D_, XN, nullptr, gw, NGW, lane);
            PHASE_END
        }
        if ((i & 1) == 0) {
            PHASE_BEGIN
            for (int tb = bid; tb < 256; tb += G) gate_gemm<3>(XN, (const bf16_t*)nb + (size_t)5120 * D_, PROJ, NSA_N, 5120, tb, lds, tid, wave, lane);
            { pg8::Gemm g{XN, (const bf16_t*)nb, S_, 5120, D_}; pg8::StaticOrder So; So.init(S_, 5120, G, bid); pg8::EpiStore E{PROJ, NSA_N};
              pg8::gemm_phase<pg8::EpiStore, pg8::StaticOrder, true, true>(lds, g, So, E, tid); }
            PHASE_END
            PHASE_BEGIN
            for (int tb = bid; tb < 256; tb += G) nsa_prep_unit(tb, PROJ, args.in[5] + j * 128, args.in[6] + j * 384, KS, KW, VTS, VTW, tid);
            for (int rep_ = 0; rep_ < REP_CMP; ++rep_)
            for (int task = bid; task < 256; task += G)
                nsa_compress_unit(task, PROJ, args.in[7] + (size_t)j * 2 * 32 * 128, (const bf16_t*)(nb + NSAW_W1), args.in[9] + j * 256, (const bf16_t*)(nb + NSAW_W2), args.in[6] + j * 384, KC, VTC, lds, tid, wave, lane);
            PHASE_END
            PHASE_BEGIN
            for (int rep_ = 0; rep_ < REP_ATTN; ++rep_)
            for (int task = bid; task < 1024; task += G) {
                const int k = task >> 8, bb = task & 255, xg = bb & 3, half = (bb >> 2) & 1, wi = bb >> 3;
                const int qb = half == 0 ? (k == 0 ? wi : k == 1 ? 127 - wi : k == 2 ? 128 + wi : 255 - wi) : (k == 0 ? 32 + wi : k == 1 ? 95 - wi : k == 2 ? 160 + wi : 223 - wi);
                nsa_attn_wg(qb, xg, PROJ, args.in[4] + j * 48, KC, VTC, KS, VTS, KW, VTW, Yb, lds, tid, wave, lane);
            }
            PHASE_END
            PHASE_BEGIN
            { pg8::Gemm g{Yb, (const bf16_t*)(nb + NSAW_OUT), S_, D_, D_}; pg8::StaticOrder So; So.init(S_, D_, G, bid); pg8::EpiResid E{X, D_};
              pg8::gemm_phase<pg8::EpiResid, pg8::StaticOrder, true, true>(lds, g, So, E, tid); }
            PHASE_END
        } else {
            PHASE_BEGIN
            for (int tb = bid; tb < 256; tb += G) gate_gemm<1>(XN, (const bf16_t*)mb + (size_t)6144 * D_, PROJ, ML_N, 6144, tb, lds, tid, wave, lane);
            { pg8::Gemm g{XN, (const bf16_t*)mb, S_, 6144, D_}; pg8::StaticOrder So; So.init(S_, 6144, G, bid); pg8::EpiStore E{PROJ, ML_N};
              pg8::gemm_phase<pg8::EpiStore, pg8::StaticOrder, true, true>(lds, g, So, E, tid); }
            PHASE_END
            PHASE_BEGIN
            ml_local_phase(bid, G, PROJ, bif, CT, NT, CI, lds, tid, wave, lane);
            PHASE_END
            PHASE_BEGIN
            for (int u = bid; u < 256; u += G) ml_scan_unit(u, CT, NT, CI, MC, lds, tid);
            PHASE_END
            PHASE_BEGIN
            for (int rep_ = 0; rep_ < REP_MLO; ++rep_)
            for (int u = bid; u < 2048; u += G) ml_out_unit(u, PROJ, bif, args.in[14] + j * D_, CT, NT, MC, Yb, lds, tid, wave, lane);
            PHASE_END
            PHASE_BEGIN
            { pg8::Gemm g{Yb, (const bf16_t*)(mb + MLW_OUT), S_, D_, D_}; pg8::StaticOrder So; So.init(S_, D_, G, bid); pg8::EpiResid E{X, D_};
              pg8::gemm_phase<pg8::EpiResid, pg8::StaticOrder, true, true>(lds, g, So, E, tid); }
            PHASE_END
        }
        PHASE_BEGIN
        rmsnorm_phase(X, args.in[2] + i * D_, XN, nullptr, gw, NGW, lane);
        PHASE_END
        PHASE_BEGIN
        for (int rep_ = 0; rep_ < REP_UP; ++rep_)
        { pg8::Gemm g{XN, (const bf16_t*)(ws + WS_FFN + i * FFN_STRIDE), S_, 2 * DFF, D_}; pg8::StaticOrder So; So.init(S_, 2 * DFF, G, bid); pg8::EpiSwiglu E{Hb, DFF};
          pg8::gemm_phase<pg8::EpiSwiglu, pg8::StaticOrder, true, true>(lds, g, So, E, tid); }
        PHASE_END
        PHASE_BEGIN
        { pg8::Gemm g{Hb, (const bf16_t*)(ws + WS_FFN + i * FFN_STRIDE + FFN_WD), S_, D_, DFF}; pg8::StaticOrder So; So.init(S_, D_, G, bid); pg8::EpiResid E{X, D_};
          pg8::gemm_phase<pg8::EpiResid, pg8::StaticOrder, true, true>(lds, g, So, E, tid); }
        PHASE_END
    }
}

#ifndef ONE_LAUNCH
#define ONE_LAUNCH 0
#endif
extern "C" void kernel_launch(void* const* d_in, const int* in_sizes, int n_in, void* d_out, int out_size, void* d_ws, size_t ws_size, hipStream_t stream) {
    static int grid = 0;
    if (grid == 0) {
        if (n_in != 19 || out_size != S_ * D_ || ws_size < WS_END) { fprintf(stderr, "kernel_launch: unexpected shapes n_in %d out %d ws %zu\n", n_in, out_size, ws_size); grid = -1; return; }
        int dev = 0, cus = 0, per_cu = 0;
        hipGetDevice(&dev); hipDeviceGetAttribute(&cus, hipDeviceAttributeMultiprocessorCount, dev);
        if (hipFuncSetAttribute((const void*)fwd_kernel, hipFuncAttributeMaxDynamicSharedMemorySize, LDS_BYTES) != hipSuccess) { fprintf(stderr, "kernel_launch: hipFuncSetAttribute failed\n"); grid = -1; return; }
        if (hipOccupancyMaxActiveBlocksPerMultiprocessor(&per_cu, (const void*)fwd_kernel, NTHR, LDS_BYTES) != hipSuccess || per_cu < 1) { fprintf(stderr, "kernel_launch: occupancy query says %d\n", per_cu); per_cu = 1; }
        (void)hipGetLastError();
        grid = cus;
        if (grid != 256) fprintf(stderr, "kernel_launch: %d CUs\n", grid);
    }
    if (grid < 0) return;
    Args a{};
    for (int i = 0; i < 19; ++i) a.in[i] = (const float*)d_in[i];
    a.out = (float*)d_out; a.ws = (unsigned char*)d_ws;
#if ONE_LAUNCH
    if (hipMemsetAsync((char*)d_ws + WS_MISC, 0, 16384, stream) != hipSuccess) { fprintf(stderr, "kernel_launch: memset failed\n"); return; }
    a.ph_lo = 0; a.ph_hi = NPH;
    void* kargs[] = {&a};
    hipError_t e = hipLaunchCooperativeKernel((const void*)fwd_kernel, dim3(grid), dim3(NTHR), kargs, LDS_BYTES, stream);
    if (e != hipSuccess) fprintf(stderr, "cooperative launch failed: %s (grid %d)\n", hipGetErrorString(e), grid);
#else
    for (int p = 0; p < NPH; ++p) {
        a.ph_lo = p; a.ph_hi = p + 1;
        hipLaunchKernelGGL(fwd_kernel, dim3(grid), dim3(NTHR), LDS_BYTES, stream, a);
    }
#endif
}
```

```cpp
#include <hip/hip_runtime.h>
#include <hip/hip_cooperative_groups.h>
#include <cstdio>
#include <cstdint>
#define ONE_LAUNCH 1
namespace pg8 {
#define PG8_LAS __attribute__((address_space(3)))
typedef unsigned short bf16_t;
typedef short bf16x8 __attribute__((ext_vector_type(8)));
typedef float f32x4 __attribute__((ext_vector_type(4)));
typedef unsigned u32x4 __attribute__((ext_vector_type(4)));
constexpr int BM = 256, BK = 64, HALF = 128, HTB = HALF * BK * 2  , STAGE_BYTES = 8 * HTB, NXCD = 8, WGM = 2;

__host__ __device__ __forceinline__ int lds_byte(int r, int c) { const int st = (r >> 4) * 2 + (c >> 5), rr = r & 15, cc = c & 31, ob = rr * 64 + cc * 2; return st * 1024 + (ob ^ (((ob >> 9) & 1) << 5)); }
__host__ __device__ __forceinline__ void stage_rc(int b, int& R, int& C) { const int st = b / 1024, sb = b % 1024, swz = sb ^ (((sb >> 9) & 1) << 5); R = (st >> 1) * 16 + swz / 64; C = (st & 1) * 32 + (swz % 64) / 2; }
__host__ __device__ __forceinline__ int perm32(int rho) { const int n = rho >> 4, i = rho & 15; return 8 * (i >> 2) + 4 * n + (i & 3); }

struct Unit { int pm, pn; };
struct Gemm { const bf16_t* A; const bf16_t* Bt; int M, N, K; };

struct StaticOrder {
    int nM, nN, nwg, G, c;
    __host__ __device__ void init(int M, int N, int G_, int c_) { nM = M / BM; nN = N / BM; nwg = nM * nN; G = G_; c = c_; }
    __host__ __device__ bool next(int i, Unit& u) const {
        const long L = (long)i * G + c; if (L >= nwg) return false;
        int wgid = (int)L; { const int q = nwg / NXCD, r = nwg % NXCD, xcd = wgid % NXCD, off = wgid / NXCD; wgid = (xcd < r ? xcd * (q + 1) : r * (q + 1) + (xcd - r) * q) + off; }
        const int nig = WGM * nN, gid = wgid / nig, fm = gid * WGM, gsz = (nM - fm) < WGM ? (nM - fm) : WGM;
        u.pm = fm + ((wgid % nig) % gsz); u.pn = (wgid % nig) / gsz; return true;
    }
    __device__ __forceinline__ void a_ready(const Unit&) const {}
    __device__ __forceinline__ void done(const Unit&) const {}
};
__device__ __forceinline__ unsigned cvt_pk_bf16(float lo, float hi) { unsigned r; asm volatile("v_cvt_pk_bf16_f32 %0, %1, %2" : "=v"(r) : "v"(lo), "v"(hi)); return r; }
typedef float f32x2e __attribute__((ext_vector_type(2))); typedef unsigned u32x2e __attribute__((ext_vector_type(2))); typedef __bf16 bf16x2e __attribute__((ext_vector_type(2)));
__device__ __forceinline__ unsigned pk2(float lo, float hi) { f32x2e v = {lo, hi}; bf16x2e b = __builtin_convertvector(v, bf16x2e); return __builtin_bit_cast(unsigned, b); }
struct EpiStore {
    static constexpr bool PERM = true, AFTER_DRAIN = false;
    bf16_t* O; int ldc;
    __device__ __forceinline__ void operator()(const f32x4 (&acc)[2][2][4][2], const Unit& u, int wr, int wc, int fr, int fq) const {
        const int row0 = u.pm * BM + wr * 64 + fr, col0 = u.pn * BM + wc * 32 + 8 * fq;
#pragma unroll
        for (int ai = 0; ai < 2; ++ai)
#pragma unroll
            for (int m = 0; m < 4; ++m) { bf16_t* rowp = O + (size_t)(row0 + ai * HALF + m * 16) * ldc + col0;
#pragma unroll
                for (int bj = 0; bj < 2; ++bj) { const f32x4 v0 = acc[ai][bj][m][0], v1 = acc[ai][bj][m][1];
                    u32x4 w; w.x = pk2(v0[0], v0[1]); w.y = pk2(v0[2], v0[3]); w.z = pk2(v1[0], v1[1]); w.w = pk2(v1[2], v1[3]);
                    *(u32x4*)(rowp + bj * HALF) = w; } }
    }
};
struct EpiSwiglu {
    static constexpr bool PERM = true, AFTER_DRAIN = false;
    bf16_t* H; int ldc;
    __device__ __forceinline__ void operator()(const f32x4 (&acc)[2][2][4][2], const Unit& u, int wr, int wc, int fr, int fq) const {
        const int row0 = u.pm * BM + wr * 64 + fr, col0 = u.pn * HALF + wc * 32 + 8 * fq;
#pragma unroll
        for (int ai = 0; ai < 2; ++ai)
#pragma unroll
            for (int m = 0; m < 4; ++m) { bf16_t* rowp = H + (size_t)(row0 + ai * HALF + m * 16) * ldc + col0;
                float h[8];
#pragma unroll
                for (int n = 0; n < 2; ++n)
#pragma unroll
                    for (int e = 0; e < 4; ++e) { const float g = acc[ai][0][m][n][e], up = acc[ai][1][m][n][e];
                        h[n * 4 + e] = g * up * __builtin_amdgcn_rcpf(1.0f + __builtin_amdgcn_exp2f(-1.4426950408889634f * g)); }
                u32x4 w; w.x = pk2(h[0], h[1]); w.y = pk2(h[2], h[3]); w.z = pk2(h[4], h[5]); w.w = pk2(h[6], h[7]);
                *(u32x4*)rowp = w; }
    }
};
struct EpiResid {
    static constexpr bool PERM = false, AFTER_DRAIN = false;
    const float* Xf_in; bf16_t* Xb; float* Xf_out; int ldc;
    __device__ __forceinline__ void operator()(const f32x4 (&acc)[2][2][4][2], const Unit& u, int wr, int wc, int fr, int fq) const {
        const int row0 = u.pm * BM + wr * 64 + fr, col0 = u.pn * BM + wc * 32 + 4 * fq;
#pragma unroll
        for (int ai = 0; ai < 2; ++ai)
#pragma unroll
            for (int mp = 0; mp < 2; ++mp) {
                f32x4 pre[2][2][2];
#pragma unroll
                for (int mm = 0; mm < 2; ++mm) { const size_t off = (size_t)(row0 + ai * HALF + (2 * mp + mm) * 16) * ldc + col0;
#pragma unroll
                    for (int bj = 0; bj < 2; ++bj)
#pragma unroll
                        for (int n = 0; n < 2; ++n) {
                            if (Xf_in) pre[mm][bj][n] = *(const f32x4*)(Xf_in + off + bj * HALF + n * 16);
                            else { const u32x2e w = *(const u32x2e*)(Xb + off + bj * HALF + n * 16);
                                   pre[mm][bj][n] = (f32x4){__uint_as_float(w.x << 16), __uint_as_float(w.x & 0xffff0000u), __uint_as_float(w.y << 16), __uint_as_float(w.y & 0xffff0000u)}; } } }
#pragma unroll
                for (int mm = 0; mm < 2; ++mm) { const size_t off = (size_t)(row0 + ai * HALF + (2 * mp + mm) * 16) * ldc + col0;
#pragma unroll
                    for (int bj = 0; bj < 2; ++bj)
#pragma unroll
                        for (int n = 0; n < 2; ++n) { const f32x4 v = pre[mm][bj][n] + acc[ai][bj][2 * mp + mm][n];
                            u32x2e w; w.x = pk2(v[0], v[1]); w.y = pk2(v[2], v[3]); *(u32x2e*)(Xb + off + bj * HALF + n * 16) = w;
                            if (Xf_out) *(f32x4*)(Xf_out + off + bj * HALF + n * 16) = v; } }
                asm volatile("" ::: "memory");
            }
    }
};
template <class Epi, class Sched, bool ALIGN_EPI = false, bool SP2 = false>
__device__ __forceinline__ void gemm_phase(PG8_LAS unsigned char* lds, const Gemm g, const Sched& S, const Epi& E, int tid_in) {
    int tid_l = tid_in; asm volatile("" : "+v"(tid_l)); const int tid = tid_l, wid = __builtin_amdgcn_readfirstlane(tid >> 6), lane = tid & 63, wr = wid >> 2, wc = wid & 3, fr = lane & 15, fq = lane >> 4;
    const int K = g.K, nt = K / BK;
    unsigned voffA[2], voffB[2];
#pragma unroll
    for (int i = 0; i < 2; ++i) { int R, C; stage_rc(tid * 16 + i * 8192, R, C); const int Rb = Epi::PERM ? ((R & ~31) + perm32(R & 31)) : R;
        voffA[i] = (unsigned)(R * K + C) * 2u; voffB[i] = (unsigned)(Rb * K + C) * 2u; }
    const size_t kstep = (size_t)(BK * 2);
    const size_t hstep = (size_t)HALF * K * 2;
    const size_t tstep = 2 * hstep;
    const unsigned ldsw = (unsigned)wid * 1024u;
    const int aoff = lds_byte(wr * 64 + fr, fq * 8), boff = lds_byte(wc * 32 + fr, fq * 8);
#define PG8_SA(b, h) (((b) * 2 + (h)) * HTB)
#define PG8_SB(b, h) ((4 + (b) * 2 + (h)) * HTB)
#define PG8_STAGE(bufoff, gbase, voff) do { _Pragma("unroll") for (int _i = 0; _i < 2; ++_i) \
        __builtin_amdgcn_global_load_lds((const unsigned*)((const char*)(gbase) + (voff)[_i]), (PG8_LAS unsigned*)(lds + (bufoff) + ldsw + _i * 8192), 16, 0, 0); } while (0)
#define PG8_LDA(dst, b, h) do { _Pragma("unroll") for (int m = 0; m < 4; ++m) _Pragma("unroll") for (int k = 0; k < 2; ++k) dst[m][k] = *(const PG8_LAS bf16x8*)(lds + PG8_SA(b, h) + aoff + m * 2048 + k * 1024); } while (0)
#define PG8_LDB(dst, b, h) do { _Pragma("unroll") for (int n = 0; n < 2; ++n) _Pragma("unroll") for (int k = 0; k < 2; ++k) dst[n][k] = *(const PG8_LAS bf16x8*)(lds + PG8_SB(b, h) + boff + n * 2048 + k * 1024); } while (0)
#define PG8_MMA(ai, bj, At, Bt) do { __builtin_amdgcn_s_setprio(1); _Pragma("unroll") for (int m = 0; m < 4; ++m) _Pragma("unroll") for (int n = 0; n < 2; ++n) _Pragma("unroll") for (int k = 0; k < 2; ++k) \
        acc[ai][bj][m][n] = __builtin_amdgcn_mfma_f32_16x16x32_bf16(Bt[n][k], At[m][k], acc[ai][bj][m][n], 0, 0, 0); __builtin_amdgcn_s_setprio(0); } while (0)
#define PG8_WAIT_V(n) asm volatile("s_waitcnt vmcnt(" #n ")" ::: "memory")
#define PG8_WAIT_L(n) asm volatile("s_waitcnt lgkmcnt(" #n ")" ::: "memory")
#define PG8_BAR __builtin_amdgcn_s_barrier()
#define PG8_SCHED __builtin_amdgcn_sched_barrier(0)
    Unit cur, nxt; int ui = 0;
    if (!S.next(0, cur)) return;
    f32x4 acc[2][2][4][2];
#pragma unroll
    for (int a = 0; a < 2; ++a)
#pragma unroll
        for (int b = 0; b < 2; ++b)
#pragma unroll
            for (int m = 0; m < 4; ++m)
#pragma unroll
                for (int n = 0; n < 2; ++n) acc[a][b][m][n] = (f32x4){0.f, 0.f, 0.f, 0.f};
    bf16x8 At[4][2], B0[2][2], B1[2][2];
    const char* cA = (const char*)g.A + (size_t)cur.pm * tstep; const char* cB = (const char*)g.Bt + (size_t)cur.pn * tstep;
    S.a_ready(cur);
    if constexpr (SP2) {
        PG8_STAGE(PG8_SB(0, 0), cB, voffB); PG8_STAGE(PG8_SB(0, 1), cB + hstep, voffB); PG8_STAGE(PG8_SA(0, 0), cA, voffA); PG8_STAGE(PG8_SA(0, 1), cA + hstep, voffA);
        if (wr == 1) PG8_BAR;
        PG8_WAIT_V(2); PG8_BAR;
        PG8_STAGE(PG8_SB(1, 0), cB + kstep, voffB); PG8_STAGE(PG8_SA(1, 0), cA + kstep, voffA); PG8_STAGE(PG8_SB(1, 1), cB + hstep + kstep, voffB);
        PG8_WAIT_V(6); PG8_BAR;
    } else {
        PG8_STAGE(PG8_SB(0, 0), cB, voffB); PG8_STAGE(PG8_SA(0, 0), cA, voffA); PG8_STAGE(PG8_SB(0, 1), cB + hstep, voffB); PG8_STAGE(PG8_SA(0, 1), cA + hstep, voffA);
        if (wr == 1) PG8_BAR;
        PG8_WAIT_V(4); PG8_BAR;
        PG8_STAGE(PG8_SB(1, 0), cB + kstep, voffB); PG8_STAGE(PG8_SA(1, 0), cA + kstep, voffA); PG8_STAGE(PG8_SB(1, 1), cB + hstep + kstep, voffB);
        PG8_WAIT_V(6); PG8_BAR;
    }
    for (;;) {
        const bool has_next = S.next(ui + 1, nxt);
        const char* nA = has_next ? (const char*)g.A + (size_t)nxt.pm * tstep : cA; const char* nB = has_next ? (const char*)g.Bt + (size_t)nxt.pn * tstep : cB;
        for (int t = 0; t < nt; t += 2) {
            const bool last = (t == nt - 2);
            const char* a1 = cA + (size_t)(t + 1) * kstep;
            const char* a2 = last ? nA : cA + (size_t)(t + 2) * kstep; const char* b2 = last ? nB : cB + (size_t)(t + 2) * kstep;
            const char* a3 = a2 + kstep; const char* b3 = b2 + kstep;
            if (last && has_next) S.a_ready(nxt);
            if constexpr (SP2) {
            PG8_LDB(B0, 0, 0); PG8_LDB(B1, 0, 1); PG8_SCHED; PG8_LDA(At, 0, 0); PG8_STAGE(PG8_SA(1, 1), a1 + hstep, voffA);
            PG8_WAIT_V(8); PG8_WAIT_L(0); PG8_BAR; PG8_MMA(0, 0, At, B0); PG8_MMA(0, 1, At, B1); PG8_BAR; PG8_SCHED;
            PG8_LDA(At, 0, 1); PG8_STAGE(PG8_SB(0, 0), b2, voffB); PG8_STAGE(PG8_SB(0, 1), b2 + hstep, voffB); PG8_STAGE(PG8_SA(0, 0), a2, voffA);
            PG8_WAIT_V(8); PG8_WAIT_L(0); PG8_BAR; PG8_MMA(1, 0, At, B0); PG8_MMA(1, 1, At, B1); PG8_BAR; PG8_SCHED;
            PG8_LDB(B0, 1, 0); PG8_LDB(B1, 1, 1); PG8_SCHED; PG8_LDA(At, 1, 0); PG8_STAGE(PG8_SA(0, 1), a2 + hstep, voffA);
            PG8_WAIT_V(8); PG8_WAIT_L(0); PG8_BAR; PG8_MMA(0, 0, At, B0); PG8_MMA(0, 1, At, B1); PG8_BAR; PG8_SCHED;
            PG8_LDA(At, 1, 1); PG8_STAGE(PG8_SB(1, 0), b3, voffB); PG8_STAGE(PG8_SB(1, 1), b3 + hstep, voffB); PG8_STAGE(PG8_SA(1, 0), a3, voffA);
            PG8_WAIT_V(8); PG8_WAIT_L(0); PG8_BAR; PG8_MMA(1, 0, At, B0); PG8_MMA(1, 1, At, B1); PG8_BAR; PG8_SCHED;
            } else {
            PG8_LDB(B0, 0, 0); PG8_SCHED; PG8_LDA(At, 0, 0); PG8_STAGE(PG8_SA(1, 1), a1 + hstep, voffA);
            PG8_WAIT_L(8); PG8_BAR; PG8_WAIT_L(0); PG8_MMA(0, 0, At, B0); PG8_BAR; PG8_SCHED;
            PG8_LDB(B1, 0, 1); PG8_STAGE(PG8_SB(0, 0), b2, voffB);
            PG8_BAR; PG8_WAIT_L(0); PG8_MMA(0, 1, At, B1); PG8_BAR;
            PG8_LDA(At, 0, 1); PG8_STAGE(PG8_SA(0, 0), a2, voffA);
            PG8_BAR; PG8_WAIT_L(0); PG8_MMA(1, 0, At, B0); PG8_BAR; PG8_SCHED;
            PG8_STAGE(PG8_SB(0, 1), b2 + hstep, voffB);
            PG8_WAIT_V(6); PG8_BAR; PG8_MMA(1, 1, At, B1); PG8_BAR;
            PG8_LDB(B0, 1, 0); PG8_SCHED; PG8_LDA(At, 1, 0); PG8_STAGE(PG8_SA(0, 1), a2 + hstep, voffA);
            PG8_WAIT_L(8); PG8_BAR; PG8_WAIT_L(0); PG8_MMA(0, 0, At, B0); PG8_BAR; PG8_SCHED;
            PG8_LDB(B1, 1, 1); PG8_STAGE(PG8_SB(1, 0), b3, voffB);
            PG8_BAR; PG8_WAIT_L(0); PG8_MMA(0, 1, At, B1); PG8_BAR;
            PG8_LDA(At, 1, 1); PG8_STAGE(PG8_SA(1, 0), a3, voffA);
            PG8_BAR; PG8_WAIT_L(0); PG8_MMA(1, 0, At, B0); PG8_BAR; PG8_SCHED;
            PG8_STAGE(PG8_SB(1, 1), b3 + hstep, voffB);
            PG8_WAIT_V(6); PG8_BAR; PG8_MMA(1, 1, At, B1); PG8_BAR;
            }
        }
        if constexpr (ALIGN_EPI) { if (wr == 0) PG8_BAR; }
        if constexpr (!Epi::AFTER_DRAIN) { E(acc, cur, wr, wc, fr, fq); S.done(cur); }
        if (!has_next) break;
#pragma unroll
        for (int a = 0; a < 2; ++a)
#pragma unroll
            for (int b = 0; b < 2; ++b)
#pragma unroll
                for (int m = 0; m < 4; ++m)
#pragma unroll
                    for (int n = 0; n < 2; ++n) acc[a][b][m][n] = (f32x4){0.f, 0.f, 0.f, 0.f};
        cur = nxt; cA = nA; cB = nB; ++ui;
        if constexpr (ALIGN_EPI) { if (wr == 1) PG8_BAR; }
    }
    PG8_WAIT_V(0);
    if constexpr (!ALIGN_EPI) { if (wr == 0) PG8_BAR; }
    PG8_BAR;
    if constexpr (Epi::AFTER_DRAIN) { E.fused(acc, cur, wr, wc, fr, fq, lds, wid, lane); S.done(cur); }
#undef PG8_SA
#undef PG8_SB
#undef PG8_STAGE
#undef PG8_LDA
#undef PG8_LDB
#undef PG8_MMA
#undef PG8_WAIT_V
#undef PG8_WAIT_L
#undef PG8_BAR
#undef PG8_SCHED
}
}
namespace cg = cooperative_groups;
#define LAS __attribute__((address_space(3)))
typedef unsigned short bf16_t;
typedef short bf16x8 __attribute__((ext_vector_type(8)));
typedef float f32x4 __attribute__((ext_vector_type(4)));
typedef unsigned u32x4 __attribute__((ext_vector_type(4)));
typedef unsigned u32x2 __attribute__((ext_vector_type(2)));
#define MFMA16(a, b, c) __builtin_amdgcn_mfma_f32_16x16x32_bf16((a), (b), (c), 0, 0, 0)
using pg8::pk2;

constexpr int S_ = 16384, D_ = 2048, DFF = 5632;
constexpr int NSA_N = 5376, NSA_IN = 5168, ML_N = 6400, ML_IN = 6160;
constexpr float EPS = 1e-6f;
constexpr float QSCALE = 0.08838834764831845f * 1.4426950408889634f;
constexpr float NEG = -1e30f;
constexpr int NWAVES = 8, NTHR = 512, LDS_BYTES = 147456;
constexpr int NPH = 34;

constexpr size_t MiB = 1u << 20;
constexpr size_t WS_MISC = 0, WS_FFN = 1 * MiB, WS_NSAW = 265 * MiB, WS_MLW = 329 * MiB, WS_XN = 400 * MiB, WS_PROJ = 464 * MiB, WS_EXT = 664 * MiB, WS_XB = 800 * MiB, WS_END = 864 * MiB;
constexpr size_t FFN_STRIDE = 66 * MiB, FFN_WD = 44 * MiB;
constexpr size_t NSAW_STRIDE = 32 * MiB, NSAW_OUT = 21 * MiB, NSAW_W1 = 29 * MiB, NSAW_W2 = 31 * MiB;
constexpr size_t MLW_STRIDE = 34 * MiB, MLW_OUT = 25 * MiB;
constexpr size_t EXT_KS = 0, EXT_KW = 16 * MiB, EXT_VTS = 32 * MiB, EXT_VTW = 48 * MiB, EXT_KC = 64 * MiB, EXT_VTC = 65 * MiB;
constexpr size_t EXT_CT = 0, EXT_NT = 128 * MiB, EXT_CI = 129 * MiB, EXT_MC = 129 * MiB + 65536;

struct Args { const float* in[19]; float* out; unsigned char* ws; int ph_lo, ph_hi; };

__device__ __forceinline__ float bf2f(unsigned short b) { return __uint_as_float(((unsigned)b) << 16); }
__device__ __forceinline__ float bflo(unsigned w) { return __uint_as_float(w << 16); }
__device__ __forceinline__ float bfhi(unsigned w) { return __uint_as_float(w & 0xffff0000u); }
__device__ __forceinline__ float wave_sum(float v) {
#pragma unroll
    for (int o = 1; o < 64; o <<= 1) v += __shfl_xor(v, o);
    return v;
}
__device__ __forceinline__ float wave_max(float v) {
#pragma unroll
    for (int o = 1; o < 64; o <<= 1) v = fmaxf(v, __shfl_xor(v, o));
    return v;
}
__device__ __forceinline__ float quad_sum(float v) {
    v += __builtin_bit_cast(float, __builtin_amdgcn_mov_dpp(__builtin_bit_cast(int, v), 0xB1, 0xF, 0xF, true));
    v += __builtin_bit_cast(float, __builtin_amdgcn_mov_dpp(__builtin_bit_cast(int, v), 0x4E, 0xF, 0xF, true));
    return v;
}
__device__ __forceinline__ float fq_sum(float v) { v += __shfl_xor(v, 16); v += __shfl_xor(v, 32); return v; }
__device__ __forceinline__ float fq_max(float v) { v = fmaxf(v, __shfl_xor(v, 16)); v = fmaxf(v, __shfl_xor(v, 32)); return v; }
__device__ __forceinline__ float ex2(float x) { return __builtin_amdgcn_exp2f(x); }
__device__ __forceinline__ float sigmoidf_(float x) { return __builtin_amdgcn_rcpf(1.0f + ex2(-1.4426950408889634f * x)); }

__device__ __forceinline__ void tr_item(const float* __restrict__ W, int K, int N, bf16_t* __restrict__ WT, int mode, int off, LAS float* scr, int item, int lane) {
    const int nblk = (N + 63) >> 6, kb = item / nblk, nb = item - kb * nblk, k0 = 64 * kb, n0 = 64 * nb;
    const int c4 = (lane & 15) * 4, nn = n0 + c4;
    f32x4 v[16];
#pragma unroll
    for (int i = 0; i < 16; ++i) { const int kk = 4 * i + (lane >> 4); v[i] = nn < N ? *(const f32x4*)(W + (size_t)(k0 + kk) * N + nn) : (f32x4){0.f, 0.f, 0.f, 0.f}; }
#pragma unroll
    for (int i = 0; i < 16; ++i) { const int kk = 4 * i + (lane >> 4); LAS float* d = scr + kk * 65 + c4; d[0] = v[i].x; d[1] = v[i].y; d[2] = v[i].z; d[3] = v[i].w; }
    asm volatile("s_waitcnt lgkmcnt(0)" ::: "memory");
    const int c = lane & 7;
#pragma unroll
    for (int j = 0; j < 8; ++j) { const int nl = (lane >> 3) + 8 * j, n = n0 + nl; const LAS float* s = scr + (8 * c) * 65 + nl;
        u32x4 o; o.x = pk2(s[0 * 65], s[1 * 65]); o.y = pk2(s[2 * 65], s[3 * 65]); o.z = pk2(s[4 * 65], s[5 * 65]); o.w = pk2(s[6 * 65], s[7 * 65]);
        const int drow = mode ? ((n >> 7) * 256 + (n & 127) + off) : (n + off);
        if (n < N) *(u32x4*)(WT + (size_t)drow * K + k0 + 8 * c) = o; }
    asm volatile("s_waitcnt lgkmcnt(0)" ::: "memory");
}
__device__ __forceinline__ void tr_matrix(const float* W, int K, int N, bf16_t* WT, int mode, int off, LAS float* scr, int gw, int NGW, int lane, int& rot) {
    const int nblk = (N + 63) >> 6, nitems = (K >> 6) * nblk;
    int first = gw - rot; if (first < 0) first += NGW;
    for (int it = first; it < nitems; it += NGW) tr_item(W, K, N, WT, mode, off, scr, it, lane);
    rot = (rot + nitems) % NGW;
}
__device__ __forceinline__ void rmsnorm_phase(const float* __restrict__ x, const float* __restrict__ g, bf16_t* __restrict__ XN, float* xcopy, int gw, int NGW, int lane) {
    for (int m = gw; m < S_; m += NGW) {
        const f32x4* xr = (const f32x4*)(x + (size_t)m * D_) + lane;
        f32x4 v[8]; float s = 0.f;
#pragma unroll
        for (int j = 0; j < 8; ++j) { v[j] = xr[64 * j]; s += (v[j].x * v[j].x + v[j].y * v[j].y) + (v[j].z * v[j].z + v[j].w * v[j].w); }
        s = wave_sum(s);
        const float rs = 1.0f / sqrtf(s * (1.0f / D_) + EPS);
        if (xcopy) {
            f32x4* xc = (f32x4*)(xcopy + (size_t)m * D_) + lane;
#pragma unroll
            for (int j = 0; j < 8; ++j) xc[64 * j] = v[j];
        }
        u32x2* o8 = (u32x2*)(XN + (size_t)m * D_) + lane;
#pragma unroll
        for (int j = 0; j < 8; ++j) { const f32x4 gg = ((const f32x4*)g)[lane + 64 * j]; u32x2 w; w.x = pk2(v[j].x * rs * gg.x, v[j].y * rs * gg.y); w.y = pk2(v[j].z * rs * gg.z, v[j].w * rs * gg.w); o8[64 * j] = w; }
    }
}

template <int NT>
__device__ __forceinline__ void gate_gemm(const bf16_t* __restrict__ XNp, const bf16_t* __restrict__ Wt, bf16_t* __restrict__ OUT, int ld, int col0, int tb, LAS unsigned char* lds, int tid, int wave, int lane) {
    const int fr = lane & 15, fq = lane >> 4, rt = wave & 3, kh = wave >> 2;
    const bf16_t* ap = XNp + (size_t)(64 * tb + 16 * rt + fr) * D_ + kh * 1024 + 8 * fq;
    const bf16_t* bp = Wt + (size_t)fr * D_ + kh * 1024 + 8 * fq;
    f32x4 acc[NT];
#pragma unroll
    for (int nt = 0; nt < NT; ++nt) acc[nt] = (f32x4){0.f, 0.f, 0.f, 0.f};
    for (int k0 = 0; k0 < 32; k0 += 4) {
        bf16x8 a[4], b[4][NT];
#pragma unroll
        for (int u = 0; u < 4; ++u) {
            a[u] = *(const bf16x8*)(ap + 32 * (k0 + u));
#pragma unroll
            for (int nt = 0; nt < NT; ++nt) b[u][nt] = *(const bf16x8*)(bp + (size_t)(16 * nt) * D_ + 32 * (k0 + u));
        }
#pragma unroll
        for (int u = 0; u < 4; ++u)
#pragma unroll
            for (int nt = 0; nt < NT; ++nt) acc[nt] = MFMA16(b[u][nt], a[u], acc[nt]);
    }
    LAS float* P = (LAS float*)lds;
#pragma unroll
    for (int nt = 0; nt < NT; ++nt) *(LAS f32x4*)(P + ((kh * 64 + 16 * rt + fr) * (NT * 16) + 16 * nt + 4 * fq)) = acc[nt];
    __syncthreads();
    for (int idx = tid; idx < 64 * NT * 16; idx += NTHR) {
        const int tok = idx / (NT * 16), n = idx - tok * (NT * 16);
        const float v = P[idx] + P[64 * NT * 16 + idx];
        OUT[(size_t)(64 * tb + tok) * ld + col0 + n] = (bf16_t)(pk2(v, v) & 0xffffu);
    }
    __syncthreads();
}

__device__ __forceinline__ void rmsnorm_bf16_phase(const bf16_t* __restrict__ x, const float* __restrict__ g, bf16_t* __restrict__ XN, int gw, int NGW, int lane) {
    for (int m = gw; m < S_; m += NGW) {
        const u32x4* xr = (const u32x4*)(x + (size_t)m * D_) + lane;
        u32x4 v[4]; float s = 0.f;
#pragma unroll
        for (int j = 0; j < 4; ++j) v[j] = xr[64 * j];
#pragma unroll
        for (int j = 0; j < 4; ++j) { const float a0 = bflo(v[j].x), a1 = bfhi(v[j].x), a2 = bflo(v[j].y), a3 = bfhi(v[j].y), a4 = bflo(v[j].z), a5 = bfhi(v[j].z), a6 = bflo(v[j].w), a7 = bfhi(v[j].w);
            s += ((a0 * a0 + a1 * a1) + (a2 * a2 + a3 * a3)) + ((a4 * a4 + a5 * a5) + (a6 * a6 + a7 * a7)); }
        s = wave_sum(s);
        const float rs = 1.0f / sqrtf(s * (1.0f / D_) + EPS);
        u32x4* o = (u32x4*)(XN + (size_t)m * D_) + lane;
#pragma unroll
        for (int j = 0; j < 4; ++j) { const f32x4 g0 = ((const f32x4*)g)[2 * (lane + 64 * j)], g1 = ((const f32x4*)g)[2 * (lane + 64 * j) + 1];
            u32x4 w; w.x = pk2(bflo(v[j].x) * rs * g0.x, bfhi(v[j].x) * rs * g0.y); w.y = pk2(bflo(v[j].y) * rs * g0.z, bfhi(v[j].y) * rs * g0.w);
            w.z = pk2(bflo(v[j].z) * rs * g1.x, bfhi(v[j].z) * rs * g1.y); w.w = pk2(bflo(v[j].w) * rs * g1.z, bfhi(v[j].w) * rs * g1.w); o[64 * j] = w; }
    }
}

__device__ __forceinline__ void nsa_prep_unit(int tb, bf16_t* PROJ, const float* qg, const float* kg, bf16_t* KS, bf16_t* KW, bf16_t* VTS, bf16_t* VTW, int tid) {
    const int sub = tid & 15;
    for (int it0 = 0; it0 < 48; it0 += 8) {
        u32x4 raw4[8];
#pragma unroll
        for (int u = 0; u < 8; ++u) {
            const int task = (it0 + u) * 32 + (tid >> 4), tok = task / 24, v = task - tok * 24, t = tb * 64 + tok;
            const int col = v < 16 ? v * 128 : v < 20 ? 2048 + (2 * 4 + (v - 16)) * 128 : 2048 + (4 * 4 + (v - 20)) * 128;
            raw4[u] = *(const u32x4*)(PROJ + (size_t)t * NSA_N + col + 8 * sub);
        }
#pragma unroll
        for (int u = 0; u < 8; ++u) {
            const int task = (it0 + u) * 32 + (tid >> 4), tok = task / 24, v = task - tok * 24, t = tb * 64 + tok;
            const float* gain; float gs = 1.0f; bf16_t* dst;
            if (v < 16) { gain = qg; gs = QSCALE; dst = PROJ + (size_t)t * NSA_N + v * 128; }
            else if (v < 20) { const int g = v - 16; gain = kg + 128; dst = KS + ((size_t)g * S_ + t) * 128; }
            else { const int g = v - 20; gain = kg + 256; dst = KW + ((size_t)g * S_ + t) * 128; }
            const u32x4 raw = raw4[u];
            float x[8] = {bflo(raw.x), bfhi(raw.x), bflo(raw.y), bfhi(raw.y), bflo(raw.z), bfhi(raw.z), bflo(raw.w), bfhi(raw.w)};
            float ss = 0.f;
#pragma unroll
            for (int e = 0; e < 8; ++e) ss += x[e] * x[e];
            ss += __shfl_xor(ss, 1); ss += __shfl_xor(ss, 2); ss += __shfl_xor(ss, 4); ss += __shfl_xor(ss, 8);
            const float rs = gs / sqrtf(ss * (1.0f / 128.0f) + EPS);
            const f32x4 g0 = *(const f32x4*)(gain + 8 * sub), g1 = *(const f32x4*)(gain + 8 * sub + 4);
            u32x4 o; o.x = pk2(x[0] * rs * g0.x, x[1] * rs * g0.y); o.y = pk2(x[2] * rs * g0.z, x[3] * rs * g0.w); o.z = pk2(x[4] * rs * g1.x, x[5] * rs * g1.y); o.w = pk2(x[6] * rs * g1.z, x[7] * rs * g1.w);
            *(u32x4*)(dst + 8 * sub) = o;
        }
    }
    for (int it0 = 0; it0 < 16; it0 += 4) {
        unsigned short e[4][8];
#pragma unroll
        for (int u = 0; u < 4; ++u) {
            const int task = (it0 + u) * 512 + tid, tile = task >> 10, rem = task & 1023, kc = rem >> 7, d = rem & 127, which = tile >> 2, g = tile & 3;
            const bf16_t* src = PROJ + (size_t)(tb * 64 + 8 * kc) * NSA_N + 2048 + ((which ? 5 : 3) * 4 + g) * 128 + d;
#pragma unroll
            for (int i = 0; i < 8; ++i) e[u][i] = src[(size_t)i * NSA_N];
        }
#pragma unroll
        for (int u = 0; u < 4; ++u) {
            const int task = (it0 + u) * 512 + tid, tile = task >> 10, rem = task & 1023, kc = rem >> 7, d = rem & 127, which = tile >> 2, g = tile & 3;
            u32x4 o; o.x = e[u][0] | ((unsigned)e[u][1] << 16); o.y = e[u][2] | ((unsigned)e[u][3] << 16); o.z = e[u][4] | ((unsigned)e[u][5] << 16); o.w = e[u][6] | ((unsigned)e[u][7] << 16);
            bf16_t* VT = which ? VTW : VTS;
            *(u32x4*)(VT + (((size_t)g * 256 + tb) * 128 + d) * 64 + 8 * kc) = o;
        }
    }
}

__device__ __forceinline__ float gelu_tanh(float x) {
    const float u = 0.7978845608028654f * (x + 0.044715f * x * x * x);
    const float t = 1.0f - 2.0f * __builtin_amdgcn_rcpf(1.0f + ex2(2.0f * 1.4426950408889634f * u));
    return 0.5f * x * (1.0f + t);
}
__device__ __forceinline__ void nsa_compress_unit(int task, const bf16_t* PROJ, const float* pos, const bf16_t* W1t, const float* b1, const bf16_t* W2t, const float* kg0,
                                                  bf16_t* KC, bf16_t* VTC, LAS unsigned char* lds, int tid, int wave, int lane) {
    const int kv = task >> 7, g = (task >> 5) & 3, ct = task & 31, c0 = 32 * ct, fr = lane & 15, fq = lane >> 4;
    LAS float* part = (LAS float*)lds;
    LAS bf16_t* hS = (LAS bf16_t*)(lds + 131072);
    const int crow0 = (c0 + fr) < 1023 ? (c0 + fr) : 1022, crow1 = (c0 + 16 + fr) < 1023 ? (c0 + 16 + fr) : 1022;
    const bf16_t* abase0 = PROJ + (size_t)(16 * crow0) * NSA_N + 2048 + (kv * 4 + g) * 128 + 8 * fq;
    const bf16_t* abase1 = PROJ + (size_t)(16 * crow1) * NSA_N + 2048 + (kv * 4 + g) * 128 + 8 * fq;
    const bf16_t* wbase = W1t + (size_t)kv * 128 * 4096 + (size_t)fr * 4096 + 8 * fq;
    const float* pbase = pos + (size_t)kv * 32 * 128 + 8 * fq;
    f32x4 acc[2][8];
#pragma unroll
    for (int r2 = 0; r2 < 2; ++r2)
#pragma unroll
        for (int i = 0; i < 8; ++i) acc[r2][i] = (f32x4){0.f, 0.f, 0.f, 0.f};
    for (int li = 0; li < 4; ++li) {
        const int l = 4 * wave + li;
#pragma unroll
        for (int dd = 0; dd < 4; ++dd) {
            const u32x4 raw0 = *(const u32x4*)(abase0 + (size_t)l * NSA_N + 32 * dd), raw1 = *(const u32x4*)(abase1 + (size_t)l * NSA_N + 32 * dd);
            const f32x4 p0 = *(const f32x4*)(pbase + l * 128 + 32 * dd), p1 = *(const f32x4*)(pbase + l * 128 + 32 * dd + 4);
            u32x4 a; a.x = pk2(bflo(raw0.x) + p0.x, bfhi(raw0.x) + p0.y); a.y = pk2(bflo(raw0.y) + p0.z, bfhi(raw0.y) + p0.w);
            a.z = pk2(bflo(raw0.z) + p1.x, bfhi(raw0.z) + p1.y); a.w = pk2(bflo(raw0.w) + p1.z, bfhi(raw0.w) + p1.w);
            u32x4 b; b.x = pk2(bflo(raw1.x) + p0.x, bfhi(raw1.x) + p0.y); b.y = pk2(bflo(raw1.y) + p0.z, bfhi(raw1.y) + p0.w);
            b.z = pk2(bflo(raw1.z) + p1.x, bfhi(raw1.z) + p1.y); b.w = pk2(bflo(raw1.w) + p1.z, bfhi(raw1.w) + p1.w);
            const bf16x8 af0 = __builtin_bit_cast(bf16x8, a), af1 = __builtin_bit_cast(bf16x8, b);
#pragma unroll
            for (int nt = 0; nt < 8; ++nt) { const bf16x8 bfr = *(const bf16x8*)(wbase + (size_t)nt * 16 * 4096 + l * 128 + 32 * dd); acc[0][nt] = MFMA16(bfr, af0, acc[0][nt]); acc[1][nt] = MFMA16(bfr, af1, acc[1][nt]); }
        }
    }
#pragma unroll
    for (int r2 = 0; r2 < 2; ++r2)
#pragma unroll
        for (int nt = 0; nt < 8; ++nt) *(LAS f32x4*)(part + (wave * 32 + 16 * r2 + fr) * 128 + 16 * nt + 4 * fq) = acc[r2][nt];
    __syncthreads();
    {
        const int c = tid >> 4, n8 = (tid & 15) * 8;
        f32x4 s0 = *(const f32x4*)(b1 + kv * 128 + n8), s1 = *(const f32x4*)(b1 + kv * 128 + n8 + 4);
#pragma unroll
        for (int w = 0; w < 8; ++w) { s0 = s0 + *(LAS f32x4*)(part + (w * 32 + c) * 128 + n8); s1 = s1 + *(LAS f32x4*)(part + (w * 32 + c) * 128 + n8 + 4); }
        u32x4 o; o.x = pk2(gelu_tanh(s0.x), gelu_tanh(s0.y)); o.y = pk2(gelu_tanh(s0.z), gelu_tanh(s0.w)); o.z = pk2(gelu_tanh(s1.x), gelu_tanh(s1.y)); o.w = pk2(gelu_tanh(s1.z), gelu_tanh(s1.w));
        *(LAS u32x4*)(hS + c * 136 + n8) = o;
    }
    __syncthreads();
    {
        f32x4 a2[2] = {(f32x4){0.f, 0.f, 0.f, 0.f}, (f32x4){0.f, 0.f, 0.f, 0.f}};
#pragma unroll
        for (int ks = 0; ks < 4; ++ks) {
            const bf16x8 wf = *(const bf16x8*)(W2t + (size_t)kv * 128 * 128 + (size_t)(16 * wave + fr) * 128 + 32 * ks + 8 * fq);
#pragma unroll
            for (int r2 = 0; r2 < 2; ++r2) { const bf16x8 hf = *(LAS bf16x8*)(hS + (16 * r2 + fr) * 136 + 32 * ks + 8 * fq); a2[r2] = MFMA16(wf, hf, a2[r2]); }
        }
#pragma unroll
        for (int r2 = 0; r2 < 2; ++r2) *(LAS f32x4*)(part + (16 * r2 + fr) * 128 + 16 * wave + 4 * fq) = a2[r2];
    }
    __syncthreads();
    if (kv == 0) {
        const int c = tid >> 4, sub = tid & 15;
        const f32x4 x0 = *(LAS f32x4*)(part + c * 128 + 8 * sub), x1 = *(LAS f32x4*)(part + c * 128 + 8 * sub + 4);
        float ss = (x0.x * x0.x + x0.y * x0.y) + (x0.z * x0.z + x0.w * x0.w) + (x1.x * x1.x + x1.y * x1.y) + (x1.z * x1.z + x1.w * x1.w);
        ss += __shfl_xor(ss, 1); ss += __shfl_xor(ss, 2); ss += __shfl_xor(ss, 4); ss += __shfl_xor(ss, 8);
        float rs = 1.0f / sqrtf(ss * (1.0f / 128.0f) + EPS);
        if (c0 + c >= 1023) rs = 0.f;
        const f32x4 g0 = *(const f32x4*)(kg0 + 8 * sub), g1 = *(const f32x4*)(kg0 + 8 * sub + 4);
        u32x4 o; o.x = pk2(x0.x * rs * g0.x, x0.y * rs * g0.y); o.y = pk2(x0.z * rs * g0.z, x0.w * rs * g0.w); o.z = pk2(x1.x * rs * g1.x, x1.y * rs * g1.y); o.w = pk2(x1.z * rs * g1.z, x1.w * rs * g1.w);
        *(u32x4*)(KC + ((size_t)g * 1024 + c0 + c) * 128 + 8 * sub) = o;
    } else {
        if (tid < 256) {
            const int d = tid & 127, hh = tid >> 7; float v[16];
#pragma unroll
            for (int c = 0; c < 16; ++c) v[c] = (c0 + 16 * hh + c < 1023) ? part[(16 * hh + c) * 128 + d] : 0.f;
            u32x4 o0, o1; o0.x = pk2(v[0], v[1]); o0.y = pk2(v[2], v[3]); o0.z = pk2(v[4], v[5]); o0.w = pk2(v[6], v[7]);
            o1.x = pk2(v[8], v[9]); o1.y = pk2(v[10], v[11]); o1.z = pk2(v[12], v[13]); o1.w = pk2(v[14], v[15]);
            bf16_t* dst = VTC + (((size_t)g * 16 + (ct >> 1)) * 128 + d) * 64 + 32 * (ct & 1) + 16 * hh;
            *(u32x4*)dst = o0; *(u32x4*)(dst + 8) = o1;
        }
    }
    __syncthreads();
}

__device__ __forceinline__ unsigned long long shfl_xor_u64(unsigned long long v, int m) {
    const unsigned lo = __shfl_xor((unsigned)v, m), hi = __shfl_xor((unsigned)(v >> 32), m);
    return ((unsigned long long)hi << 32) | lo;
}

struct QuadState { bf16x8 qf[4]; f32x4 o[8]; float l; };
constexpr int AT_STAGE = 32768, AT_V = 16384;
constexpr int AT_IMP = 2 * AT_STAGE;
constexpr int AT_SELM = AT_IMP + 65536;
static_assert(AT_SELM + 2048 + 512 <= LDS_BYTES, "attention LDS map");

template <bool WV>
__device__ __forceinline__ void at_dma(LAS unsigned char* st, const bf16_t* __restrict__ Kb, const bf16_t* __restrict__ Vb, int wave, int lane) {
#pragma unroll
    for (int i = 0; i < 2; ++i) {
        const int k = 2 * wave + i;
        const int rho = 4 * k + (lane >> 4), sg = lane & 15, key = (rho & 32) + ((rho >> 2) & 3) * 8 + ((rho >> 4) & 1) * 4 + (rho & 3);
        __builtin_amdgcn_global_load_lds((const unsigned*)(Kb + key * 128 + 8 * (sg ^ (rho & 15))), (LAS unsigned*)(st + 1024 * k), 16, 0, 0);
    }
    if (WV) {
#pragma unroll
        for (int i = 0; i < 2; ++i) {
            const int k = 2 * wave + i;
            const int d = 8 * k + (lane >> 3), sg = lane & 7;
            __builtin_amdgcn_global_load_lds((const unsigned*)(Vb + d * 64 + 8 * (sg ^ ((d >> 1) & 7))), (LAS unsigned*)(st + AT_V + 1024 * k), 16, 0, 0);
        }
    }
}
template <int MODE, bool DUAL>
__device__ __forceinline__ void at_block(const LAS unsigned char* st, QuadState& A, QuadState& B, bool domask, float biasA, float biasB, int pos0, int loA, int hiA, int loB, int hiB, float invlA, float invlB,
                                         float& carryA, float& carryB, LAS float* impA, LAS float* impB, int lane, int fr, int fq) {
    f32x4 sA[4], sB[4];
#pragma unroll
    for (int T = 0; T < 4; ++T) { sA[T] = (f32x4){biasA, biasA, biasA, biasA}; sB[T] = (f32x4){biasB, biasB, biasB, biasB}; }
    bf16x8 vpre[8];
    if (!DUAL && MODE != 0) {
#pragma unroll
        for (int dt = 0; dt < 8; ++dt) vpre[dt] = *(const LAS bf16x8*)(st + AT_V + (16 * dt + fr) * 128 + 16 * ((fq) ^ ((fr >> 1) & 7)));
    }
#pragma unroll
    for (int ks = 0; ks < 4; ++ks) {
        bf16x8 kf[4];
#pragma unroll
        for (int T = 0; T < 4; ++T) kf[T] = *(const LAS bf16x8*)(st + (32 * (T >> 1) + 16 * (T & 1) + fr) * 256 + 16 * ((4 * fq + ks) ^ fr));
#pragma unroll
        for (int T = 0; T < 4; ++T) { sA[T] = MFMA16(kf[T], A.qf[ks], sA[T]); if (DUAL) sB[T] = MFMA16(kf[T], B.qf[ks], sB[T]); }
        if (DUAL) __builtin_amdgcn_sched_barrier(0);
    }
    float la = 0.f, lb = 0.f;
    if (domask) {
#pragma unroll
        for (int T = 0; T < 4; ++T)
#pragma unroll
            for (int i = 0; i < 4; ++i) {
                const int pos = pos0 + 32 * (T >> 1) + 8 * fq + 4 * (T & 1) + i;
                if (!(pos >= loA && pos <= hiA)) sA[T][i] = NEG;
                if (DUAL) { if (!(pos >= loB && pos <= hiB)) sB[T][i] = NEG; }
            }
    }
#pragma unroll
    for (int T = 0; T < 4; ++T)
#pragma unroll
        for (int i = 0; i < 4; ++i) {
            float e = ex2(sA[T][i]); if (MODE == 2) e *= invlA; sA[T][i] = e; la += e;
            if (DUAL) { float f = ex2(sB[T][i]); if (MODE == 2) f *= invlB; sB[T][i] = f; lb += f; }
        }
    if (MODE != 2) { A.l += la; if (DUAL) B.l += lb; }
    if (MODE == 2) {
        const int src = (lane + 48) & 63;
        {
            const float r0 = __shfl(sA[1][3], src), r1 = __shfl(sA[3][3], src);
            const float pv0 = fq ? r0 : carryA, pv1 = fq ? r1 : r0; carryA = r1;
            float i00 = (sA[0][0] + sA[0][1]) + (sA[0][2] + sA[0][3]) + pv0, i01 = (sA[1][0] + sA[1][1]) + (sA[1][2] + sA[1][3]) + sA[0][3];
            float i10 = (sA[2][0] + sA[2][1]) + (sA[2][2] + sA[2][3]) + pv1, i11 = (sA[3][0] + sA[3][1]) + (sA[3][2] + sA[3][3]) + sA[2][3];
            i00 = quad_sum(i00); i01 = quad_sum(i01); i10 = quad_sum(i10); i11 = quad_sum(i11);
            if ((fr & 3) == 0) { impA[2 * fq] = i00; impA[2 * fq + 1] = i01; impA[8 + 2 * fq] = i10; impA[8 + 2 * fq + 1] = i11; }
        }
        if (DUAL) {
            const float r0 = __shfl(sB[1][3], src), r1 = __shfl(sB[3][3], src);
            const float pv0 = fq ? r0 : carryB, pv1 = fq ? r1 : r0; carryB = r1;
            float i00 = (sB[0][0] + sB[0][1]) + (sB[0][2] + sB[0][3]) + pv0, i01 = (sB[1][0] + sB[1][1]) + (sB[1][2] + sB[1][3]) + sB[0][3];
            float i10 = (sB[2][0] + sB[2][1]) + (sB[2][2] + sB[2][3]) + pv1, i11 = (sB[3][0] + sB[3][1]) + (sB[3][2] + sB[3][3]) + sB[2][3];
            i00 = quad_sum(i00); i01 = quad_sum(i01); i10 = quad_sum(i10); i11 = quad_sum(i11);
            if ((fr & 3) == 0) { impB[2 * fq] = i00; impB[2 * fq + 1] = i01; impB[8 + 2 * fq] = i10; impB[8 + 2 * fq + 1] = i11; }
        }
    }
    if (MODE != 0) {
        bf16x8 pfA[2], pfB[2];
#pragma unroll
        for (int u = 0; u < 2; ++u) {
            u32x4 w; w.x = pk2(sA[2 * u][0], sA[2 * u][1]); w.y = pk2(sA[2 * u][2], sA[2 * u][3]); w.z = pk2(sA[2 * u + 1][0], sA[2 * u + 1][1]); w.w = pk2(sA[2 * u + 1][2], sA[2 * u + 1][3]); pfA[u] = __builtin_bit_cast(bf16x8, w);
            if (DUAL) { u32x4 x; x.x = pk2(sB[2 * u][0], sB[2 * u][1]); x.y = pk2(sB[2 * u][2], sB[2 * u][3]); x.z = pk2(sB[2 * u + 1][0], sB[2 * u + 1][1]); x.w = pk2(sB[2 * u + 1][2], sB[2 * u + 1][3]); pfB[u] = __builtin_bit_cast(bf16x8, x); }
        }
#pragma unroll
        for (int u = 0; u < 2; ++u) {
#pragma unroll
            for (int dt = 0; dt < 8; ++dt) {
                const bf16x8 vf = (DUAL || u == 1) ? *(const LAS bf16x8*)(st + AT_V + (16 * dt + fr) * 128 + 16 * ((4 * u + fq) ^ ((fr >> 1) & 7))) : vpre[dt];
                A.o[dt] = MFMA16(vf, pfA[u], A.o[dt]); if (DUAL) B.o[dt] = MFMA16(vf, pfB[u], B.o[dt]);
                if (DUAL && (dt & 3) == 3) __builtin_amdgcn_sched_barrier(0);
            }
        }
    }
}
template <int MODE, bool SEL, int NST>
__device__ __forceinline__ void at_run(LAS unsigned char* lds, const bf16_t* Kg, const bf16_t* Vg, int first, int last, QuadState& A, QuadState& B, int loA, int hiA, int loB, int hiB,
                                       float invlA, float invlB, LAS float* impA, LAS float* impB, const LAS unsigned* uni, const LAS unsigned* selmA, const LAS unsigned* selmB,
                                       int tid, int lane, int fr, int fq, int nm_lo = 1, int nm_hi = 0) {
    constexpr bool WV = MODE != 0;
    constexpr int BPS = NST / 2;
    const int wave = __builtin_amdgcn_readfirstlane(tid >> 6);
    const int sb0 = first / BPS, sb1 = last / BPS;
    float carryA = 0.f, carryB = 0.f;
#define AT_DMA_SB(sb) do { _Pragma("unroll") for (int h_ = 0; h_ < BPS; ++h_) { const int blk_ = (sb) * BPS + h_; if (blk_ >= first && blk_ <= last) \
        at_dma<WV>(lds + ((((sb) & 1) * BPS + h_) * AT_STAGE), Kg + (size_t)blk_ * 8192, Vg + (size_t)blk_ * 8192, wave, lane); } } while (0)
    AT_DMA_SB(sb0);
    unsigned wa = 0u, wb = 0u;
    for (int sb = sb0; sb <= sb1; ++sb) {
        asm volatile("s_waitcnt vmcnt(0)" ::: "memory");
        __syncthreads();
        if (sb < sb1) AT_DMA_SB(sb + 1);
#pragma unroll
        for (int h = 0; h < BPS; ++h) {
            const int idx = sb * BPS + h;
            if (idx < first || idx > last) continue;
            const LAS unsigned char* st = lds + (((sb & 1) * BPS + h) * AT_STAGE);
            if (SEL) {
                if ((idx & 31) == 0 || idx == first) { wa = (unsigned)__builtin_amdgcn_readfirstlane((int)uni[idx >> 5]); wb = (unsigned)__builtin_amdgcn_readfirstlane((int)uni[8 + (idx >> 5)]); }
                const bool actA = (wa >> (idx & 31)) & 1u, actB = (wb >> (idx & 31)) & 1u;
                if (actA) { const float bA = ((selmA[idx >> 5] >> (idx & 31)) & 1u) ? 0.f : NEG; at_block<1, false>(st, A, A, idx == last, bA, bA, 64 * idx, 0, hiA, 0, hiA, 0.f, 0.f, carryA, carryA, nullptr, nullptr, lane, fr, fq); }
                if (actB) { const float bB = ((selmB[idx >> 5] >> (idx & 31)) & 1u) ? 0.f : NEG; at_block<1, false>(st, B, B, idx == last, bB, bB, 64 * idx, 0, hiB, 0, hiB, 0.f, 0.f, carryB, carryB, nullptr, nullptr, lane, fr, fq); }
            } else {
                at_block<MODE, true>(st, A, B, idx < nm_lo || idx > nm_hi, 0.f, 0.f, 64 * idx, loA, hiA, loB, hiB, invlA, invlB, carryA, carryB, impA + 16 * idx, impB + 16 * idx, lane, fr, fq);
            }
        }
    }
#undef AT_DMA_SB
    asm volatile("s_waitcnt vmcnt(0)" ::: "memory");
    __syncthreads();
}
__device__ __forceinline__ void y_accum(bf16_t* yp, const f32x4 (&o)[8], float sc, bool first) {
    u32x2 old[8];
    if (!first) {
#pragma unroll
        for (int dt = 0; dt < 8; ++dt) old[dt] = *(const u32x2*)(yp + 16 * dt);
    }
#pragma unroll
    for (int dt = 0; dt < 8; ++dt) {
        float a0 = o[dt][0] * sc, a1 = o[dt][1] * sc, a2 = o[dt][2] * sc, a3 = o[dt][3] * sc;
        if (!first) { a0 += bflo(old[dt].x); a1 += bfhi(old[dt].x); a2 += bflo(old[dt].y); a3 += bfhi(old[dt].y); }
        u32x2 w; w.x = pk2(a0, a1); w.y = pk2(a2, a3); *(u32x2*)(yp + 16 * dt) = w;
    }
}
__device__ __forceinline__ void nsa_attn_wg(int qb, int g, const bf16_t* PROJ, const float* bgate, const bf16_t* KC, const bf16_t* VTC, const bf16_t* KS, const bf16_t* VTS,
                                            const bf16_t* KW, const bf16_t* VTW, bf16_t* Y, LAS unsigned char* lds, int tid, int wave, int lane) {
    const int fr = lane & 15, fq = lane >> 4, a = fr >> 2, r = fr & 3, cur = qb;
    const int tlA = 8 * wave + a, tlB = tlA + 4, tA = 64 * qb + tlA, tB = 64 * qb + tlB;
    LAS float* IMP = (LAS float*)(lds + AT_IMP); LAS unsigned* SELM = (LAS unsigned*)(lds + AT_SELM); LAS unsigned* UNI = SELM + 512;
    QuadState A, B;
    {
        const bf16x8* qa = (const bf16x8*)(PROJ + (size_t)tA * NSA_N + (4 * g + r) * 128 + 32 * fq); const bf16x8* qbp = (const bf16x8*)(PROJ + (size_t)tB * NSA_N + (4 * g + r) * 128 + 32 * fq);
#pragma unroll
        for (int ks = 0; ks < 4; ++ks) { A.qf[ks] = qa[ks]; B.qf[ks] = qbp[ks]; }
    }
#define gpA (PROJ + (size_t)tA * NSA_N + 5120 + (4 * g + r) * 3)
#define gpB (PROJ + (size_t)tB * NSA_N + 5120 + (4 * g + r) * 3)
#define bg (bgate + (4 * g + r) * 3)
#define ypA (Y + (size_t)tA * D_ + (4 * g + r) * 128 + 4 * fq)
#define ypB (Y + (size_t)tB * D_ + (4 * g + r) * 128 + 4 * fq)
    {
        const int cmA = (tA - 31) >> 4, cmB = (tB - 31) >> 4, nb = ((4 * qb + 2) >> 6) + 1;
        const bf16_t* KCg = KC + (size_t)g * 1024 * 128; const bf16_t* VCg = VTC + (size_t)g * 16 * 8192;
        A.l = 0.f; B.l = 0.f;
        at_run<0, false, 2>(lds, KCg, VCg, 0, nb - 1, A, B, 0, cmA, 0, cmB, 0.f, 0.f, nullptr, nullptr, nullptr, nullptr, nullptr, tid, lane, fr, fq, 0, (4 * qb - 65) >> 6);
        const float lA = fq_sum(A.l), lB = fq_sum(B.l);
        const float invlA = lA > 0.f ? 1.0f / lA : 0.f, invlB = lB > 0.f ? 1.0f / lB : 0.f;
#pragma unroll
        for (int i = 0; i < 8; ++i) { A.o[i] = (f32x4){0.f, 0.f, 0.f, 0.f}; B.o[i] = (f32x4){0.f, 0.f, 0.f, 0.f}; }
        at_run<2, false, 2>(lds, KCg, VCg, 0, nb - 1, A, B, 0, cmA, 0, cmB, invlA, invlB, IMP + tlA * 256, IMP + tlB * 256, nullptr, nullptr, nullptr, tid, lane, fr, fq, 0, (4 * qb - 65) >> 6);
        y_accum(ypA, A.o, sigmoidf_(bf2f(gpA[0]) + bg[0]), true);
        y_accum(ypB, B.o, sigmoidf_(bf2f(gpB[0]) + bg[0]), true);
    }
    asm volatile("s_waitcnt lgkmcnt(0)" ::: "memory");
    {
        float val[8][4]; unsigned selb[8];
#pragma unroll
        for (int ta = 0; ta < 8; ++ta) {
            selb[ta] = 0u;
#pragma unroll
            for (int q = 0; q < 4; ++q) {
                const int j = lane + 64 * q;
                if ((j <= cur) && (j == 0 || j >= cur - 1 || cur <= 15)) selb[ta] |= 1u << q;
                val[ta][q] = (cur > 15 && j >= 1 && j <= cur - 2) ? IMP[(8 * wave + ta) * 256 + j] : -1.0f;
            }
        }
        if (cur > 15) {
            for (int it = 0; it < 13; ++it) {
                unsigned long long best[8];
#pragma unroll
                for (int ta = 0; ta < 8; ++ta) {
                    unsigned long long b = 0ull;
#pragma unroll
                    for (int q = 0; q < 4; ++q) if (val[ta][q] >= 0.f) { const unsigned long long k = ((unsigned long long)__float_as_uint(val[ta][q]) << 32) | (unsigned)(256 - (lane + 64 * q)); b = k > b ? k : b; }
                    best[ta] = b;
                }
#pragma unroll
                for (int m = 1; m < 64; m <<= 1) {
#pragma unroll
                    for (int ta = 0; ta < 8; ++ta) { const unsigned long long ot = shfl_xor_u64(best[ta], m); best[ta] = ot > best[ta] ? ot : best[ta]; }
                }
#pragma unroll
                for (int ta = 0; ta < 8; ++ta) {
                    const int jw = 256 - (int)(best[ta] & 0x1ffu);
#pragma unroll
                    for (int q = 0; q < 4; ++q) if (lane + 64 * q == jw) { val[ta][q] = -1.0f; selb[ta] |= 1u << q; }
                }
            }
        }
#pragma unroll
        for (int ta = 0; ta < 8; ++ta)
#pragma unroll
            for (int q = 0; q < 4; ++q) {
                const unsigned long long m = __ballot((selb[ta] >> q) & 1u);
                if (lane == 0) { SELM[(8 * wave + ta) * 8 + 2 * q] = (unsigned)m; SELM[(8 * wave + ta) * 8 + 2 * q + 1] = (unsigned)(m >> 32); }
            }
    }
    asm volatile("s_waitcnt lgkmcnt(0)" ::: "memory");
    if (lane < 16) {
        const int qd = lane >> 3, wd = lane & 7;
        UNI[16 * wave + lane] = SELM[(8 * wave + 4 * qd + 0) * 8 + wd] | SELM[(8 * wave + 4 * qd + 1) * 8 + wd] | SELM[(8 * wave + 4 * qd + 2) * 8 + wd] | SELM[(8 * wave + 4 * qd + 3) * 8 + wd];
    }
    asm volatile("s_waitcnt lgkmcnt(0)" ::: "memory");
    __syncthreads();
    {
#pragma unroll
        for (int i = 0; i < 8; ++i) { A.o[i] = (f32x4){0.f, 0.f, 0.f, 0.f}; B.o[i] = (f32x4){0.f, 0.f, 0.f, 0.f}; }
        A.l = 0.f; B.l = 0.f;
        at_run<1, true, 4>(lds, KS + (size_t)g * S_ * 128, VTS + (size_t)g * 256 * 8192, 0, cur, A, B, 0, tA, 0, tB, 0.f, 0.f, nullptr, nullptr, UNI + 16 * wave, SELM + tlA * 8, SELM + tlB * 8, tid, lane, fr, fq);
        const float lA = fq_sum(A.l), lB = fq_sum(B.l);
        y_accum(ypA, A.o, lA > 0.f ? sigmoidf_(bf2f(gpA[1]) + bg[1]) / lA : 0.f, false);
        y_accum(ypB, B.o, lB > 0.f ? sigmoidf_(bf2f(gpB[1]) + bg[1]) / lB : 0.f, false);
    }
    {
#pragma unroll
        for (int i = 0; i < 8; ++i) { A.o[i] = (f32x4){0.f, 0.f, 0.f, 0.f}; B.o[i] = (f32x4){0.f, 0.f, 0.f, 0.f}; }
        A.l = 0.f; B.l = 0.f;
        const int jlo = qb >= 8 ? qb - 8 : 0;
        at_run<1, false, 4>(lds, KW + (size_t)g * S_ * 128, VTW + (size_t)g * 256 * 8192, jlo, cur, A, B, tA - 511, tA, tB - 511, tB, 0.f, 0.f, nullptr, nullptr, nullptr, nullptr, nullptr, tid, lane, fr, fq, qb - 7, qb - 1);
        const float lA = fq_sum(A.l), lB = fq_sum(B.l);
        y_accum(ypA, A.o, lA > 0.f ? sigmoidf_(bf2f(gpA[2]) + bg[2]) / lA : 0.f, false);
        y_accum(ypB, B.o, lB > 0.f ? sigmoidf_(bf2f(gpB[2]) + bg[2]) / lB : 0.f, false);
    }
#undef gpA
#undef gpB
#undef bg
#undef ypA
#undef ypB
}

__device__ __forceinline__ float log_sigmoid(float x) { return fminf(x, 0.f) - log1pf(__expf(-fabsf(x))); }
__device__ __forceinline__ void ml_stage_load(const bf16_t* PROJ, int h, int c, bool do_k, int tid, u32x4 (&rk)[2], u32x4 (&rv)[4]) {
    if (do_k) {
#pragma unroll
        for (int i = 0; i < 2; ++i) { const int idx = tid + 512 * i, s = (idx & 3) + 4 * (idx >> 6), ch = (idx >> 2) & 15; rk[i] = *(const u32x4*)(PROJ + (size_t)(64 * c + s) * ML_N + 1024 + h * 128 + 8 * ch); }
    }
#pragma unroll
    for (int i = 0; i < 4; ++i) { const int i2 = tid + 512 * i, s = (i2 & 3) + 4 * (i2 >> 7), ch = (i2 >> 2) & 31; rv[i] = *(const u32x4*)(PROJ + (size_t)(64 * c + s) * ML_N + 2048 + h * 256 + 8 * ch); }
}
__device__ __forceinline__ void ml_stage_store(LAS bf16_t* kT, LAS bf16_t* vT, const LAS float* wS, bool do_k, int tid, const u32x4 (&rk)[2], const u32x4 (&rv)[4]) {
    if (do_k) {
#pragma unroll
        for (int i = 0; i < 2; ++i) {
            const int idx = tid + 512 * i, s = (idx & 3) + 4 * (idx >> 6), ch = (idx >> 2) & 15, col = (s + 8 * ch) & 63;
            const float w = wS[s] * 0.08838834764831845f;
            const unsigned ww[4] = {rk[i].x, rk[i].y, rk[i].z, rk[i].w};
#pragma unroll
            for (int e = 0; e < 4; ++e) { const unsigned pkd = pk2(bflo(ww[e]) * w, bfhi(ww[e]) * w); kT[(8 * ch + 2 * e) * 72 + col] = (bf16_t)(pkd & 0xffffu); kT[(8 * ch + 2 * e + 1) * 72 + col] = (bf16_t)(pkd >> 16); }
        }
    }
#pragma unroll
    for (int i = 0; i < 4; ++i) {
        const int i2 = tid + 512 * i, s = (i2 & 3) + 4 * (i2 >> 7), ch = (i2 >> 2) & 31, col = (s + 8 * ch) & 63;
        const unsigned ww[4] = {rv[i].x, rv[i].y, rv[i].z, rv[i].w};
#pragma unroll
        for (int e = 0; e < 4; ++e) { vT[(8 * ch + 2 * e) * 72 + col] = (bf16_t)(ww[e] & 0xffffu); vT[(8 * ch + 2 * e + 1) * 72 + col] = (bf16_t)(ww[e] >> 16); }
    }
}
__device__ __forceinline__ void ml_local_phase(int first, int step, const bf16_t* PROJ, const float* bif, bf16_t* CT, float* NT, float* CI, LAS unsigned char* lds, int tid, int wave, int lane) {
    const int fr = lane & 15, fq = lane >> 4;
    LAS bf16_t* kT = (LAS bf16_t*)lds;
    LAS bf16_t* vT = (LAS bf16_t*)(lds + 18432);
    LAS float* wS = (LAS float*)(lds + 18432 + 36864);
    u32x4 rk[2], rv[4]; unsigned short gi = 0, gf = 0;
    if (first < 2048) {
        ml_stage_load(PROJ, first >> 8, first & 255, true, tid, rk, rv);
        if (wave == 0) { const bf16_t* gp = PROJ + (size_t)(64 * (first & 255) + lane) * ML_N + 6144 + (first >> 8); gi = gp[0]; gf = gp[8]; }
    }
    for (int unit = first; unit < 2048; unit += step) {
        const int h = unit >> 8, c = unit & 255;
        if (wave == 0) {
            const float ig = bf2f(gi) + bif[h], lf = log_sigmoid(bf2f(gf) + bif[8 + h]);
            float b = lf;
#pragma unroll
            for (int o = 1; o < 64; o <<= 1) { const float u = __shfl_up(b, o); if (lane >= o) b += u; }
            const float blast = __shfl(b, 63), gs = blast - b + ig, gmax = wave_max(gs);
            wS[lane] = __expf(gs - gmax);
            if (lane == 0) { CI[(h * 256 + c) * 2] = blast; CI[(h * 256 + c) * 2 + 1] = gmax; }
        }
        __syncthreads();
        ml_stage_store(kT, vT, wS, true, tid, rk, rv);
        __syncthreads();
        const int un = unit + step;
        if (un < 2048) {
            ml_stage_load(PROJ, un >> 8, un & 255, true, tid, rk, rv);
            if (wave == 0) { const bf16_t* gp = PROJ + (size_t)(64 * (un & 255) + lane) * ML_N + 6144 + (un >> 8); gi = gp[0]; gf = gp[8]; }
        }
        f32x4 acc[16];
#pragma unroll
        for (int i = 0; i < 16; ++i) acc[i] = (f32x4){0.f, 0.f, 0.f, 0.f};
#pragma unroll
        for (int ks = 0; ks < 2; ++ks) {
            const bf16x8 af = *(LAS bf16x8*)(kT + (16 * wave + fr) * 72 + 8 * ((4 * ks + fq + 2 * wave + (fr >> 3)) & 7));
#pragma unroll
            for (int nt = 0; nt < 16; ++nt) { const bf16x8 bfr = *(LAS bf16x8*)(vT + (16 * nt + fr) * 72 + 8 * ((4 * ks + fq + 2 * nt + (fr >> 3)) & 7)); acc[nt] = MFMA16(af, bfr, acc[nt]); }
        }
        LAS bf16_t* tS = (LAS bf16_t*)(lds + 57344);
#pragma unroll
        for (int nt = 0; nt < 16; ++nt) { u32x2 w; w.x = pk2(acc[nt][0], acc[nt][1]); w.y = pk2(acc[nt][2], acc[nt][3]); *(LAS u32x2*)(tS + (16 * nt + fr) * 136 + 16 * wave + 4 * fq) = w; }
        if (tid < 128) { float s = 0.f; for (int i = 0; i < 64; ++i) s += bf2f(kT[tid * 72 + i]); NT[(size_t)(h * 256 + c) * 128 + tid] = s; }
        __syncthreads();
        {
            bf16_t* ct = CT + ((size_t)(h * 256 + c) * 256) * 128;
#pragma unroll
            for (int i = 0; i < 8; ++i) { const int q = tid + 512 * i, row = q >> 4, c16 = q & 15; *(u32x4*)(ct + (size_t)row * 128 + 8 * c16) = *(LAS u32x4*)(tS + row * 136 + 8 * c16); }
        }
    }
}
__device__ __forceinline__ void ml_scan_unit(int unit, bf16_t* CT, float* NT, const float* CI, float* MC, LAS unsigned char* lds, int tid) {
    const int h = unit >> 5, part = unit & 31;
    LAS float* cdS = (LAS float*)lds; LAS float* eS = cdS + 256; LAS float* blS = eS + 256; LAS float* gmS = blS + 256; LAS float* mS = gmS + 256;
    if (tid < 256) { blS[tid] = CI[(h * 256 + tid) * 2]; gmS[tid] = CI[(h * 256 + tid) * 2 + 1]; }
    __syncthreads();
    {
        float B = 0.f, Gm = 0.f;
        if (tid < 256) { B = blS[tid]; Gm = gmS[tid]; }
        for (int off = 1; off < 256; off <<= 1) {
            if (tid < 256) { cdS[tid] = B; eS[tid] = Gm; }
            __syncthreads();
            if (tid < 256 && tid >= off) { const float B1 = cdS[tid - off], G1 = eS[tid - off]; Gm = fmaxf(G1 + B, Gm); B = B1 + B; }
            __syncthreads();
        }
        if (tid < 256) mS[tid + 1] = fmaxf(NEG + B, Gm);
        if (tid == 0) mS[0] = NEG;
    }
    __syncthreads();
    if (tid < 256) {
        const float m = mS[tid], mn = mS[tid + 1];
        cdS[tid] = __expf(blS[tid] + m - mn); eS[tid] = __expf(gmS[tid] - mn);
        if (part == 0) MC[h * 256 + tid] = m;
    }
    __syncthreads();
    {
        unsigned* p = (unsigned*)(CT + (size_t)h * 256 * 32768) + part * 512 + tid;
        float r0 = 0.f, r1 = 0.f;
        unsigned d[16], dn[16];
#pragma unroll
        for (int i = 0; i < 16; ++i) d[i] = p[(size_t)i * 16384];
        for (int c0 = 0; c0 < 256; c0 += 16) {
            if (c0 + 16 < 256) {
#pragma unroll
                for (int i = 0; i < 16; ++i) dn[i] = p[(size_t)(c0 + 16 + i) * 16384];
            }
#pragma unroll
            for (int i = 0; i < 16; ++i) { p[(size_t)(c0 + i) * 16384] = pk2(r0, r1); const float cd = cdS[c0 + i], e = eS[c0 + i]; r0 = cd * r0 + e * bflo(d[i]); r1 = cd * r1 + e * bfhi(d[i]); }
#pragma unroll
            for (int i = 0; i < 16; ++i) d[i] = dn[i];
        }
    }
    if (part == 0 && tid < 128) {
        float* p = NT + (size_t)h * 256 * 128 + tid; float r = 0.f;
        for (int c0 = 0; c0 < 256; c0 += 16) {
            float d[16];
#pragma unroll
            for (int i = 0; i < 16; ++i) d[i] = p[(c0 + i) * 128];
#pragma unroll
            for (int i = 0; i < 16; ++i) { p[(c0 + i) * 128] = r; r = cdS[c0 + i] * r + eS[c0 + i] * d[i]; }
        }
    }
    __syncthreads();
}
__device__ __forceinline__ void ml_out_unit(int unit, const bf16_t* PROJ, const float* bif, const float* outg, const bf16_t* CT, const float* NT, const float* MC, bf16_t* Y,
                                            LAS unsigned char* lds, int tid, int wave, int lane) {
    const int h = unit >> 8, c = unit & 255, fr = lane & 15, fq = lane >> 4, tt = wave & 3, dvh = wave >> 2;
    LAS bf16_t* vT = (LAS bf16_t*)(lds + 18432);
    LAS float* dS = (LAS float*)(lds + 18432 + 36864);
    LAS float* pmS = dS + 64;
    LAS float* bS = pmS + 64;
    LAS float* nS = bS + 64;
    LAS float* ssS = nS + 128;
    u32x4 rk[2], rv[4];
    ml_stage_load(PROJ, h, c, false, tid, rk, rv);
    if (wave == 0) {
        const bf16_t* gp = PROJ + (size_t)(64 * c + lane) * ML_N + 6144 + h;
        const float ig = bf2f(gp[0]) + bif[h], lf = log_sigmoid(bf2f(gp[8]) + bif[8 + h]);
        float b = lf;
#pragma unroll
        for (int o = 1; o < 64; o <<= 1) { const float u = __shfl_up(b, o); if (lane >= o) b += u; }
        const float d = ig - b; float pm = d;
#pragma unroll
        for (int o = 1; o < 64; o <<= 1) { const float u = __shfl_up(pm, o); if (lane >= o) pm = fmaxf(pm, u); }
        dS[lane] = d; pmS[lane] = pm; bS[lane] = b;
    }
    if (tid >= 64 && tid < 192) nS[tid - 64] = NT[(size_t)(h * 256 + c) * 128 + tid - 64];
    const int trow = 16 * tt + fr;
    const float mc = MC[h * 256 + c];
    bf16x8 qf[4], kfr[4][4], ctf[4][4];
    {
        const bf16_t* qp = PROJ + (size_t)(64 * c + trow) * ML_N + h * 128 + 8 * fq;
#pragma unroll
        for (int ks = 0; ks < 4; ++ks) qf[ks] = *(const bf16x8*)(qp + 32 * ks);
#pragma unroll
        for (int T = 0; T < 4; ++T) {
            const int s_ = 32 * (T >> 1) + 8 * (fr >> 2) + 4 * (T & 1) + (fr & 3);
            const bf16_t* kp = PROJ + (size_t)(64 * c + s_) * ML_N + 1024 + h * 128 + 8 * fq;
#pragma unroll
            for (int ks = 0; ks < 4; ++ks) kfr[T][ks] = *(const bf16x8*)(kp + 32 * ks);
        }
    }
    const bf16_t* ctp = CT + ((size_t)(h * 256 + c) * 256 + 128 * dvh + fr) * 128 + 8 * fq;
#pragma unroll
    for (int dt = 0; dt < 4; ++dt)
#pragma unroll
        for (int ks = 0; ks < 4; ++ks) ctf[dt][ks] = *(const bf16x8*)(ctp + (size_t)(16 * dt) * 128 + 32 * ks);
    ml_stage_store(nullptr, vT, nullptr, false, tid, rk, rv);
    __syncthreads();
    const float Mt = fmaxf(mc, pmS[trow]), bt = bS[trow], dec = __expf(mc - Mt);
    float A[4][4]; float rsum = 0.f;
#pragma unroll
    for (int T = 0; T < 4; ++T) {
        f32x4 a = (f32x4){0.f, 0.f, 0.f, 0.f};
#pragma unroll
        for (int ks = 0; ks < 4; ++ks) a = MFMA16(kfr[T][ks], qf[ks], a);
#pragma unroll
        for (int i = 0; i < 4; ++i) { const int ss = 32 * (T >> 1) + 8 * fq + 4 * (T & 1) + i; const float v = ss <= trow ? __expf(dS[ss] - Mt) * a[i] * 0.08838834764831845f : 0.f; A[T][i] = v; rsum += v; }
    }
    bf16x8 ctg[4][4];
#pragma unroll
    for (int dt = 0; dt < 4; ++dt)
#pragma unroll
        for (int ks = 0; ks < 4; ++ks) ctg[dt][ks] = *(const bf16x8*)(ctp + (size_t)(16 * (dt + 4)) * 128 + 32 * ks);
    rsum = fq_sum(rsum);
    bf16x8 af[2];
#pragma unroll
    for (int u = 0; u < 2; ++u) { u32x4 w; w.x = pk2(A[2 * u][0], A[2 * u][1]); w.y = pk2(A[2 * u][2], A[2 * u][3]); w.z = pk2(A[2 * u + 1][0], A[2 * u + 1][1]); w.w = pk2(A[2 * u + 1][2], A[2 * u + 1][3]); af[u] = __builtin_bit_cast(bf16x8, w); }
    float qn = 0.f;
#pragma unroll
    for (int ks = 0; ks < 4; ++ks) { const u32x4 w = __builtin_bit_cast(u32x4, qf[ks]); const LAS float* np = nS + 32 * ks + 8 * fq;
        qn += bflo(w.x) * np[0] + bfhi(w.x) * np[1] + bflo(w.y) * np[2] + bfhi(w.y) * np[3] + bflo(w.z) * np[4] + bfhi(w.z) * np[5] + bflo(w.w) * np[6] + bfhi(w.w) * np[7]; }
    qn = fq_sum(qn);
    const float den = rsum + dec * qn, dnm = fmaxf(fabsf(den), __expf(-(bt + Mt))), inv = 1.0f / dnm;
    f32x4 acc[8];
    float ssq = 0.f;
#pragma unroll
    for (int dt = 0; dt < 8; ++dt) {
        f32x4 a = (f32x4){0.f, 0.f, 0.f, 0.f};
#pragma unroll
        for (int ks = 0; ks < 4; ++ks) a = MFMA16(dt < 4 ? ctf[dt][ks] : ctg[dt - 4 < 0 ? 0 : dt - 4][ks], qf[ks], a);
        a = a * dec;
#pragma unroll
        for (int u = 0; u < 2; ++u) a = MFMA16(*(LAS bf16x8*)(vT + (128 * dvh + 16 * dt + fr) * 72 + 8 * ((4 * u + fq + 2 * dt + (fr >> 3)) & 7)), af[u], a);
        a = a * inv;
        ssq += (a[0] * a[0] + a[1] * a[1]) + (a[2] * a[2] + a[3] * a[3]);
        acc[dt] = a;
    }
    ssq = fq_sum(ssq);
    if (fq == 0) ssS[wave * 16 + fr] = ssq;
    const size_t trg = (size_t)(64 * c + trow);
    f32x4 ggv[8]; u32x2 owv[8];
#pragma unroll
    for (int dt = 0; dt < 8; ++dt) { const int dv = 128 * dvh + 16 * dt + 4 * fq; ggv[dt] = *(const f32x4*)(outg + h * 256 + dv); owv[dt] = *(const u32x2*)(PROJ + trg * ML_N + 4096 + h * 256 + dv); }
    __syncthreads();
    const float tot = ssS[wave * 16 + fr] + ssS[(wave ^ 4) * 16 + fr];
    const float rs = 1.0f / sqrtf(tot * (1.0f / 256.0f) + EPS);
#pragma unroll
    for (int dt = 0; dt < 8; ++dt) {
        const int dv = 128 * dvh + 16 * dt + 4 * fq;
        const f32x4 gg = ggv[dt];
        const u32x2 ow = owv[dt];
        const float y0 = acc[dt][0] * rs * gg.x * sigmoidf_(bflo(ow.x)), y1 = acc[dt][1] * rs * gg.y * sigmoidf_(bfhi(ow.x));
        const float y2 = acc[dt][2] * rs * gg.z * sigmoidf_(bflo(ow.y)), y3 = acc[dt][3] * rs * gg.w * sigmoidf_(bfhi(ow.y));
        u32x2 w; w.x = pk2(y0, y1); w.y = pk2(y2, y3);
        *(u32x2*)(Y + trg * D_ + h * 256 + dv) = w;
    }
    __syncthreads();
}

#define GAS __attribute__((address_space(1)))
#define XB_TMO      128
#define XB_XCNT(j)  (256  + 64 * (j))
#define XB_XSUB(j)  (1280 + 64 * (j))
#define XB_XGEN(j)  (2304 + 64 * (j))
#define XB_TOP      3328
#define XB_TOPGEN   3392
#define XCD_BAR_WORDS 3456
#define XB_SPIN_CAP (1u << 18)

__device__ __forceinline__ unsigned xb_ld(unsigned* p)              { return __hip_atomic_load(p, __ATOMIC_RELAXED, __HIP_MEMORY_SCOPE_AGENT); }
__device__ __forceinline__ unsigned xb_add(unsigned* p, unsigned v) { return __hip_atomic_fetch_add(p, v, __ATOMIC_RELAXED, __HIP_MEMORY_SCOPE_AGENT); }
__device__ __forceinline__ unsigned xb_xcc_id() { return (unsigned)__builtin_amdgcn_s_getreg((3 << 11) | 20) & 0xFu; }
#define XB_SPIN(cond, bar) do { unsigned _sp = 0; while (cond) { __builtin_amdgcn_s_sleep(1); \
    if ((++_sp & 255u) == 0u) { if (xb_ld(&(bar)[XB_TMO])) break; if (_sp > XB_SPIN_CAP) { atomicAdd(&(bar)[XB_TMO], 1u); break; } } } } while (0)

struct XcdBarrier {
    unsigned* bar; unsigned x;
    volatile LAS unsigned* st;
};

__device__ __forceinline__ XcdBarrier xcd_barrier_post(unsigned* bar, volatile LAS unsigned* st) {
    XcdBarrier b; b.bar = bar; b.x = xb_xcc_id(); b.st = st;
    if (threadIdx.x == 0) (void)xb_add(&bar[XB_XCNT(b.x)], 1u);
    return b;
}
__device__ __forceinline__ void xcd_barrier_complete(unsigned* bar, unsigned x, unsigned& nloc, unsigned& nx) {
    const unsigned G = gridDim.x * gridDim.y * gridDim.z;
    unsigned sum, cnt, mine, sp = 0u;
    for (;;) {
        sum = 0u; cnt = 0u; mine = 0u;
#pragma unroll
        for (unsigned j = 0; j < 16; ++j) { const unsigned c = xb_ld(&bar[XB_XCNT(j)]); sum += c; cnt += (c > 0u) ? 1u : 0u; mine = (j == x) ? c : mine; }
        if (sum == G) break;
        __builtin_amdgcn_s_sleep(1);
        if ((++sp & 255u) == 0u) { if (xb_ld(&bar[XB_TMO])) break; if (sp > XB_SPIN_CAP) { atomicAdd(&bar[XB_TMO], 1u); break; } }
    }
    nloc = mine > 0u ? mine : 1u; nx = cnt > 0u ? cnt : 1u;
}

__device__ __forceinline__ void xcd_barrier(const XcdBarrier& b) {
    asm volatile("s_waitcnt vmcnt(0)" ::: "memory");
    __syncthreads();
    if (threadIdx.x == 0) {
        unsigned* bar = b.bar;
        __builtin_amdgcn_s_waitcnt(0);
        unsigned nloc = b.st[0], nx = b.st[1];
        if (nloc == 0u) { xcd_barrier_complete(bar, b.x, nloc, nx); b.st[0] = nloc; b.st[1] = nx; }
        const unsigned old = xb_add(&bar[XB_XSUB(b.x)], 1u);
        const unsigned gen = old / nloc;
        if (old + 1u == (gen + 1u) * nloc) {
            __builtin_amdgcn_fence(__ATOMIC_RELEASE, "agent");
            asm volatile("s_waitcnt vmcnt(0)" ::: "memory");
            const unsigned og = xb_add(&bar[XB_TOP], 1u);
            const unsigned tg = og / nx;
            if (og + 1u == (tg + 1u) * nx) xb_add(&bar[XB_TOPGEN], 1u);
            else XB_SPIN(xb_ld(&bar[XB_TOPGEN]) == tg, bar);
            __builtin_amdgcn_fence(__ATOMIC_ACQUIRE, "agent");
            xb_add(&bar[XB_XGEN(b.x)], 1u);
            asm volatile("s_waitcnt vmcnt(0)" ::: "memory");
        } else {
            XB_SPIN(xb_ld(&bar[XB_XGEN(b.x)]) == gen, bar);
            __builtin_amdgcn_fence(__ATOMIC_ACQUIRE, "agent");
            asm volatile("s_waitcnt vmcnt(0)" ::: "memory");
        }
    }
    __syncthreads();
}

#ifndef REP_UP
#define REP_UP 1
#endif
#ifndef REP_P0
#define REP_P0 1
#endif
#ifndef REP_CMP
#define REP_CMP 1
#endif
#ifndef REP_ATTN
#define REP_ATTN 1
#endif
#ifndef REP_MLL
#define REP_MLL 1
#endif
#ifndef REP_MLO
#define REP_MLO 1
#endif
__global__ void __launch_bounds__(NTHR, 2) fwd_kernel(Args args) {
    extern __shared__ __attribute__((aligned(16))) unsigned char lds_raw[];
    LAS unsigned char* lds = (LAS unsigned char*)lds_raw;
    cg::grid_group grid = cg::this_grid();
    volatile LAS unsigned* bar_st = (volatile LAS unsigned*)(lds + LDS_BYTES - 64);
    if (threadIdx.x == 0) { bar_st[0] = 0u; bar_st[1] = 0u; }
    __syncthreads();
    XcdBarrier xbar; xbar.bar = (unsigned*)(args.ws + WS_MISC); xbar.x = 0; xbar.st = nullptr;
    if (args.ph_hi - args.ph_lo > 1) xbar = xcd_barrier_post((unsigned*)(args.ws + WS_MISC), bar_st);
    const int wave0 = __builtin_amdgcn_readfirstlane((int)(threadIdx.x >> 6));
    const int G0 = gridDim.x, bid0 = blockIdx.x;
    const int lo = args.ph_lo, hi = args.ph_hi;
#define X (args.out)
#define XN ((bf16_t*)(ws + WS_XN))
#define XBS ((bf16_t*)(ws + WS_XB))
#define Yb ((bf16_t*)(ws + WS_XN))
#define PROJ ((bf16_t*)(ws + WS_PROJ))
#define Hb ((bf16_t*)(ws + WS_PROJ))
#define nb (ws + WS_NSAW + j * NSAW_STRIDE)
#define mb (ws + WS_MLW + j * MLW_STRIDE)
#define KS ((bf16_t*)(ws + WS_EXT + EXT_KS))
#define KW ((bf16_t*)(ws + WS_EXT + EXT_KW))
#define VTS ((bf16_t*)(ws + WS_EXT + EXT_VTS))
#define VTW ((bf16_t*)(ws + WS_EXT + EXT_VTW))
#define KC ((bf16_t*)(ws + WS_EXT + EXT_KC))
#define VTC ((bf16_t*)(ws + WS_EXT + EXT_VTC))
#define CT ((bf16_t*)(ws + WS_EXT + EXT_CT))
#define NT ((float*)(ws + WS_EXT + EXT_NT))
#define CI ((float*)(ws + WS_EXT + EXT_CI))
#define MC ((float*)(ws + WS_EXT + EXT_MC))
#define bif (args.in[13] + j * 16)
    int ph = 0;
#define PHASE_BEGIN if (lo <= ph && ph < hi) { int bid = bid0, G = G0; asm volatile("" : "+s"(bid), "+s"(G)); const int NGW = G * NWAVES; int tid = wave0 * 64 + (int)__builtin_amdgcn_mbcnt_hi(~0u, __builtin_amdgcn_mbcnt_lo(~0u, 0u)); asm volatile("" : "+v"(tid)); const int lane = tid & 63; const int wave = __builtin_amdgcn_readfirstlane(tid >> 6); const int gw = bid * NWAVES + wave; unsigned char* ws = args.ws; asm volatile("" : "+s"(ws));
#define PHASE_END if (ph + 1 < hi) { if (hi == 0x7fffffff) grid.sync(); else xcd_barrier(xbar); } } ++ph;

    PHASE_BEGIN
    {
        LAS float* scr = (LAS float*)(lds + wave * 17408);
        for (int rep_ = 0; rep_ < REP_P0; ++rep_) {
        int rot = 0;
#pragma unroll 1
        for (int l = 0; l < 4; ++l) {
            bf16_t* wgu = (bf16_t*)(ws + WS_FFN + l * FFN_STRIDE); bf16_t* wd = (bf16_t*)(ws + WS_FFN + l * FFN_STRIDE + FFN_WD);
            tr_matrix(args.in[16] + (size_t)l * D_ * DFF, D_, DFF, wgu, 1, 0, scr, gw, NGW, lane, rot);
            tr_matrix(args.in[17] + (size_t)l * D_ * DFF, D_, DFF, wgu, 1, 128, scr, gw, NGW, lane, rot);
            tr_matrix(args.in[18] + (size_t)l * DFF * D_, DFF, D_, wd, 0, 0, scr, gw, NGW, lane, rot);
        }
#pragma unroll 1
        for (int j = 0; j < 2; ++j) {
            tr_matrix(args.in[3] + (size_t)j * D_ * NSA_IN, D_, NSA_IN, (bf16_t*)nb, 0, 0, scr, gw, NGW, lane, rot);
            tr_matrix(args.in[11] + (size_t)j * D_ * D_, D_, D_, (bf16_t*)(nb + NSAW_OUT), 0, 0, scr, gw, NGW, lane, rot);
            tr_matrix(args.in[8] + (size_t)(j * 2 + 0) * 4096 * 128, 4096, 128, (bf16_t*)(nb + NSAW_W1), 0, 0, scr, gw, NGW, lane, rot);
            tr_matrix(args.in[8] + (size_t)(j * 2 + 1) * 4096 * 128, 4096, 128, (bf16_t*)(nb + NSAW_W1) + 128 * 4096, 0, 0, scr, gw, NGW, lane, rot);
            tr_matrix(args.in[10] + (size_t)(j * 2 + 0) * 128 * 128, 128, 128, (bf16_t*)(nb + NSAW_W2), 0, 0, scr, gw, NGW, lane, rot);
            tr_matrix(args.in[10] + (size_t)(j * 2 + 1) * 128 * 128, 128, 128, (bf16_t*)(nb + NSAW_W2) + 128 * 128, 0, 0, scr, gw, NGW, lane, rot);
            tr_matrix(args.in[12] + (size_t)j * D_ * ML_IN, D_, ML_IN, (bf16_t*)mb, 0, 0, scr, gw, NGW, lane, rot);
            tr_matrix(args.in[15] + (size_t)j * D_ * D_, D_, D_, (bf16_t*)(mb + MLW_OUT), 0, 0, scr, gw, NGW, lane, rot);
        }
        }
        rmsnorm_phase(args.in[0], args.in[1], XN, nullptr, gw, NGW, lane);
    }
    PHASE_END

#pragma unroll 1
    for (int i = 0; i < 4; ++i) {
        const int j = i >> 1;
        if (i > 0) {
            PHASE_BEGIN
            rmsnorm_bf16_phase(XBS, args.in[1] + i * D_, XN, gw, NGW, lane);
            PHASE_END
        }
        if ((i & 1) == 0) {
            PHASE_BEGIN
            for (int tb = bid; tb < 256; tb += G) gate_gemm<3>(XN, (const bf16_t*)nb + (size_t)5120 * D_, PROJ, NSA_N, 5120, tb, lds, tid, wave, lane);
            { pg8::Gemm g{XN, (const bf16_t*)nb, S_, 5120, D_}; pg8::StaticOrder So; So.init(S_, 5120, G, bid); pg8::EpiStore E{PROJ, NSA_N};
              pg8::gemm_phase<pg8::EpiStore, pg8::StaticOrder, true, true>(lds, g, So, E, tid); }
            PHASE_END
            PHASE_BEGIN
            for (int tb = bid; tb < 256; tb += G) nsa_prep_unit(tb, PROJ, args.in[5] + j * 128, args.in[6] + j * 384, KS, KW, VTS, VTW, tid);
            for (int rep_ = 0; rep_ < REP_CMP; ++rep_)
            for (int task = bid; task < 256; task += G)
                nsa_compress_unit(task, PROJ, args.in[7] + (size_t)j * 2 * 32 * 128, (const bf16_t*)(nb + NSAW_W1), args.in[9] + j * 256, (const bf16_t*)(nb + NSAW_W2), args.in[6] + j * 384, KC, VTC, lds, tid, wave, lane);
            PHASE_END
            PHASE_BEGIN
            for (int rep_ = 0; rep_ < REP_ATTN; ++rep_)
            for (int task = bid; task < 1024; task += G) {
                const int k = task >> 8, bb = task & 255, xg = bb & 3, half = (bb >> 2) & 1, wi = bb >> 3;
                const int qb = half == 0 ? (k == 0 ? wi : k == 1 ? 127 - wi : k == 2 ? 128 + wi : 255 - wi) : (k == 0 ? 32 + wi : k == 1 ? 95 - wi : k == 2 ? 160 + wi : 223 - wi);
                nsa_attn_wg(qb, xg, PROJ, args.in[4] + j * 48, KC, VTC, KS, VTS, KW, VTW, Yb, lds, tid, wave, lane);
            }
            PHASE_END
            PHASE_BEGIN
            { pg8::Gemm g{Yb, (const bf16_t*)(nb + NSAW_OUT), S_, D_, D_}; pg8::StaticOrder So; So.init(S_, D_, G, bid); pg8::EpiResid E{i == 0 ? args.in[0] : (const float*)nullptr, XBS, nullptr, D_};
              pg8::gemm_phase<pg8::EpiResid, pg8::StaticOrder, true, true>(lds, g, So, E, tid); }
            PHASE_END
        } else {
            PHASE_BEGIN
            for (int tb = bid; tb < 256; tb += G) gate_gemm<1>(XN, (const bf16_t*)mb + (size_t)6144 * D_, PROJ, ML_N, 6144, tb, lds, tid, wave, lane);
            { pg8::Gemm g{XN, (const bf16_t*)mb, S_, 6144, D_}; pg8::StaticOrder So; So.init(S_, 6144, G, bid); pg8::EpiStore E{PROJ, ML_N};
              pg8::gemm_phase<pg8::EpiStore, pg8::StaticOrder, true, true>(lds, g, So, E, tid); }
            PHASE_END
            PHASE_BEGIN
            ml_local_phase(bid, G, PROJ, bif, CT, NT, CI, lds, tid, wave, lane);
            PHASE_END
            PHASE_BEGIN
            for (int u = bid; u < 256; u += G) ml_scan_unit(u, CT, NT, CI, MC, lds, tid);
            PHASE_END
            PHASE_BEGIN
            for (int rep_ = 0; rep_ < REP_MLO; ++rep_)
            for (int u = bid; u < 2048; u += G) ml_out_unit(u, PROJ, bif, args.in[14] + j * D_, CT, NT, MC, Yb, lds, tid, wave, lane);
            PHASE_END
            PHASE_BEGIN
            { pg8::Gemm g{Yb, (const bf16_t*)(mb + MLW_OUT), S_, D_, D_}; pg8::StaticOrder So; So.init(S_, D_, G, bid); pg8::EpiResid E{nullptr, XBS, nullptr, D_};
              pg8::gemm_phase<pg8::EpiResid, pg8::StaticOrder, true, true>(lds, g, So, E, tid); }
            PHASE_END
        }
        PHASE_BEGIN
        rmsnorm_bf16_phase(XBS, args.in[2] + i * D_, XN, gw, NGW, lane);
        PHASE_END
        PHASE_BEGIN
        for (int rep_ = 0; rep_ < REP_UP; ++rep_)
        { pg8::Gemm g{XN, (const bf16_t*)(ws + WS_FFN + i * FFN_STRIDE), S_, 2 * DFF, D_}; pg8::StaticOrder So; So.init(S_, 2 * DFF, G, bid); pg8::EpiSwiglu E{Hb, DFF};
          pg8::gemm_phase<pg8::EpiSwiglu, pg8::StaticOrder, true, true>(lds, g, So, E, tid); }
        PHASE_END
        PHASE_BEGIN
        { pg8::Gemm g{Hb, (const bf16_t*)(ws + WS_FFN + i * FFN_STRIDE + FFN_WD), S_, D_, DFF}; pg8::StaticOrder So; So.init(S_, D_, G, bid); pg8::EpiResid E{nullptr, XBS, i == 3 ? X : (float*)nullptr, D_};
          pg8::gemm_phase<pg8::EpiResid, pg8::StaticOrder, true, true>(lds, g, So, E, tid); }
        PHASE_END
    }
}

#ifndef ONE_LAUNCH
#define ONE_LAUNCH 0
#endif
extern "C" void kernel_launch(void* const* d_in, const int* in_sizes, int n_in, void* d_out, int out_size, void* d_ws, size_t ws_size, hipStream_t stream) {
    static int grid = 0;
    if (grid == 0) {
        if (n_in != 19 || out_size != S_ * D_ || ws_size < WS_END) { fprintf(stderr, "kernel_launch: unexpected shapes n_in %d out %d ws %zu\n", n_in, out_size, ws_size); grid = -1; return; }
        int dev = 0, cus = 0, per_cu = 0;
        hipGetDevice(&dev); hipDeviceGetAttribute(&cus, hipDeviceAttributeMultiprocessorCount, dev);
        if (hipFuncSetAttribute((const void*)fwd_kernel, hipFuncAttributeMaxDynamicSharedMemorySize, LDS_BYTES) != hipSuccess) { fprintf(stderr, "kernel_launch: hipFuncSetAttribute failed\n"); grid = -1; return; }
        if (hipOccupancyMaxActiveBlocksPerMultiprocessor(&per_cu, (const void*)fwd_kernel, NTHR, LDS_BYTES) != hipSuccess || per_cu < 1) { fprintf(stderr, "kernel_launch: occupancy query says %d\n", per_cu); per_cu = 1; }
        (void)hipGetLastError();
        grid = cus;
        if (grid != 256) fprintf(stderr, "kernel_launch: %d CUs\n", grid);
    }
    if (grid < 0) return;
    Args a{};
    for (int i = 0; i < 19; ++i) a.in[i] = (const float*)d_in[i];
    a.out = (float*)d_out; a.ws = (unsigned char*)d_ws;
#if ONE_LAUNCH
    if (hipMemsetAsync((char*)d_ws + WS_MISC, 0, 16384, stream) != hipSuccess) { fprintf(stderr, "kernel_launch: memset failed\n"); return; }
    a.ph_lo = 0; a.ph_hi = NPH;
    void* kargs[] = {&a};
    hipError_t e = hipLaunchCooperativeKernel((const void*)fwd_kernel, dim3(grid), dim3(NTHR), kargs, LDS_BYTES, stream);
    if (e != hipSuccess) fprintf(stderr, "cooperative launch failed: %s (grid %d)\n", hipGetErrorString(e), grid);
#else
    for (int p = 0; p < NPH; ++p) {
        a.ph_lo = p; a.ph_hi = p + 1;
        hipLaunchKernelGGL(fwd_kernel, dim3(grid), dim3(NTHR), LDS_BYTES, stream, a);
    }
#endif
}
```

```cpp
#include <hip/hip_runtime.h>
#include <hip/hip_cooperative_groups.h>
#include <cstdio>
#include <cstdint>
#define ONE_LAUNCH 1
namespace pg8 {
#define PG8_LAS __attribute__((address_space(3)))
typedef unsigned short bf16_t;
typedef short bf16x8 __attribute__((ext_vector_type(8)));
typedef float f32x4 __attribute__((ext_vector_type(4)));
typedef unsigned u32x4 __attribute__((ext_vector_type(4)));
constexpr int BM = 256, BK = 64, HALF = 128, HTB = HALF * BK * 2  , STAGE_BYTES = 8 * HTB, NXCD = 8, WGM = 2;

__host__ __device__ __forceinline__ int lds_byte(int r, int c) { const int st = (r >> 4) * 2 + (c >> 5), rr = r & 15, cc = c & 31, ob = rr * 64 + cc * 2; return st * 1024 + (ob ^ (((ob >> 9) & 1) << 5)); }
__host__ __device__ __forceinline__ void stage_rc(int b, int& R, int& C) { const int st = b / 1024, sb = b % 1024, swz = sb ^ (((sb >> 9) & 1) << 5); R = (st >> 1) * 16 + swz / 64; C = (st & 1) * 32 + (swz % 64) / 2; }
__host__ __device__ __forceinline__ int perm32(int rho) { const int n = rho >> 4, i = rho & 15; return 8 * (i >> 2) + 4 * n + (i & 3); }

struct Unit { int pm, pn; };
struct Gemm { const bf16_t* A; const bf16_t* Bt; int M, N, K; };

struct StaticOrder {
    int nM, nN, nwg, G, c;
    __host__ __device__ void init(int M, int N, int G_, int c_) { nM = M / BM; nN = N / BM; nwg = nM * nN; G = G_; c = c_; }
    __host__ __device__ bool next(int i, Unit& u) const {
        const long L = (long)i * G + c; if (L >= nwg) return false;
        int wgid = (int)L; { const int q = nwg / NXCD, r = nwg % NXCD, xcd = wgid % NXCD, off = wgid / NXCD; wgid = (xcd < r ? xcd * (q + 1) : r * (q + 1) + (xcd - r) * q) + off; }
        const int nig = WGM * nN, gid = wgid / nig, fm = gid * WGM, gsz = (nM - fm) < WGM ? (nM - fm) : WGM;
        u.pm = fm + ((wgid % nig) % gsz); u.pn = (wgid % nig) / gsz; return true;
    }
    __device__ __forceinline__ void a_ready(const Unit&) const {}
    __device__ __forceinline__ void done(const Unit&) const {}
};
__device__ __forceinline__ unsigned cvt_pk_bf16(float lo, float hi) { unsigned r; asm volatile("v_cvt_pk_bf16_f32 %0, %1, %2" : "=v"(r) : "v"(lo), "v"(hi)); return r; }
typedef float f32x2e __attribute__((ext_vector_type(2))); typedef unsigned u32x2e __attribute__((ext_vector_type(2))); typedef __bf16 bf16x2e __attribute__((ext_vector_type(2)));
__device__ __forceinline__ unsigned pk2(float lo, float hi) { f32x2e v = {lo, hi}; bf16x2e b = __builtin_convertvector(v, bf16x2e); return __builtin_bit_cast(unsigned, b); }
struct EpiStore {
    static constexpr bool PERM = true, AFTER_DRAIN = false;
    bf16_t* O; int ldc;
    __device__ __forceinline__ void operator()(const f32x4 (&acc)[2][2][4][2], const Unit& u, int wr, int wc, int fr, int fq) const {
        const int row0 = u.pm * BM + wr * 64 + fr, col0 = u.pn * BM + wc * 32 + 8 * fq;
#pragma unroll
        for (int ai = 0; ai < 2; ++ai)
#pragma unroll
            for (int m = 0; m < 4; ++m) { bf16_t* rowp = O + (size_t)(row0 + ai * HALF + m * 16) * ldc + col0;
#pragma unroll
                for (int bj = 0; bj < 2; ++bj) { const f32x4 v0 = acc[ai][bj][m][0], v1 = acc[ai][bj][m][1];
                    u32x4 w; w.x = pk2(v0[0], v0[1]); w.y = pk2(v0[2], v0[3]); w.z = pk2(v1[0], v1[1]); w.w = pk2(v1[2], v1[3]);
                    *(u32x4*)(rowp + bj * HALF) = w; } }
    }
};
struct EpiSwiglu {
    static constexpr bool PERM = true, AFTER_DRAIN = false;
    bf16_t* H; int ldc;
    __device__ __forceinline__ void operator()(const f32x4 (&acc)[2][2][4][2], const Unit& u, int wr, int wc, int fr, int fq) const {
        const int row0 = u.pm * BM + wr * 64 + fr, col0 = u.pn * HALF + wc * 32 + 8 * fq;
#pragma unroll
        for (int ai = 0; ai < 2; ++ai)
#pragma unroll
            for (int m = 0; m < 4; ++m) { bf16_t* rowp = H + (size_t)(row0 + ai * HALF + m * 16) * ldc + col0;
                float h[8];
#pragma unroll
                for (int n = 0; n < 2; ++n)
#pragma unroll
                    for (int e = 0; e < 4; ++e) { const float g = acc[ai][0][m][n][e], up = acc[ai][1][m][n][e];
                        h[n * 4 + e] = g * up * __builtin_amdgcn_rcpf(1.0f + __builtin_amdgcn_exp2f(-1.4426950408889634f * g)); }
                u32x4 w; w.x = pk2(h[0], h[1]); w.y = pk2(h[2], h[3]); w.z = pk2(h[4], h[5]); w.w = pk2(h[6], h[7]);
                *(u32x4*)rowp = w; }
    }
};
struct EpiResid {
    static constexpr bool PERM = true, AFTER_DRAIN = false;
    const float* Xf_in; bf16_t* Xb; float* Xf_out; int ldc;
    __device__ __forceinline__ void operator()(const f32x4 (&acc)[2][2][4][2], const Unit& u, int wr, int wc, int fr, int fq) const {
        const int row0 = u.pm * BM + wr * 64 + fr, col0 = u.pn * BM + wc * 32 + 8 * fq;
#pragma unroll
        for (int ai = 0; ai < 2; ++ai)
#pragma unroll
            for (int mp = 0; mp < 2; ++mp) {
                f32x4 pre[2][2][2];
#pragma unroll
                for (int mm = 0; mm < 2; ++mm) { const size_t off = (size_t)(row0 + ai * HALF + (2 * mp + mm) * 16) * ldc + col0;
#pragma unroll
                    for (int bj = 0; bj < 2; ++bj) {
                        if (Xf_in) { pre[mm][bj][0] = *(const f32x4*)(Xf_in + off + bj * HALF); pre[mm][bj][1] = *(const f32x4*)(Xf_in + off + bj * HALF + 4); }
                        else { const u32x4 w = *(const u32x4*)(Xb + off + bj * HALF);
                               pre[mm][bj][0] = (f32x4){__uint_as_float(w.x << 16), __uint_as_float(w.x & 0xffff0000u), __uint_as_float(w.y << 16), __uint_as_float(w.y & 0xffff0000u)};
                               pre[mm][bj][1] = (f32x4){__uint_as_float(w.z << 16), __uint_as_float(w.z & 0xffff0000u), __uint_as_float(w.w << 16), __uint_as_float(w.w & 0xffff0000u)}; } } }
#pragma unroll
                for (int mm = 0; mm < 2; ++mm) { const size_t off = (size_t)(row0 + ai * HALF + (2 * mp + mm) * 16) * ldc + col0;
#pragma unroll
                    for (int bj = 0; bj < 2; ++bj) { const f32x4 v0 = pre[mm][bj][0] + acc[ai][bj][2 * mp + mm][0], v1 = pre[mm][bj][1] + acc[ai][bj][2 * mp + mm][1];
                        u32x4 w; w.x = pk2(v0[0], v0[1]); w.y = pk2(v0[2], v0[3]); w.z = pk2(v1[0], v1[1]); w.w = pk2(v1[2], v1[3]); *(u32x4*)(Xb + off + bj * HALF) = w;
                        if (Xf_out) { *(f32x4*)(Xf_out + off + bj * HALF) = v0; *(f32x4*)(Xf_out + off + bj * HALF + 4) = v1; } } }
                asm volatile("" ::: "memory");
            }
    }
};
template <class Epi, class Sched, bool ALIGN_EPI = false, bool SP2 = false>
__device__ __forceinline__ void gemm_phase(PG8_LAS unsigned char* lds, const Gemm g, const Sched& S, const Epi& E, int tid_in) {
    int tid_l = tid_in; asm volatile("" : "+v"(tid_l)); const int tid = tid_l, wid = __builtin_amdgcn_readfirstlane(tid >> 6), lane = tid & 63, wr = wid >> 2, wc = wid & 3, fr = lane & 15, fq = lane >> 4;
    const int K = g.K, nt = K / BK;
    unsigned voffA[2], voffB[2];
#pragma unroll
    for (int i = 0; i < 2; ++i) { int R, C; stage_rc(tid * 16 + i * 8192, R, C); const int Rb = Epi::PERM ? ((R & ~31) + perm32(R & 31)) : R;
        voffA[i] = (unsigned)(R * K + C) * 2u; voffB[i] = (unsigned)(Rb * K + C) * 2u; }
    const size_t kstep = (size_t)(BK * 2);
    const size_t hstep = (size_t)HALF * K * 2;
    const size_t tstep = 2 * hstep;
    const unsigned ldsw = (unsigned)wid * 1024u;
    const int aoff = lds_byte(wr * 64 + fr, fq * 8), boff = lds_byte(wc * 32 + fr, fq * 8);
#define PG8_SA(b, h) (((b) * 2 + (h)) * HTB)
#define PG8_SB(b, h) ((4 + (b) * 2 + (h)) * HTB)
#define PG8_STAGE(bufoff, gbase, voff) do { _Pragma("unroll") for (int _i = 0; _i < 2; ++_i) \
        __builtin_amdgcn_global_load_lds((const unsigned*)((const char*)(gbase) + (voff)[_i]), (PG8_LAS unsigned*)(lds + (bufoff) + ldsw + _i * 8192), 16, 0, 0); } while (0)
#define PG8_LDA(dst, b, h) do { _Pragma("unroll") for (int m = 0; m < 4; ++m) _Pragma("unroll") for (int k = 0; k < 2; ++k) dst[m][k] = *(const PG8_LAS bf16x8*)(lds + PG8_SA(b, h) + aoff + m * 2048 + k * 1024); } while (0)
#define PG8_LDB(dst, b, h) do { _Pragma("unroll") for (int n = 0; n < 2; ++n) _Pragma("unroll") for (int k = 0; k < 2; ++k) dst[n][k] = *(const PG8_LAS bf16x8*)(lds + PG8_SB(b, h) + boff + n * 2048 + k * 1024); } while (0)
#define PG8_MMA(ai, bj, At, Bt) do { __builtin_amdgcn_s_setprio(1); _Pragma("unroll") for (int m = 0; m < 4; ++m) _Pragma("unroll") for (int n = 0; n < 2; ++n) _Pragma("unroll") for (int k = 0; k < 2; ++k) \
        acc[ai][bj][m][n] = __builtin_amdgcn_mfma_f32_16x16x32_bf16(Bt[n][k], At[m][k], acc[ai][bj][m][n], 0, 0, 0); __builtin_amdgcn_s_setprio(0); } while (0)
#define PG8_WAIT_V(n) asm volatile("s_waitcnt vmcnt(" #n ")" ::: "memory")
#define PG8_WAIT_L(n) asm volatile("s_waitcnt lgkmcnt(" #n ")" ::: "memory")
#define PG8_BAR __builtin_amdgcn_s_barrier()
#define PG8_SCHED __builtin_amdgcn_sched_barrier(0)
    Unit cur, nxt; int ui = 0;
    if (!S.next(0, cur)) return;
    f32x4 acc[2][2][4][2];
#pragma unroll
    for (int a = 0; a < 2; ++a)
#pragma unroll
        for (int b = 0; b < 2; ++b)
#pragma unroll
            for (int m = 0; m < 4; ++m)
#pragma unroll
                for (int n = 0; n < 2; ++n) acc[a][b][m][n] = (f32x4){0.f, 0.f, 0.f, 0.f};
    bf16x8 At[4][2], B0[2][2], B1[2][2];
    const char* cA = (const char*)g.A + (size_t)cur.pm * tstep; const char* cB = (const char*)g.Bt + (size_t)cur.pn * tstep;
    S.a_ready(cur);
    if constexpr (SP2) {
        PG8_STAGE(PG8_SB(0, 0), cB, voffB); PG8_STAGE(PG8_SB(0, 1), cB + hstep, voffB); PG8_STAGE(PG8_SA(0, 0), cA, voffA); PG8_STAGE(PG8_SA(0, 1), cA + hstep, voffA);
        if (wr == 1) PG8_BAR;
        PG8_WAIT_V(2); PG8_BAR;
        PG8_STAGE(PG8_SB(1, 0), cB + kstep, voffB); PG8_STAGE(PG8_SA(1, 0), cA + kstep, voffA); PG8_STAGE(PG8_SB(1, 1), cB + hstep + kstep, voffB);
        PG8_WAIT_V(6); PG8_BAR;
    } else {
        PG8_STAGE(PG8_SB(0, 0), cB, voffB); PG8_STAGE(PG8_SA(0, 0), cA, voffA); PG8_STAGE(PG8_SB(0, 1), cB + hstep, voffB); PG8_STAGE(PG8_SA(0, 1), cA + hstep, voffA);
        if (wr == 1) PG8_BAR;
        PG8_WAIT_V(4); PG8_BAR;
        PG8_STAGE(PG8_SB(1, 0), cB + kstep, voffB); PG8_STAGE(PG8_SA(1, 0), cA + kstep, voffA); PG8_STAGE(PG8_SB(1, 1), cB + hstep + kstep, voffB);
        PG8_WAIT_V(6); PG8_BAR;
    }
    for (;;) {
        const bool has_next = S.next(ui + 1, nxt);
        const char* nA = has_next ? (const char*)g.A + (size_t)nxt.pm * tstep : cA; const char* nB = has_next ? (const char*)g.Bt + (size_t)nxt.pn * tstep : cB;
        for (int t = 0; t < nt; t += 2) {
            const bool last = (t == nt - 2);
            const char* a1 = cA + (size_t)(t + 1) * kstep;
            const char* a2 = last ? nA : cA + (size_t)(t + 2) * kstep; const char* b2 = last ? nB : cB + (size_t)(t + 2) * kstep;
            const char* a3 = a2 + kstep; const char* b3 = b2 + kstep;
            if (last && has_next) S.a_ready(nxt);
            if constexpr (SP2) {
            PG8_LDB(B0, 0, 0); PG8_LDB(B1, 0, 1); PG8_SCHED; PG8_LDA(At, 0, 0); PG8_STAGE(PG8_SA(1, 1), a1 + hstep, voffA);
            PG8_WAIT_V(8); PG8_WAIT_L(0); PG8_BAR; PG8_MMA(0, 0, At, B0); PG8_MMA(0, 1, At, B1); PG8_BAR; PG8_SCHED;
            PG8_LDA(At, 0, 1); PG8_STAGE(PG8_SB(0, 0), b2, voffB); PG8_STAGE(PG8_SB(0, 1), b2 + hstep, voffB); PG8_STAGE(PG8_SA(0, 0), a2, voffA);
            PG8_WAIT_V(8); PG8_WAIT_L(0); PG8_BAR; PG8_MMA(1, 0, At, B0); PG8_MMA(1, 1, At, B1); PG8_BAR; PG8_SCHED;
            PG8_LDB(B0, 1, 0); PG8_LDB(B1, 1, 1); PG8_SCHED; PG8_LDA(At, 1, 0); PG8_STAGE(PG8_SA(0, 1), a2 + hstep, voffA);
            PG8_WAIT_V(8); PG8_WAIT_L(0); PG8_BAR; PG8_MMA(0, 0, At, B0); PG8_MMA(0, 1, At, B1); PG8_BAR; PG8_SCHED;
            PG8_LDA(At, 1, 1); PG8_STAGE(PG8_SB(1, 0), b3, voffB); PG8_STAGE(PG8_SB(1, 1), b3 + hstep, voffB); PG8_STAGE(PG8_SA(1, 0), a3, voffA);
            PG8_WAIT_V(8); PG8_WAIT_L(0); PG8_BAR; PG8_MMA(1, 0, At, B0); PG8_MMA(1, 1, At, B1); PG8_BAR; PG8_SCHED;
            } else {
            PG8_LDB(B0, 0, 0); PG8_SCHED; PG8_LDA(At, 0, 0); PG8_STAGE(PG8_SA(1, 1), a1 + hstep, voffA);
            PG8_WAIT_L(8); PG8_BAR; PG8_WAIT_L(0); PG8_MMA(0, 0, At, B0); PG8_BAR; PG8_SCHED;
            PG8_LDB(B1, 0, 1); PG8_STAGE(PG8_SB(0, 0), b2, voffB);
            PG8_BAR; PG8_WAIT_L(0); PG8_MMA(0, 1, At, B1); PG8_BAR;
            PG8_LDA(At, 0, 1); PG8_STAGE(PG8_SA(0, 0), a2, voffA);
            PG8_BAR; PG8_WAIT_L(0); PG8_MMA(1, 0, At, B0); PG8_BAR; PG8_SCHED;
            PG8_STAGE(PG8_SB(0, 1), b2 + hstep, voffB);
            PG8_WAIT_V(6); PG8_BAR; PG8_MMA(1, 1, At, B1); PG8_BAR;
            PG8_LDB(B0, 1, 0); PG8_SCHED; PG8_LDA(At, 1, 0); PG8_STAGE(PG8_SA(0, 1), a2 + hstep, voffA);
            PG8_WAIT_L(8); PG8_BAR; PG8_WAIT_L(0); PG8_MMA(0, 0, At, B0); PG8_BAR; PG8_SCHED;
            PG8_LDB(B1, 1, 1); PG8_STAGE(PG8_SB(1, 0), b3, voffB);
            PG8_BAR; PG8_WAIT_L(0); PG8_MMA(0, 1, At, B1); PG8_BAR;
            PG8_LDA(At, 1, 1); PG8_STAGE(PG8_SA(1, 0), a3, voffA);
            PG8_BAR; PG8_WAIT_L(0); PG8_MMA(1, 0, At, B0); PG8_BAR; PG8_SCHED;
            PG8_STAGE(PG8_SB(1, 1), b3 + hstep, voffB);
            PG8_WAIT_V(6); PG8_BAR; PG8_MMA(1, 1, At, B1); PG8_BAR;
            }
        }
        if constexpr (ALIGN_EPI) { if (wr == 0) PG8_BAR; }
        if constexpr (!Epi::AFTER_DRAIN) { E(acc, cur, wr, wc, fr, fq); S.done(cur); }
        if (!has_next) break;
#pragma unroll
        for (int a = 0; a < 2; ++a)
#pragma unroll
            for (int b = 0; b < 2; ++b)
#pragma unroll
                for (int m = 0; m < 4; ++m)
#pragma unroll
                    for (int n = 0; n < 2; ++n) acc[a][b][m][n] = (f32x4){0.f, 0.f, 0.f, 0.f};
        cur = nxt; cA = nA; cB = nB; ++ui;
        if constexpr (ALIGN_EPI) { if (wr == 1) PG8_BAR; }
    }
    PG8_WAIT_V(0);
    if constexpr (!ALIGN_EPI) { if (wr == 0) PG8_BAR; }
    PG8_BAR;
    if constexpr (Epi::AFTER_DRAIN) { E.fused(acc, cur, wr, wc, fr, fq, lds, wid, lane); S.done(cur); }
#undef PG8_SA
#undef PG8_SB
#undef PG8_STAGE
#undef PG8_LDA
#undef PG8_LDB
#undef PG8_MMA
#undef PG8_WAIT_V
#undef PG8_WAIT_L
#undef PG8_BAR
#undef PG8_SCHED
}
}
namespace cg = cooperative_groups;
#define LAS __attribute__((address_space(3)))
typedef unsigned short bf16_t;
typedef short bf16x8 __attribute__((ext_vector_type(8)));
typedef float f32x4 __attribute__((ext_vector_type(4)));
typedef unsigned u32x4 __attribute__((ext_vector_type(4)));
typedef unsigned u32x2 __attribute__((ext_vector_type(2)));
#define MFMA16(a, b, c) __builtin_amdgcn_mfma_f32_16x16x32_bf16((a), (b), (c), 0, 0, 0)
using pg8::pk2;

constexpr int S_ = 16384, D_ = 2048, DFF = 5632;
constexpr int NSA_N = 5376, NSA_IN = 5168, ML_N = 6400, ML_IN = 6160;
constexpr float EPS = 1e-6f;
constexpr float QSCALE = 0.08838834764831845f * 1.4426950408889634f;
constexpr float NEG = -1e30f;
constexpr int NWAVES = 8, NTHR = 512, LDS_BYTES = 147456;
constexpr int NPH = 34;

constexpr size_t MiB = 1u << 20;
constexpr size_t WS_MISC = 0, WS_FFN = 1 * MiB, WS_NSAW = 265 * MiB, WS_MLW = 329 * MiB, WS_XN = 400 * MiB, WS_PROJ = 464 * MiB, WS_EXT = 664 * MiB, WS_XB = 800 * MiB, WS_END = 864 * MiB;
constexpr size_t FFN_STRIDE = 66 * MiB, FFN_WD = 44 * MiB;
constexpr size_t NSAW_STRIDE = 32 * MiB, NSAW_OUT = 21 * MiB, NSAW_W1 = 29 * MiB, NSAW_W2 = 31 * MiB;
constexpr size_t MLW_STRIDE = 34 * MiB, MLW_OUT = 25 * MiB;
constexpr size_t EXT_KS = 0, EXT_KW = 16 * MiB, EXT_VTS = 32 * MiB, EXT_VTW = 48 * MiB, EXT_KC = 64 * MiB, EXT_VTC = 65 * MiB;
constexpr size_t EXT_CT = 0, EXT_NT = 128 * MiB, EXT_CI = 129 * MiB, EXT_MC = 129 * MiB + 65536;

struct Args { const float* in[19]; float* out; unsigned char* ws; int ph_lo, ph_hi; };

__device__ __forceinline__ float bf2f(unsigned short b) { return __uint_as_float(((unsigned)b) << 16); }
__device__ __forceinline__ float bflo(unsigned w) { return __uint_as_float(w << 16); }
__device__ __forceinline__ float bfhi(unsigned w) { return __uint_as_float(w & 0xffff0000u); }
__device__ __forceinline__ float wave_sum(float v) {
#pragma unroll
    for (int o = 1; o < 64; o <<= 1) v += __shfl_xor(v, o);
    return v;
}
__device__ __forceinline__ float wave_max(float v) {
#pragma unroll
    for (int o = 1; o < 64; o <<= 1) v = fmaxf(v, __shfl_xor(v, o));
    return v;
}
__device__ __forceinline__ float quad_sum(float v) {
    v += __builtin_bit_cast(float, __builtin_amdgcn_mov_dpp(__builtin_bit_cast(int, v), 0xB1, 0xF, 0xF, true));
    v += __builtin_bit_cast(float, __builtin_amdgcn_mov_dpp(__builtin_bit_cast(int, v), 0x4E, 0xF, 0xF, true));
    return v;
}
__device__ __forceinline__ float fq_sum(float v) { v += __shfl_xor(v, 16); v += __shfl_xor(v, 32); return v; }
__device__ __forceinline__ float fq_max(float v) { v = fmaxf(v, __shfl_xor(v, 16)); v = fmaxf(v, __shfl_xor(v, 32)); return v; }
__device__ __forceinline__ float ex2(float x) { return __builtin_amdgcn_exp2f(x); }
__device__ __forceinline__ float sigmoidf_(float x) { return __builtin_amdgcn_rcpf(1.0f + ex2(-1.4426950408889634f * x)); }

__device__ __forceinline__ void tr_item(const float* __restrict__ W, int K, int N, bf16_t* __restrict__ WT, int mode, int off, LAS float* scr, int item, int lane) {
    const int nblk = (N + 63) >> 6, kb = item / nblk, nb = item - kb * nblk, k0 = 64 * kb, n0 = 64 * nb;
    const int c4 = (lane & 15) * 4, nn = n0 + c4;
    f32x4 v[16];
#pragma unroll
    for (int i = 0; i < 16; ++i) { const int kk = 4 * i + (lane >> 4); v[i] = nn < N ? *(const f32x4*)(W + (size_t)(k0 + kk) * N + nn) : (f32x4){0.f, 0.f, 0.f, 0.f}; }
#pragma unroll
    for (int i = 0; i < 16; ++i) { const int kk = 4 * i + (lane >> 4); LAS float* d = scr + kk * 65 + c4; d[0] = v[i].x; d[1] = v[i].y; d[2] = v[i].z; d[3] = v[i].w; }
    asm volatile("s_waitcnt lgkmcnt(0)" ::: "memory");
    const int c = lane & 7;
#pragma unroll
    for (int j = 0; j < 8; ++j) { const int nl = (lane >> 3) + 8 * j, n = n0 + nl; const LAS float* s = scr + (8 * c) * 65 + nl;
        u32x4 o; o.x = pk2(s[0 * 65], s[1 * 65]); o.y = pk2(s[2 * 65], s[3 * 65]); o.z = pk2(s[4 * 65], s[5 * 65]); o.w = pk2(s[6 * 65], s[7 * 65]);
        const int drow = mode ? ((n >> 7) * 256 + (n & 127) + off) : (n + off);
        if (n < N) *(u32x4*)(WT + (size_t)drow * K + k0 + 8 * c) = o; }
    asm volatile("s_waitcnt lgkmcnt(0)" ::: "memory");
}
__device__ __forceinline__ void tr_matrix(const float* W, int K, int N, bf16_t* WT, int mode, int off, LAS float* scr, int gw, int NGW, int lane, int& rot) {
    const int nblk = (N + 63) >> 6, nitems = (K >> 6) * nblk;
    int first = gw - rot; if (first < 0) first += NGW;
    for (int it = first; it < nitems; it += NGW) tr_item(W, K, N, WT, mode, off, scr, it, lane);
    rot = (rot + nitems) % NGW;
}
__device__ __forceinline__ void rmsnorm_phase(const float* __restrict__ x, const float* __restrict__ g, bf16_t* __restrict__ XN, float* xcopy, int gw, int NGW, int lane) {
    for (int m = gw; m < S_; m += NGW) {
        const f32x4* xr = (const f32x4*)(x + (size_t)m * D_) + lane;
        f32x4 v[8]; float s = 0.f;
#pragma unroll
        for (int j = 0; j < 8; ++j) { v[j] = xr[64 * j]; s += (v[j].x * v[j].x + v[j].y * v[j].y) + (v[j].z * v[j].z + v[j].w * v[j].w); }
        s = wave_sum(s);
        const float rs = 1.0f / sqrtf(s * (1.0f / D_) + EPS);
        if (xcopy) {
            f32x4* xc = (f32x4*)(xcopy + (size_t)m * D_) + lane;
#pragma unroll
            for (int j = 0; j < 8; ++j) xc[64 * j] = v[j];
        }
        u32x2* o8 = (u32x2*)(XN + (size_t)m * D_) + lane;
#pragma unroll
        for (int j = 0; j < 8; ++j) { const f32x4 gg = ((const f32x4*)g)[lane + 64 * j]; u32x2 w; w.x = pk2(v[j].x * rs * gg.x, v[j].y * rs * gg.y); w.y = pk2(v[j].z * rs * gg.z, v[j].w * rs * gg.w); o8[64 * j] = w; }
    }
}

template <int NT>
__device__ __forceinline__ void gate_gemm(const bf16_t* __restrict__ XNp, const bf16_t* __restrict__ Wt, bf16_t* __restrict__ OUT, int ld, int col0, int tb, LAS unsigned char* lds, int tid, int wave, int lane) {
    const int fr = lane & 15, fq = lane >> 4, rt = wave & 3, kh = wave >> 2;
    const bf16_t* ap = XNp + (size_t)(64 * tb + 16 * rt + fr) * D_ + kh * 1024 + 8 * fq;
    const bf16_t* bp = Wt + (size_t)fr * D_ + kh * 1024 + 8 * fq;
    f32x4 acc[NT];
#pragma unroll
    for (int nt = 0; nt < NT; ++nt) acc[nt] = (f32x4){0.f, 0.f, 0.f, 0.f};
    for (int k0 = 0; k0 < 32; k0 += 4) {
        bf16x8 a[4], b[4][NT];
#pragma unroll
        for (int u = 0; u < 4; ++u) {
            a[u] = *(const bf16x8*)(ap + 32 * (k0 + u));
#pragma unroll
            for (int nt = 0; nt < NT; ++nt) b[u][nt] = *(const bf16x8*)(bp + (size_t)(16 * nt) * D_ + 32 * (k0 + u));
        }
#pragma unroll
        for (int u = 0; u < 4; ++u)
#pragma unroll
            for (int nt = 0; nt < NT; ++nt) acc[nt] = MFMA16(b[u][nt], a[u], acc[nt]);
    }
    LAS float* P = (LAS float*)lds;
#pragma unroll
    for (int nt = 0; nt < NT; ++nt) *(LAS f32x4*)(P + ((kh * 64 + 16 * rt + fr) * (NT * 16) + 16 * nt + 4 * fq)) = acc[nt];
    __syncthreads();
    for (int idx = tid; idx < 64 * NT * 16; idx += NTHR) {
        const int tok = idx / (NT * 16), n = idx - tok * (NT * 16);
        const float v = P[idx] + P[64 * NT * 16 + idx];
        OUT[(size_t)(64 * tb + tok) * ld + col0 + n] = (bf16_t)(pk2(v, v) & 0xffffu);
    }
    __syncthreads();
}

__device__ __forceinline__ void rmsnorm_bf16_phase(const bf16_t* __restrict__ x, const float* __restrict__ g, bf16_t* __restrict__ XN, int gw, int NGW, int lane) {
    for (int m = gw; m < S_; m += NGW) {
        const u32x4* xr = (const u32x4*)(x + (size_t)m * D_) + lane;
        u32x4 v[4]; float s = 0.f;
#pragma unroll
        for (int j = 0; j < 4; ++j) v[j] = xr[64 * j];
#pragma unroll
        for (int j = 0; j < 4; ++j) { const float a0 = bflo(v[j].x), a1 = bfhi(v[j].x), a2 = bflo(v[j].y), a3 = bfhi(v[j].y), a4 = bflo(v[j].z), a5 = bfhi(v[j].z), a6 = bflo(v[j].w), a7 = bfhi(v[j].w);
            s += ((a0 * a0 + a1 * a1) + (a2 * a2 + a3 * a3)) + ((a4 * a4 + a5 * a5) + (a6 * a6 + a7 * a7)); }
        s = wave_sum(s);
        const float rs = 1.0f / sqrtf(s * (1.0f / D_) + EPS);
        u32x4* o = (u32x4*)(XN + (size_t)m * D_) + lane;
#pragma unroll
        for (int j = 0; j < 4; ++j) { const f32x4 g0 = ((const f32x4*)g)[2 * (lane + 64 * j)], g1 = ((const f32x4*)g)[2 * (lane + 64 * j) + 1];
            u32x4 w; w.x = pk2(bflo(v[j].x) * rs * g0.x, bfhi(v[j].x) * rs * g0.y); w.y = pk2(bflo(v[j].y) * rs * g0.z, bfhi(v[j].y) * rs * g0.w);
            w.z = pk2(bflo(v[j].z) * rs * g1.x, bfhi(v[j].z) * rs * g1.y); w.w = pk2(bflo(v[j].w) * rs * g1.z, bfhi(v[j].w) * rs * g1.w); o[64 * j] = w; }
    }
}

__device__ __forceinline__ void nsa_prep_unit(int tb, bf16_t* PROJ, const float* qg, const float* kg, bf16_t* KS, bf16_t* KW, bf16_t* VTS, bf16_t* VTW, int tid) {
    const int sub = tid & 15;
    for (int it0 = 0; it0 < 48; it0 += 8) {
        u32x4 raw4[8];
#pragma unroll
        for (int u = 0; u < 8; ++u) {
            const int task = (it0 + u) * 32 + (tid >> 4), tok = task / 24, v = task - tok * 24, t = tb * 64 + tok;
            const int col = v < 16 ? v * 128 : v < 20 ? 2048 + (2 * 4 + (v - 16)) * 128 : 2048 + (4 * 4 + (v - 20)) * 128;
            raw4[u] = *(const u32x4*)(PROJ + (size_t)t * NSA_N + col + 8 * sub);
        }
#pragma unroll
        for (int u = 0; u < 8; ++u) {
            const int task = (it0 + u) * 32 + (tid >> 4), tok = task / 24, v = task - tok * 24, t = tb * 64 + tok;
            const float* gain; float gs = 1.0f; bf16_t* dst;
            if (v < 16) { gain = qg; gs = QSCALE; dst = PROJ + (size_t)t * NSA_N + v * 128; }
            else if (v < 20) { const int g = v - 16; gain = kg + 128; dst = KS + ((size_t)g * S_ + t) * 128; }
            else { const int g = v - 20; gain = kg + 256; dst = KW + ((size_t)g * S_ + t) * 128; }
            const u32x4 raw = raw4[u];
            float x[8] = {bflo(raw.x), bfhi(raw.x), bflo(raw.y), bfhi(raw.y), bflo(raw.z), bfhi(raw.z), bflo(raw.w), bfhi(raw.w)};
            float ss = 0.f;
#pragma unroll
            for (int e = 0; e < 8; ++e) ss += x[e] * x[e];
            ss += __shfl_xor(ss, 1); ss += __shfl_xor(ss, 2); ss += __shfl_xor(ss, 4); ss += __shfl_xor(ss, 8);
            const float rs = gs / sqrtf(ss * (1.0f / 128.0f) + EPS);
            const f32x4 g0 = *(const f32x4*)(gain + 8 * sub), g1 = *(const f32x4*)(gain + 8 * sub + 4);
            u32x4 o; o.x = pk2(x[0] * rs * g0.x, x[1] * rs * g0.y); o.y = pk2(x[2] * rs * g0.z, x[3] * rs * g0.w); o.z = pk2(x[4] * rs * g1.x, x[5] * rs * g1.y); o.w = pk2(x[6] * rs * g1.z, x[7] * rs * g1.w);
            *(u32x4*)(dst + 8 * sub) = o;
        }
    }
    for (int it0 = 0; it0 < 16; it0 += 4) {
        unsigned short e[4][8];
#pragma unroll
        for (int u = 0; u < 4; ++u) {
            const int task = (it0 + u) * 512 + tid, tile = task >> 10, rem = task & 1023, kc = rem >> 7, d = rem & 127, which = tile >> 2, g = tile & 3;
            const bf16_t* src = PROJ + (size_t)(tb * 64 + 8 * kc) * NSA_N + 2048 + ((which ? 5 : 3) * 4 + g) * 128 + d;
#pragma unroll
            for (int i = 0; i < 8; ++i) e[u][i] = src[(size_t)i * NSA_N];
        }
#pragma unroll
        for (int u = 0; u < 4; ++u) {
            const int task = (it0 + u) * 512 + tid, tile = task >> 10, rem = task & 1023, kc = rem >> 7, d = rem & 127, which = tile >> 2, g = tile & 3;
            u32x4 o; o.x = e[u][0] | ((unsigned)e[u][1] << 16); o.y = e[u][2] | ((unsigned)e[u][3] << 16); o.z = e[u][4] | ((unsigned)e[u][5] << 16); o.w = e[u][6] | ((unsigned)e[u][7] << 16);
            bf16_t* VT = which ? VTW : VTS;
            *(u32x4*)(VT + (((size_t)g * 256 + tb) * 128 + d) * 64 + 8 * kc) = o;
        }
    }
}

__device__ __forceinline__ float gelu_tanh(float x) {
    const float u = 0.7978845608028654f * (x + 0.044715f * x * x * x);
    const float t = 1.0f - 2.0f * __builtin_amdgcn_rcpf(1.0f + ex2(2.0f * 1.4426950408889634f * u));
    return 0.5f * x * (1.0f + t);
}
__device__ __forceinline__ void nsa_compress_unit(int task, const bf16_t* PROJ, const float* pos, const bf16_t* W1t, const float* b1, const bf16_t* W2t, const float* kg0,
                                                  bf16_t* KC, bf16_t* VTC, LAS unsigned char* lds, int tid, int wave, int lane) {
    const int kv = task >> 7, g = (task >> 5) & 3, ct = task & 31, c0 = 32 * ct, fr = lane & 15, fq = lane >> 4;
    LAS float* part = (LAS float*)lds;
    LAS bf16_t* hS = (LAS bf16_t*)(lds + 131072);
    const int crow0 = (c0 + fr) < 1023 ? (c0 + fr) : 1022, crow1 = (c0 + 16 + fr) < 1023 ? (c0 + 16 + fr) : 1022;
    const bf16_t* abase0 = PROJ + (size_t)(16 * crow0) * NSA_N + 2048 + (kv * 4 + g) * 128 + 8 * fq;
    const bf16_t* abase1 = PROJ + (size_t)(16 * crow1) * NSA_N + 2048 + (kv * 4 + g) * 128 + 8 * fq;
    const bf16_t* wbase = W1t + (size_t)kv * 128 * 4096 + (size_t)fr * 4096 + 8 * fq;
    const float* pbase = pos + (size_t)kv * 32 * 128 + 8 * fq;
    f32x4 acc[2][8];
#pragma unroll
    for (int r2 = 0; r2 < 2; ++r2)
#pragma unroll
        for (int i = 0; i < 8; ++i) acc[r2][i] = (f32x4){0.f, 0.f, 0.f, 0.f};
    for (int li = 0; li < 4; ++li) {
        const int l = 4 * wave + li;
#pragma unroll
        for (int dd = 0; dd < 4; ++dd) {
            const u32x4 raw0 = *(const u32x4*)(abase0 + (size_t)l * NSA_N + 32 * dd), raw1 = *(const u32x4*)(abase1 + (size_t)l * NSA_N + 32 * dd);
            const f32x4 p0 = *(const f32x4*)(pbase + l * 128 + 32 * dd), p1 = *(const f32x4*)(pbase + l * 128 + 32 * dd + 4);
            u32x4 a; a.x = pk2(bflo(raw0.x) + p0.x, bfhi(raw0.x) + p0.y); a.y = pk2(bflo(raw0.y) + p0.z, bfhi(raw0.y) + p0.w);
            a.z = pk2(bflo(raw0.z) + p1.x, bfhi(raw0.z) + p1.y); a.w = pk2(bflo(raw0.w) + p1.z, bfhi(raw0.w) + p1.w);
            u32x4 b; b.x = pk2(bflo(raw1.x) + p0.x, bfhi(raw1.x) + p0.y); b.y = pk2(bflo(raw1.y) + p0.z, bfhi(raw1.y) + p0.w);
            b.z = pk2(bflo(raw1.z) + p1.x, bfhi(raw1.z) + p1.y); b.w = pk2(bflo(raw1.w) + p1.z, bfhi(raw1.w) + p1.w);
            const bf16x8 af0 = __builtin_bit_cast(bf16x8, a), af1 = __builtin_bit_cast(bf16x8, b);
#pragma unroll
            for (int nt = 0; nt < 8; ++nt) { const bf16x8 bfr = *(const bf16x8*)(wbase + (size_t)nt * 16 * 4096 + l * 128 + 32 * dd); acc[0][nt] = MFMA16(bfr, af0, acc[0][nt]); acc[1][nt] = MFMA16(bfr, af1, acc[1][nt]); }
        }
    }
#pragma unroll
    for (int r2 = 0; r2 < 2; ++r2)
#pragma unroll
        for (int nt = 0; nt < 8; ++nt) *(LAS f32x4*)(part + (wave * 32 + 16 * r2 + fr) * 128 + 16 * nt + 4 * fq) = acc[r2][nt];
    __syncthreads();
    {
        const int c = tid >> 4, n8 = (tid & 15) * 8;
        f32x4 s0 = *(const f32x4*)(b1 + kv * 128 + n8), s1 = *(const f32x4*)(b1 + kv * 128 + n8 + 4);
#pragma unroll
        for (int w = 0; w < 8; ++w) { s0 = s0 + *(LAS f32x4*)(part + (w * 32 + c) * 128 + n8); s1 = s1 + *(LAS f32x4*)(part + (w * 32 + c) * 128 + n8 + 4); }
        u32x4 o; o.x = pk2(gelu_tanh(s0.x), gelu_tanh(s0.y)); o.y = pk2(gelu_tanh(s0.z), gelu_tanh(s0.w)); o.z = pk2(gelu_tanh(s1.x), gelu_tanh(s1.y)); o.w = pk2(gelu_tanh(s1.z), gelu_tanh(s1.w));
        *(LAS u32x4*)(hS + c * 136 + n8) = o;
    }
    __syncthreads();
    {
        f32x4 a2[2] = {(f32x4){0.f, 0.f, 0.f, 0.f}, (f32x4){0.f, 0.f, 0.f, 0.f}};
#pragma unroll
        for (int ks = 0; ks < 4; ++ks) {
            const bf16x8 wf = *(const bf16x8*)(W2t + (size_t)kv * 128 * 128 + (size_t)(16 * wave + fr) * 128 + 32 * ks + 8 * fq);
#pragma unroll
            for (int r2 = 0; r2 < 2; ++r2) { const bf16x8 hf = *(LAS bf16x8*)(hS + (16 * r2 + fr) * 136 + 32 * ks + 8 * fq); a2[r2] = MFMA16(wf, hf, a2[r2]); }
        }
#pragma unroll
        for (int r2 = 0; r2 < 2; ++r2) *(LAS f32x4*)(part + (16 * r2 + fr) * 128 + 16 * wave + 4 * fq) = a2[r2];
    }
    __syncthreads();
    if (kv == 0) {
        const int c = tid >> 4, sub = tid & 15;
        const f32x4 x0 = *(LAS f32x4*)(part + c * 128 + 8 * sub), x1 = *(LAS f32x4*)(part + c * 128 + 8 * sub + 4);
        float ss = (x0.x * x0.x + x0.y * x0.y) + (x0.z * x0.z + x0.w * x0.w) + (x1.x * x1.x + x1.y * x1.y) + (x1.z * x1.z + x1.w * x1.w);
        ss += __shfl_xor(ss, 1); ss += __shfl_xor(ss, 2); ss += __shfl_xor(ss, 4); ss += __shfl_xor(ss, 8);
        float rs = 1.0f / sqrtf(ss * (1.0f / 128.0f) + EPS);
        if (c0 + c >= 1023) rs = 0.f;
        const f32x4 g0 = *(const f32x4*)(kg0 + 8 * sub), g1 = *(const f32x4*)(kg0 + 8 * sub + 4);
        u32x4 o; o.x = pk2(x0.x * rs * g0.x, x0.y * rs * g0.y); o.y = pk2(x0.z * rs * g0.z, x0.w * rs * g0.w); o.z = pk2(x1.x * rs * g1.x, x1.y * rs * g1.y); o.w = pk2(x1.z * rs * g1.z, x1.w * rs * g1.w);
        *(u32x4*)(KC + ((size_t)g * 1024 + c0 + c) * 128 + 8 * sub) = o;
    } else {
        if (tid < 256) {
            const int d = tid & 127, hh = tid >> 7; float v[16];
#pragma unroll
            for (int c = 0; c < 16; ++c) v[c] = (c0 + 16 * hh + c < 1023) ? part[(16 * hh + c) * 128 + d] : 0.f;
            u32x4 o0, o1; o0.x = pk2(v[0], v[1]); o0.y = pk2(v[2], v[3]); o0.z = pk2(v[4], v[5]); o0.w = pk2(v[6], v[7]);
            o1.x = pk2(v[8], v[9]); o1.y = pk2(v[10], v[11]); o1.z = pk2(v[12], v[13]); o1.w = pk2(v[14], v[15]);
            bf16_t* dst = VTC + (((size_t)g * 16 + (ct >> 1)) * 128 + d) * 64 + 32 * (ct & 1) + 16 * hh;
            *(u32x4*)dst = o0; *(u32x4*)(dst + 8) = o1;
        }
    }
    __syncthreads();
}

__device__ __forceinline__ unsigned long long shfl_xor_u64(unsigned long long v, int m) {
    const unsigned lo = __shfl_xor((unsigned)v, m), hi = __shfl_xor((unsigned)(v >> 32), m);
    return ((unsigned long long)hi << 32) | lo;
}

struct QuadState { bf16x8 qf[4]; f32x4 o[8]; float l; };
constexpr int AT_STAGE = 32768, AT_V = 16384;
constexpr int AT_IMP = 2 * AT_STAGE;
constexpr int AT_SELM = AT_IMP + 65536;
static_assert(AT_SELM + 2048 + 512 <= LDS_BYTES, "attention LDS map");

template <bool WV>
__device__ __forceinline__ void at_dma(LAS unsigned char* st, const bf16_t* __restrict__ Kb, const bf16_t* __restrict__ Vb, int wave, int lane) {
#pragma unroll
    for (int i = 0; i < 2; ++i) {
        const int k = 2 * wave + i;
        const int rho = 4 * k + (lane >> 4), sg = lane & 15, key = (rho & 32) + ((rho >> 2) & 3) * 8 + ((rho >> 4) & 1) * 4 + (rho & 3);
        __builtin_amdgcn_global_load_lds((const unsigned*)(Kb + key * 128 + 8 * (sg ^ (rho & 15))), (LAS unsigned*)(st + 1024 * k), 16, 0, 0);
    }
    if (WV) {
#pragma unroll
        for (int i = 0; i < 2; ++i) {
            const int k = 2 * wave + i;
            const int d = 8 * k + (lane >> 3), sg = lane & 7;
            __builtin_amdgcn_global_load_lds((const unsigned*)(Vb + d * 64 + 8 * (sg ^ ((d >> 1) & 7))), (LAS unsigned*)(st + AT_V + 1024 * k), 16, 0, 0);
        }
    }
}
template <int MODE, bool DUAL>
__device__ __forceinline__ void at_block(const LAS unsigned char* st, QuadState& A, QuadState& B, bool domask, float biasA, float biasB, int pos0, int loA, int hiA, int loB, int hiB, float invlA, float invlB,
                                         float& carryA, float& carryB, LAS float* impA, LAS float* impB, int lane, int fr, int fq) {
    f32x4 sA[4], sB[4];
#pragma unroll
    for (int T = 0; T < 4; ++T) { sA[T] = (f32x4){biasA, biasA, biasA, biasA}; sB[T] = (f32x4){biasB, biasB, biasB, biasB}; }
    bf16x8 vpre[8];
    if (!DUAL && MODE != 0) {
#pragma unroll
        for (int dt = 0; dt < 8; ++dt) vpre[dt] = *(const LAS bf16x8*)(st + AT_V + (16 * dt + fr) * 128 + 16 * ((fq) ^ ((fr >> 1) & 7)));
    }
#pragma unroll
    for (int ks = 0; ks < 4; ++ks) {
        bf16x8 kf[4];
#pragma unroll
        for (int T = 0; T < 4; ++T) kf[T] = *(const LAS bf16x8*)(st + (32 * (T >> 1) + 16 * (T & 1) + fr) * 256 + 16 * ((4 * fq + ks) ^ fr));
#pragma unroll
        for (int T = 0; T < 4; ++T) { sA[T] = MFMA16(kf[T], A.qf[ks], sA[T]); if (DUAL) sB[T] = MFMA16(kf[T], B.qf[ks], sB[T]); }
        if (DUAL) __builtin_amdgcn_sched_barrier(0);
    }
    float la = 0.f, lb = 0.f;
    if (domask) {
#pragma unroll
        for (int T = 0; T < 4; ++T)
#pragma unroll
            for (int i = 0; i < 4; ++i) {
                const int pos = pos0 + 32 * (T >> 1) + 8 * fq + 4 * (T & 1) + i;
                if (!(pos >= loA && pos <= hiA)) sA[T][i] = NEG;
                if (DUAL) { if (!(pos >= loB && pos <= hiB)) sB[T][i] = NEG; }
            }
    }
#pragma unroll
    for (int T = 0; T < 4; ++T)
#pragma unroll
        for (int i = 0; i < 4; ++i) {
            float e = ex2(sA[T][i]); if (MODE == 2) e *= invlA; sA[T][i] = e; la += e;
            if (DUAL) { float f = ex2(sB[T][i]); if (MODE == 2) f *= invlB; sB[T][i] = f; lb += f; }
        }
    if (MODE != 2) { A.l += la; if (DUAL) B.l += lb; }
    if (MODE == 2) {
        const int src = (lane + 48) & 63;
        {
            const float r0 = __shfl(sA[1][3], src), r1 = __shfl(sA[3][3], src);
            const float pv0 = fq ? r0 : carryA, pv1 = fq ? r1 : r0; carryA = r1;
            float i00 = (sA[0][0] + sA[0][1]) + (sA[0][2] + sA[0][3]) + pv0, i01 = (sA[1][0] + sA[1][1]) + (sA[1][2] + sA[1][3]) + sA[0][3];
            float i10 = (sA[2][0] + sA[2][1]) + (sA[2][2] + sA[2][3]) + pv1, i11 = (sA[3][0] + sA[3][1]) + (sA[3][2] + sA[3][3]) + sA[2][3];
            i00 = quad_sum(i00); i01 = quad_sum(i01); i10 = quad_sum(i10); i11 = quad_sum(i11);
            if ((fr & 3) == 0) { impA[2 * fq] = i00; impA[2 * fq + 1] = i01; impA[8 + 2 * fq] = i10; impA[8 + 2 * fq + 1] = i11; }
        }
        if (DUAL) {
            const float r0 = __shfl(sB[1][3], src), r1 = __shfl(sB[3][3], src);
            const float pv0 = fq ? r0 : carryB, pv1 = fq ? r1 : r0; carryB = r1;
            float i00 = (sB[0][0] + sB[0][1]) + (sB[0][2] + sB[0][3]) + pv0, i01 = (sB[1][0] + sB[1][1]) + (sB[1][2] + sB[1][3]) + sB[0][3];
            float i10 = (sB[2][0] + sB[2][1]) + (sB[2][2] + sB[2][3]) + pv1, i11 = (sB[3][0] + sB[3][1]) + (sB[3][2] + sB[3][3]) + sB[2][3];
            i00 = quad_sum(i00); i01 = quad_sum(i01); i10 = quad_sum(i10); i11 = quad_sum(i11);
            if ((fr & 3) == 0) { impB[2 * fq] = i00; impB[2 * fq + 1] = i01; impB[8 + 2 * fq] = i10; impB[8 + 2 * fq + 1] = i11; }
        }
    }
    if (MODE != 0) {
        bf16x8 pfA[2], pfB[2];
#pragma unroll
        for (int u = 0; u < 2; ++u) {
            u32x4 w; w.x = pk2(sA[2 * u][0], sA[2 * u][1]); w.y = pk2(sA[2 * u][2], sA[2 * u][3]); w.z = pk2(sA[2 * u + 1][0], sA[2 * u + 1][1]); w.w = pk2(sA[2 * u + 1][2], sA[2 * u + 1][3]); pfA[u] = __builtin_bit_cast(bf16x8, w);
            if (DUAL) { u32x4 x; x.x = pk2(sB[2 * u][0], sB[2 * u][1]); x.y = pk2(sB[2 * u][2], sB[2 * u][3]); x.z = pk2(sB[2 * u + 1][0], sB[2 * u + 1][1]); x.w = pk2(sB[2 * u + 1][2], sB[2 * u + 1][3]); pfB[u] = __builtin_bit_cast(bf16x8, x); }
        }
#pragma unroll
        for (int u = 0; u < 2; ++u) {
#pragma unroll
            for (int dt = 0; dt < 8; ++dt) {
                const bf16x8 vf = (DUAL || u == 1) ? *(const LAS bf16x8*)(st + AT_V + (16 * dt + fr) * 128 + 16 * ((4 * u + fq) ^ ((fr >> 1) & 7))) : vpre[dt];
                A.o[dt] = MFMA16(vf, pfA[u], A.o[dt]); if (DUAL) B.o[dt] = MFMA16(vf, pfB[u], B.o[dt]);
                if (DUAL && (dt & 3) == 3) __builtin_amdgcn_sched_barrier(0);
            }
        }
    }
}
template <int MODE, bool SEL, int NST>
__device__ __forceinline__ void at_run(LAS unsigned char* lds, const bf16_t* Kg, const bf16_t* Vg, int first, int last, QuadState& A, QuadState& B, int loA, int hiA, int loB, int hiB,
                                       float invlA, float invlB, LAS float* impA, LAS float* impB, const LAS unsigned* uni, const LAS unsigned* selmA, const LAS unsigned* selmB,
                                       int tid, int lane, int fr, int fq, int nm_lo = 1, int nm_hi = 0) {
    constexpr bool WV = MODE != 0;
    constexpr int BPS = NST / 2;
    const int wave = __builtin_amdgcn_readfirstlane(tid >> 6);
    const int sb0 = first / BPS, sb1 = last / BPS;
    float carryA = 0.f, carryB = 0.f;
#define AT_DMA_SB(sb) do { _Pragma("unroll") for (int h_ = 0; h_ < BPS; ++h_) { const int blk_ = (sb) * BPS + h_; if (blk_ >= first && blk_ <= last) \
        at_dma<WV>(lds + ((((sb) & 1) * BPS + h_) * AT_STAGE), Kg + (size_t)blk_ * 8192, Vg + (size_t)blk_ * 8192, wave, lane); } } while (0)
    AT_DMA_SB(sb0);
    unsigned wa = 0u, wb = 0u;
    for (int sb = sb0; sb <= sb1; ++sb) {
        asm volatile("s_waitcnt vmcnt(0)" ::: "memory");
        __syncthreads();
        if (sb < sb1) AT_DMA_SB(sb + 1);
#pragma unroll
        for (int h = 0; h < BPS; ++h) {
            const int idx = sb * BPS + h;
            if (idx < first || idx > last) continue;
            const LAS unsigned char* st = lds + (((sb & 1) * BPS + h) * AT_STAGE);
            if (SEL) {
                if ((idx & 31) == 0 || idx == first) { wa = (unsigned)__builtin_amdgcn_readfirstlane((int)uni[idx >> 5]); wb = (unsigned)__builtin_amdgcn_readfirstlane((int)uni[8 + (idx >> 5)]); }
                const bool actA = (wa >> (idx & 31)) & 1u, actB = (wb >> (idx & 31)) & 1u;
                if (actA) { const float bA = ((selmA[idx >> 5] >> (idx & 31)) & 1u) ? 0.f : NEG; at_block<1, false>(st, A, A, idx == last, bA, bA, 64 * idx, 0, hiA, 0, hiA, 0.f, 0.f, carryA, carryA, nullptr, nullptr, lane, fr, fq); }
                if (actB) { const float bB = ((selmB[idx >> 5] >> (idx & 31)) & 1u) ? 0.f : NEG; at_block<1, false>(st, B, B, idx == last, bB, bB, 64 * idx, 0, hiB, 0, hiB, 0.f, 0.f, carryB, carryB, nullptr, nullptr, lane, fr, fq); }
            } else {
                at_block<MODE, true>(st, A, B, idx < nm_lo || idx > nm_hi, 0.f, 0.f, 64 * idx, loA, hiA, loB, hiB, invlA, invlB, carryA, carryB, impA + 16 * idx, impB + 16 * idx, lane, fr, fq);
            }
        }
    }
#undef AT_DMA_SB
    asm volatile("s_waitcnt vmcnt(0)" ::: "memory");
    __syncthreads();
}
__device__ __forceinline__ void y_accum(bf16_t* yp, const f32x4 (&o)[8], float sc, bool first) {
    u32x2 old[8];
    if (!first) {
#pragma unroll
        for (int dt = 0; dt < 8; ++dt) old[dt] = *(const u32x2*)(yp + 16 * dt);
    }
#pragma unroll
    for (int dt = 0; dt < 8; ++dt) {
        float a0 = o[dt][0] * sc, a1 = o[dt][1] * sc, a2 = o[dt][2] * sc, a3 = o[dt][3] * sc;
        if (!first) { a0 += bflo(old[dt].x); a1 += bfhi(old[dt].x); a2 += bflo(old[dt].y); a3 += bfhi(old[dt].y); }
        u32x2 w; w.x = pk2(a0, a1); w.y = pk2(a2, a3); *(u32x2*)(yp + 16 * dt) = w;
    }
}
__device__ __forceinline__ void nsa_attn_wg(int qb, int g, const bf16_t* PROJ, const float* bgate, const bf16_t* KC, const bf16_t* VTC, const bf16_t* KS, const bf16_t* VTS,
                                            const bf16_t* KW, const bf16_t* VTW, bf16_t* Y, LAS unsigned char* lds, int tid, int wave, int lane) {
    const int fr = lane & 15, fq = lane >> 4, a = fr >> 2, r = fr & 3, cur = qb;
    const int tlA = 8 * wave + a, tlB = tlA + 4, tA = 64 * qb + tlA, tB = 64 * qb + tlB;
    LAS float* IMP = (LAS float*)(lds + AT_IMP); LAS unsigned* SELM = (LAS unsigned*)(lds + AT_SELM); LAS unsigned* UNI = SELM + 512;
    QuadState A, B;
    {
        const bf16x8* qa = (const bf16x8*)(PROJ + (size_t)tA * NSA_N + (4 * g + r) * 128 + 32 * fq); const bf16x8* qbp = (const bf16x8*)(PROJ + (size_t)tB * NSA_N + (4 * g + r) * 128 + 32 * fq);
#pragma unroll
        for (int ks = 0; ks < 4; ++ks) { A.qf[ks] = qa[ks]; B.qf[ks] = qbp[ks]; }
    }
#define gpA (PROJ + (size_t)tA * NSA_N + 5120 + (4 * g + r) * 3)
#define gpB (PROJ + (size_t)tB * NSA_N + 5120 + (4 * g + r) * 3)
#define bg (bgate + (4 * g + r) * 3)
#define ypA (Y + (size_t)tA * D_ + (4 * g + r) * 128 + 4 * fq)
#define ypB (Y + (size_t)tB * D_ + (4 * g + r) * 128 + 4 * fq)
    {
        const int cmA = (tA - 31) >> 4, cmB = (tB - 31) >> 4, nb = ((4 * qb + 2) >> 6) + 1;
        const bf16_t* KCg = KC + (size_t)g * 1024 * 128; const bf16_t* VCg = VTC + (size_t)g * 16 * 8192;
        A.l = 0.f; B.l = 0.f;
        at_run<0, false, 2>(lds, KCg, VCg, 0, nb - 1, A, B, 0, cmA, 0, cmB, 0.f, 0.f, nullptr, nullptr, nullptr, nullptr, nullptr, tid, lane, fr, fq, 0, (4 * qb - 65) >> 6);
        const float lA = fq_sum(A.l), lB = fq_sum(B.l);
        const float invlA = lA > 0.f ? 1.0f / lA : 0.f, invlB = lB > 0.f ? 1.0f / lB : 0.f;
#pragma unroll
        for (int i = 0; i < 8; ++i) { A.o[i] = (f32x4){0.f, 0.f, 0.f, 0.f}; B.o[i] = (f32x4){0.f, 0.f, 0.f, 0.f}; }
        at_run<2, false, 2>(lds, KCg, VCg, 0, nb - 1, A, B, 0, cmA, 0, cmB, invlA, invlB, IMP + tlA * 256, IMP + tlB * 256, nullptr, nullptr, nullptr, tid, lane, fr, fq, 0, (4 * qb - 65) >> 6);
        y_accum(ypA, A.o, sigmoidf_(bf2f(gpA[0]) + bg[0]), true);
        y_accum(ypB, B.o, sigmoidf_(bf2f(gpB[0]) + bg[0]), true);
    }
    asm volatile("s_waitcnt lgkmcnt(0)" ::: "memory");
    {
        float val[8][4]; unsigned selb[8];
#pragma unroll
        for (int ta = 0; ta < 8; ++ta) {
            selb[ta] = 0u;
#pragma unroll
            for (int q = 0; q < 4; ++q) {
                const int j = lane + 64 * q;
                if ((j <= cur) && (j == 0 || j >= cur - 1 || cur <= 15)) selb[ta] |= 1u << q;
                val[ta][q] = (cur > 15 && j >= 1 && j <= cur - 2) ? IMP[(8 * wave + ta) * 256 + j] : -1.0f;
            }
        }
        if (cur > 15) {
            for (int it = 0; it < 13; ++it) {
                unsigned long long best[8];
#pragma unroll
                for (int ta = 0; ta < 8; ++ta) {
                    unsigned long long b = 0ull;
#pragma unroll
                    for (int q = 0; q < 4; ++q) if (val[ta][q] >= 0.f) { const unsigned long long k = ((unsigned long long)__float_as_uint(val[ta][q]) << 32) | (unsigned)(256 - (lane + 64 * q)); b = k > b ? k : b; }
                    best[ta] = b;
                }
#pragma unroll
                for (int m = 1; m < 64; m <<= 1) {
#pragma unroll
                    for (int ta = 0; ta < 8; ++ta) { const unsigned long long ot = shfl_xor_u64(best[ta], m); best[ta] = ot > best[ta] ? ot : best[ta]; }
                }
#pragma unroll
                for (int ta = 0; ta < 8; ++ta) {
                    const int jw = 256 - (int)(best[ta] & 0x1ffu);
#pragma unroll
                    for (int q = 0; q < 4; ++q) if (lane + 64 * q == jw) { val[ta][q] = -1.0f; selb[ta] |= 1u << q; }
                }
            }
        }
#pragma unroll
        for (int ta = 0; ta < 8; ++ta)
#pragma unroll
            for (int q = 0; q < 4; ++q) {
                const unsigned long long m = __ballot((selb[ta] >> q) & 1u);
                if (lane == 0) { SELM[(8 * wave + ta) * 8 + 2 * q] = (unsigned)m; SELM[(8 * wave + ta) * 8 + 2 * q + 1] = (unsigned)(m >> 32); }
            }
    }
    asm volatile("s_waitcnt lgkmcnt(0)" ::: "memory");
    if (lane < 16) {
        const int qd = lane >> 3, wd = lane & 7;
        UNI[16 * wave + lane] = SELM[(8 * wave + 4 * qd + 0) * 8 + wd] | SELM[(8 * wave + 4 * qd + 1) * 8 + wd] | SELM[(8 * wave + 4 * qd + 2) * 8 + wd] | SELM[(8 * wave + 4 * qd + 3) * 8 + wd];
    }
    asm volatile("s_waitcnt lgkmcnt(0)" ::: "memory");
    __syncthreads();
    {
#pragma unroll
        for (int i = 0; i < 8; ++i) { A.o[i] = (f32x4){0.f, 0.f, 0.f, 0.f}; B.o[i] = (f32x4){0.f, 0.f, 0.f, 0.f}; }
        A.l = 0.f; B.l = 0.f;
        at_run<1, true, 4>(lds, KS + (size_t)g * S_ * 128, VTS + (size_t)g * 256 * 8192, 0, cur, A, B, 0, tA, 0, tB, 0.f, 0.f, nullptr, nullptr, UNI + 16 * wave, SELM + tlA * 8, SELM + tlB * 8, tid, lane, fr, fq);
        const float lA = fq_sum(A.l), lB = fq_sum(B.l);
        y_accum(ypA, A.o, lA > 0.f ? sigmoidf_(bf2f(gpA[1]) + bg[1]) / lA : 0.f, false);
        y_accum(ypB, B.o, lB > 0.f ? sigmoidf_(bf2f(gpB[1]) + bg[1]) / lB : 0.f, false);
    }
    {
#pragma unroll
        for (int i = 0; i < 8; ++i) { A.o[i] = (f32x4){0.f, 0.f, 0.f, 0.f}; B.o[i] = (f32x4){0.f, 0.f, 0.f, 0.f}; }
        A.l = 0.f; B.l = 0.f;
        const int jlo = qb >= 8 ? qb - 8 : 0;
        at_run<1, false, 4>(lds, KW + (size_t)g * S_ * 128, VTW + (size_t)g * 256 * 8192, jlo, cur, A, B, tA - 511, tA, tB - 511, tB, 0.f, 0.f, nullptr, nullptr, nullptr, nullptr, nullptr, tid, lane, fr, fq, qb - 7, qb - 1);
        const float lA = fq_sum(A.l), lB = fq_sum(B.l);
        y_accum(ypA, A.o, lA > 0.f ? sigmoidf_(bf2f(gpA[2]) + bg[2]) / lA : 0.f, false);
        y_accum(ypB, B.o, lB > 0.f ? sigmoidf_(bf2f(gpB[2]) + bg[2]) / lB : 0.f, false);
    }
#undef gpA
#undef gpB
#undef bg
#undef ypA
#undef ypB
}

__device__ __forceinline__ float log_sigmoid(float x) { return fminf(x, 0.f) - log1pf(__expf(-fabsf(x))); }
__device__ __forceinline__ void ml_stage_load(const bf16_t* PROJ, int h, int c, bool do_k, int tid, u32x4 (&rk)[2], u32x4 (&rv)[4]) {
    if (do_k) {
#pragma unroll
        for (int i = 0; i < 2; ++i) { const int idx = tid + 512 * i, s = (idx & 3) + 4 * (idx >> 6), ch = (idx >> 2) & 15; rk[i] = *(const u32x4*)(PROJ + (size_t)(64 * c + s) * ML_N + 1024 + h * 128 + 8 * ch); }
    }
#pragma unroll
    for (int i = 0; i < 4; ++i) { const int i2 = tid + 512 * i, s = (i2 & 3) + 4 * (i2 >> 7), ch = (i2 >> 2) & 31; rv[i] = *(const u32x4*)(PROJ + (size_t)(64 * c + s) * ML_N + 2048 + h * 256 + 8 * ch); }
}
__device__ __forceinline__ void ml_stage_store(LAS bf16_t* kT, LAS bf16_t* vT, const LAS float* wS, bool do_k, int tid, const u32x4 (&rk)[2], const u32x4 (&rv)[4]) {
    if (do_k) {
#pragma unroll
        for (int i = 0; i < 2; ++i) {
            const int idx = tid + 512 * i, s = (idx & 3) + 4 * (idx >> 6), ch = (idx >> 2) & 15, col = (s + 8 * ch) & 63;
            const float w = wS[s] * 0.08838834764831845f;
            const unsigned ww[4] = {rk[i].x, rk[i].y, rk[i].z, rk[i].w};
#pragma unroll
            for (int e = 0; e < 4; ++e) { const unsigned pkd = pk2(bflo(ww[e]) * w, bfhi(ww[e]) * w); kT[(8 * ch + 2 * e) * 72 + col] = (bf16_t)(pkd & 0xffffu); kT[(8 * ch + 2 * e + 1) * 72 + col] = (bf16_t)(pkd >> 16); }
        }
    }
#pragma unroll
    for (int i = 0; i < 4; ++i) {
        const int i2 = tid + 512 * i, s = (i2 & 3) + 4 * (i2 >> 7), ch = (i2 >> 2) & 31, col = (s + 8 * ch) & 63;
        const unsigned ww[4] = {rv[i].x, rv[i].y, rv[i].z, rv[i].w};
#pragma unroll
        for (int e = 0; e < 4; ++e) { vT[(8 * ch + 2 * e) * 72 + col] = (bf16_t)(ww[e] & 0xffffu); vT[(8 * ch + 2 * e + 1) * 72 + col] = (bf16_t)(ww[e] >> 16); }
    }
}
__device__ __forceinline__ void ml_local_phase(int first, int step, const bf16_t* PROJ, const float* bif, bf16_t* CT, float* NT, float* CI, LAS unsigned char* lds, int tid, int wave, int lane) {
    const int fr = lane & 15, fq = lane >> 4;
    LAS bf16_t* kT = (LAS bf16_t*)lds;
    LAS bf16_t* vT = (LAS bf16_t*)(lds + 18432);
    LAS float* wS = (LAS float*)(lds + 18432 + 36864);
    u32x4 rk[2], rv[4]; unsigned short gi = 0, gf = 0;
    if (first < 2048) {
        ml_stage_load(PROJ, first >> 8, first & 255, true, tid, rk, rv);
        if (wave == 0) { const bf16_t* gp = PROJ + (size_t)(64 * (first & 255) + lane) * ML_N + 6144 + (first >> 8); gi = gp[0]; gf = gp[8]; }
    }
    for (int unit = first; unit < 2048; unit += step) {
        const int h = unit >> 8, c = unit & 255;
        if (wave == 0) {
            const float ig = bf2f(gi) + bif[h], lf = log_sigmoid(bf2f(gf) + bif[8 + h]);
            float b = lf;
#pragma unroll
            for (int o = 1; o < 64; o <<= 1) { const float u = __shfl_up(b, o); if (lane >= o) b += u; }
            const float blast = __shfl(b, 63), gs = blast - b + ig, gmax = wave_max(gs);
            wS[lane] = __expf(gs - gmax);
            if (lane == 0) { CI[(h * 256 + c) * 2] = blast; CI[(h * 256 + c) * 2 + 1] = gmax; }
        }
        __syncthreads();
        ml_stage_store(kT, vT, wS, true, tid, rk, rv);
        __syncthreads();
        const int un = unit + step;
        if (un < 2048) {
            ml_stage_load(PROJ, un >> 8, un & 255, true, tid, rk, rv);
            if (wave == 0) { const bf16_t* gp = PROJ + (size_t)(64 * (un & 255) + lane) * ML_N + 6144 + (un >> 8); gi = gp[0]; gf = gp[8]; }
        }
        f32x4 acc[16];
#pragma unroll
        for (int i = 0; i < 16; ++i) acc[i] = (f32x4){0.f, 0.f, 0.f, 0.f};
#pragma unroll
        for (int ks = 0; ks < 2; ++ks) {
            const bf16x8 af = *(LAS bf16x8*)(kT + (16 * wave + fr) * 72 + 8 * ((4 * ks + fq + 2 * wave + (fr >> 3)) & 7));
#pragma unroll
            for (int nt = 0; nt < 16; ++nt) { const bf16x8 bfr = *(LAS bf16x8*)(vT + (16 * nt + fr) * 72 + 8 * ((4 * ks + fq + 2 * nt + (fr >> 3)) & 7)); acc[nt] = MFMA16(af, bfr, acc[nt]); }
        }
        LAS bf16_t* tS = (LAS bf16_t*)(lds + 57344);
#pragma unroll
        for (int nt = 0; nt < 16; ++nt) { u32x2 w; w.x = pk2(acc[nt][0], acc[nt][1]); w.y = pk2(acc[nt][2], acc[nt][3]); *(LAS u32x2*)(tS + (16 * nt + fr) * 136 + 16 * wave + 4 * fq) = w; }
        if (tid < 128) { float s = 0.f; for (int i = 0; i < 64; ++i) s += bf2f(kT[tid * 72 + i]); NT[(size_t)(h * 256 + c) * 128 + tid] = s; }
        __syncthreads();
        {
            bf16_t* ct = CT + ((size_t)(h * 256 + c) * 256) * 128;
#pragma unroll
            for (int i = 0; i < 8; ++i) { const int q = tid + 512 * i, row = q >> 4, c16 = q & 15; *(u32x4*)(ct + (size_t)row * 128 + 8 * c16) = *(LAS u32x4*)(tS + row * 136 + 8 * c16); }
        }
    }
}
__device__ __forceinline__ void ml_scan_unit(int unit, bf16_t* CT, float* NT, const float* CI, float* MC, LAS unsigned char* lds, int tid) {
    const int h = unit >> 5, part = unit & 31;
    LAS float* cdS = (LAS float*)lds; LAS float* eS = cdS + 256; LAS float* blS = eS + 256; LAS float* gmS = blS + 256; LAS float* mS = gmS + 256;
    if (tid < 256) { blS[tid] = CI[(h * 256 + tid) * 2]; gmS[tid] = CI[(h * 256 + tid) * 2 + 1]; }
    __syncthreads();
    {
        float B = 0.f, Gm = 0.f;
        if (tid < 256) { B = blS[tid]; Gm = gmS[tid]; }
        for (int off = 1; off < 256; off <<= 1) {
            if (tid < 256) { cdS[tid] = B; eS[tid] = Gm; }
            __syncthreads();
            if (tid < 256 && tid >= off) { const float B1 = cdS[tid - off], G1 = eS[tid - off]; Gm = fmaxf(G1 + B, Gm); B = B1 + B; }
            __syncthreads();
        }
        if (tid < 256) mS[tid + 1] = fmaxf(NEG + B, Gm);
        if (tid == 0) mS[0] = NEG;
    }
    __syncthreads();
    if (tid < 256) {
        const float m = mS[tid], mn = mS[tid + 1];
        cdS[tid] = __expf(blS[tid] + m - mn); eS[tid] = __expf(gmS[tid] - mn);
        if (part == 0) MC[h * 256 + tid] = m;
    }
    __syncthreads();
    {
        unsigned* p = (unsigned*)(CT + (size_t)h * 256 * 32768) + part * 512 + tid;
        float r0 = 0.f, r1 = 0.f;
        unsigned d[16], dn[16];
#pragma unroll
        for (int i = 0; i < 16; ++i) d[i] = p[(size_t)i * 16384];
        for (int c0 = 0; c0 < 256; c0 += 16) {
            if (c0 + 16 < 256) {
#pragma unroll
                for (int i = 0; i < 16; ++i) dn[i] = p[(size_t)(c0 + 16 + i) * 16384];
            }
#pragma unroll
            for (int i = 0; i < 16; ++i) { p[(size_t)(c0 + i) * 16384] = pk2(r0, r1); const float cd = cdS[c0 + i], e = eS[c0 + i]; r0 = cd * r0 + e * bflo(d[i]); r1 = cd * r1 + e * bfhi(d[i]); }
#pragma unroll
            for (int i = 0; i < 16; ++i) d[i] = dn[i];
        }
    }
    if (part == 0 && tid < 128) {
        float* p = NT + (size_t)h * 256 * 128 + tid; float r = 0.f;
        for (int c0 = 0; c0 < 256; c0 += 16) {
            float d[16];
#pragma unroll
            for (int i = 0; i < 16; ++i) d[i] = p[(c0 + i) * 128];
#pragma unroll
            for (int i = 0; i < 16; ++i) { p[(c0 + i) * 128] = r; r = cdS[c0 + i] * r + eS[c0 + i] * d[i]; }
        }
    }
    __syncthreads();
}
__device__ __forceinline__ void ml_out_unit(int unit, const bf16_t* PROJ, const float* bif, const float* outg, const bf16_t* CT, const float* NT, const float* MC, bf16_t* Y,
                                            LAS unsigned char* lds, int tid, int wave, int lane) {
    const int h = unit >> 8, c = unit & 255, fr = lane & 15, fq = lane >> 4, tt = wave & 3, dvh = wave >> 2;
    LAS bf16_t* vT = (LAS bf16_t*)(lds + 18432);
    LAS float* dS = (LAS float*)(lds + 18432 + 36864);
    LAS float* pmS = dS + 64;
    LAS float* bS = pmS + 64;
    LAS float* nS = bS + 64;
    LAS float* ssS = nS + 128;
    u32x4 rk[2], rv[4];
    ml_stage_load(PROJ, h, c, false, tid, rk, rv);
    if (wave == 0) {
        const bf16_t* gp = PROJ + (size_t)(64 * c + lane) * ML_N + 6144 + h;
        const float ig = bf2f(gp[0]) + bif[h], lf = log_sigmoid(bf2f(gp[8]) + bif[8 + h]);
        float b = lf;
#pragma unroll
        for (int o = 1; o < 64; o <<= 1) { const float u = __shfl_up(b, o); if (lane >= o) b += u; }
        const float d = ig - b; float pm = d;
#pragma unroll
        for (int o = 1; o < 64; o <<= 1) { const float u = __shfl_up(pm, o); if (lane >= o) pm = fmaxf(pm, u); }
        dS[lane] = d; pmS[lane] = pm; bS[lane] = b;
    }
    if (tid >= 64 && tid < 192) nS[tid - 64] = NT[(size_t)(h * 256 + c) * 128 + tid - 64];
    const int trow = 16 * tt + fr;
    const float mc = MC[h * 256 + c];
    bf16x8 qf[4], kfr[4][4], ctf[4][4];
    {
        const bf16_t* qp = PROJ + (size_t)(64 * c + trow) * ML_N + h * 128 + 8 * fq;
#pragma unroll
        for (int ks = 0; ks < 4; ++ks) qf[ks] = *(const bf16x8*)(qp + 32 * ks);
#pragma unroll
        for (int T = 0; T < 4; ++T) {
            const int s_ = 32 * (T >> 1) + 8 * (fr >> 2) + 4 * (T & 1) + (fr & 3);
            const bf16_t* kp = PROJ + (size_t)(64 * c + s_) * ML_N + 1024 + h * 128 + 8 * fq;
#pragma unroll
            for (int ks = 0; ks < 4; ++ks) kfr[T][ks] = *(const bf16x8*)(kp + 32 * ks);
        }
    }
    const bf16_t* ctp = CT + ((size_t)(h * 256 + c) * 256 + 128 * dvh + fr) * 128 + 8 * fq;
#pragma unroll
    for (int dt = 0; dt < 4; ++dt)
#pragma unroll
        for (int ks = 0; ks < 4; ++ks) ctf[dt][ks] = *(const bf16x8*)(ctp + (size_t)(16 * dt) * 128 + 32 * ks);
    ml_stage_store(nullptr, vT, nullptr, false, tid, rk, rv);
    __syncthreads();
    const float Mt = fmaxf(mc, pmS[trow]), bt = bS[trow], dec = __expf(mc - Mt);
    float A[4][4]; float rsum = 0.f;
#pragma unroll
    for (int T = 0; T < 4; ++T) {
        f32x4 a = (f32x4){0.f, 0.f, 0.f, 0.f};
#pragma unroll
        for (int ks = 0; ks < 4; ++ks) a = MFMA16(kfr[T][ks], qf[ks], a);
#pragma unroll
        for (int i = 0; i < 4; ++i) { const int ss = 32 * (T >> 1) + 8 * fq + 4 * (T & 1) + i; const float v = ss <= trow ? __expf(dS[ss] - Mt) * a[i] * 0.08838834764831845f : 0.f; A[T][i] = v; rsum += v; }
    }
    bf16x8 ctg[4][4];
#pragma unroll
    for (int dt = 0; dt < 4; ++dt)
#pragma unroll
        for (int ks = 0; ks < 4; ++ks) ctg[dt][ks] = *(const bf16x8*)(ctp + (size_t)(16 * (dt + 4)) * 128 + 32 * ks);
    rsum = fq_sum(rsum);
    bf16x8 af[2];
#pragma unroll
    for (int u = 0; u < 2; ++u) { u32x4 w; w.x = pk2(A[2 * u][0], A[2 * u][1]); w.y = pk2(A[2 * u][2], A[2 * u][3]); w.z = pk2(A[2 * u + 1][0], A[2 * u + 1][1]); w.w = pk2(A[2 * u + 1][2], A[2 * u + 1][3]); af[u] = __builtin_bit_cast(bf16x8, w); }
    float qn = 0.f;
#pragma unroll
    for (int ks = 0; ks < 4; ++ks) { const u32x4 w = __builtin_bit_cast(u32x4, qf[ks]); const LAS float* np = nS + 32 * ks + 8 * fq;
        qn += bflo(w.x) * np[0] + bfhi(w.x) * np[1] + bflo(w.y) * np[2] + bfhi(w.y) * np[3] + bflo(w.z) * np[4] + bfhi(w.z) * np[5] + bflo(w.w) * np[6] + bfhi(w.w) * np[7]; }
    qn = fq_sum(qn);
    const float den = rsum + dec * qn, dnm = fmaxf(fabsf(den), __expf(-(bt + Mt))), inv = 1.0f / dnm;
    f32x4 acc[8];
    float ssq = 0.f;
#pragma unroll
    for (int dt = 0; dt < 8; ++dt) {
        f32x4 a = (f32x4){0.f, 0.f, 0.f, 0.f};
#pragma unroll
        for (int ks = 0; ks < 4; ++ks) a = MFMA16(dt < 4 ? ctf[dt][ks] : ctg[dt - 4 < 0 ? 0 : dt - 4][ks], qf[ks], a);
        a = a * dec;
#pragma unroll
        for (int u = 0; u < 2; ++u) a = MFMA16(*(LAS bf16x8*)(vT + (128 * dvh + 16 * dt + fr) * 72 + 8 * ((4 * u + fq + 2 * dt + (fr >> 3)) & 7)), af[u], a);
        a = a * inv;
        ssq += (a[0] * a[0] + a[1] * a[1]) + (a[2] * a[2] + a[3] * a[3]);
        acc[dt] = a;
    }
    ssq = fq_sum(ssq);
    if (fq == 0) ssS[wave * 16 + fr] = ssq;
    const size_t trg = (size_t)(64 * c + trow);
    f32x4 ggv[8]; u32x2 owv[8];
#pragma unroll
    for (int dt = 0; dt < 8; ++dt) { const int dv = 128 * dvh + 16 * dt + 4 * fq; ggv[dt] = *(const f32x4*)(outg + h * 256 + dv); owv[dt] = *(const u32x2*)(PROJ + trg * ML_N + 4096 + h * 256 + dv); }
    __syncthreads();
    const float tot = ssS[wave * 16 + fr] + ssS[(wave ^ 4) * 16 + fr];
    const float rs = 1.0f / sqrtf(tot * (1.0f / 256.0f) + EPS);
#pragma unroll
    for (int dt = 0; dt < 8; ++dt) {
        const int dv = 128 * dvh + 16 * dt + 4 * fq;
        const f32x4 gg = ggv[dt];
        const u32x2 ow = owv[dt];
        const float y0 = acc[dt][0] * rs * gg.x * sigmoidf_(bflo(ow.x)), y1 = acc[dt][1] * rs * gg.y * sigmoidf_(bfhi(ow.x));
        const float y2 = acc[dt][2] * rs * gg.z * sigmoidf_(bflo(ow.y)), y3 = acc[dt][3] * rs * gg.w * sigmoidf_(bfhi(ow.y));
        u32x2 w; w.x = pk2(y0, y1); w.y = pk2(y2, y3);
        *(u32x2*)(Y + trg * D_ + h * 256 + dv) = w;
    }
    __syncthreads();
}

#define GAS __attribute__((address_space(1)))
#define XB_TMO      128
#define XB_XCNT(j)  (256  + 64 * (j))
#define XB_XSUB(j)  (1280 + 64 * (j))
#define XB_XGEN(j)  (2304 + 64 * (j))
#define XB_TOP      3328
#define XB_TOPGEN   3392
#define XCD_BAR_WORDS 3456
#define XB_SPIN_CAP (1u << 18)

__device__ __forceinline__ unsigned xb_ld(unsigned* p)              { return __hip_atomic_load(p, __ATOMIC_RELAXED, __HIP_MEMORY_SCOPE_AGENT); }
__device__ __forceinline__ unsigned xb_add(unsigned* p, unsigned v) { return __hip_atomic_fetch_add(p, v, __ATOMIC_RELAXED, __HIP_MEMORY_SCOPE_AGENT); }
__device__ __forceinline__ unsigned xb_xcc_id() { return (unsigned)__builtin_amdgcn_s_getreg((3 << 11) | 20) & 0xFu; }
#define XB_SPIN(cond, bar) do { unsigned _sp = 0; while (cond) { __builtin_amdgcn_s_sleep(1); \
    if ((++_sp & 255u) == 0u) { if (xb_ld(&(bar)[XB_TMO])) break; if (_sp > XB_SPIN_CAP) { atomicAdd(&(bar)[XB_TMO], 1u); break; } } } } while (0)

struct XcdBarrier {
    unsigned* bar; unsigned x;
    volatile LAS unsigned* st;
};

__device__ __forceinline__ XcdBarrier xcd_barrier_post(unsigned* bar, volatile LAS unsigned* st) {
    XcdBarrier b; b.bar = bar; b.x = xb_xcc_id(); b.st = st;
    if (threadIdx.x == 0) (void)xb_add(&bar[XB_XCNT(b.x)], 1u);
    return b;
}
__device__ __forceinline__ void xcd_barrier_complete(unsigned* bar, unsigned x, unsigned& nloc, unsigned& nx) {
    const unsigned G = gridDim.x * gridDim.y * gridDim.z;
    unsigned sum, cnt, mine, sp = 0u;
    for (;;) {
        sum = 0u; cnt = 0u; mine = 0u;
#pragma unroll
        for (unsigned j = 0; j < 16; ++j) { const unsigned c = xb_ld(&bar[XB_XCNT(j)]); sum += c; cnt += (c > 0u) ? 1u : 0u; mine = (j == x) ? c : mine; }
        if (sum == G) break;
        __builtin_amdgcn_s_sleep(1);
        if ((++sp & 255u) == 0u) { if (xb_ld(&bar[XB_TMO])) break; if (sp > XB_SPIN_CAP) { atomicAdd(&bar[XB_TMO], 1u); break; } }
    }
    nloc = mine > 0u ? mine : 1u; nx = cnt > 0u ? cnt : 1u;
}

__device__ __forceinline__ void xcd_barrier(const XcdBarrier& b) {
    asm volatile("s_waitcnt vmcnt(0)" ::: "memory");
    __syncthreads();
    if (threadIdx.x == 0) {
        unsigned* bar = b.bar;
        __builtin_amdgcn_s_waitcnt(0);
        unsigned nloc = b.st[0], nx = b.st[1];
        if (nloc == 0u) { xcd_barrier_complete(bar, b.x, nloc, nx); b.st[0] = nloc; b.st[1] = nx; }
        const unsigned old = xb_add(&bar[XB_XSUB(b.x)], 1u);
        const unsigned gen = old / nloc;
        if (old + 1u == (gen + 1u) * nloc) {
            __builtin_amdgcn_fence(__ATOMIC_RELEASE, "agent");
            asm volatile("s_waitcnt vmcnt(0)" ::: "memory");
            const unsigned og = xb_add(&bar[XB_TOP], 1u);
            const unsigned tg = og / nx;
            if (og + 1u == (tg + 1u) * nx) xb_add(&bar[XB_TOPGEN], 1u);
            else XB_SPIN(xb_ld(&bar[XB_TOPGEN]) == tg, bar);
            __builtin_amdgcn_fence(__ATOMIC_ACQUIRE, "agent");
            xb_add(&bar[XB_XGEN(b.x)], 1u);
            asm volatile("s_waitcnt vmcnt(0)" ::: "memory");
        } else {
            XB_SPIN(xb_ld(&bar[XB_XGEN(b.x)]) == gen, bar);
            __builtin_amdgcn_fence(__ATOMIC_ACQUIRE, "agent");
            asm volatile("s_waitcnt vmcnt(0)" ::: "memory");
        }
    }
    __syncthreads();
}

#ifndef REP_UP
#define REP_UP 1
#endif
#ifndef REP_P0
#define REP_P0 1
#endif
#ifndef REP_CMP
#define REP_CMP 1
#endif
#ifndef REP_ATTN
#define REP_ATTN 1
#endif
#ifndef REP_MLL
#define REP_MLL 1
#endif
#ifndef REP_MLO
#define REP_MLO 1
#endif
__global__ void __launch_bounds__(NTHR, 2) fwd_kernel(Args args) {
    extern __shared__ __attribute__((aligned(16))) unsigned char lds_raw[];
    LAS unsigned char* lds = (LAS unsigned char*)lds_raw;
    cg::grid_group grid = cg::this_grid();
    volatile LAS unsigned* bar_st = (volatile LAS unsigned*)(lds + LDS_BYTES - 64);
    if (threadIdx.x == 0) { bar_st[0] = 0u; bar_st[1] = 0u; }
    __syncthreads();
    XcdBarrier xbar; xbar.bar = (unsigned*)(args.ws + WS_MISC); xbar.x = 0; xbar.st = nullptr;
    if (args.ph_hi - args.ph_lo > 1) xbar = xcd_barrier_post((unsigned*)(args.ws + WS_MISC), bar_st);
    const int wave0 = __builtin_amdgcn_readfirstlane((int)(threadIdx.x >> 6));
    const int G0 = gridDim.x, bid0 = blockIdx.x;
    const int lo = args.ph_lo, hi = args.ph_hi;
#define X (args.out)
#define XN ((bf16_t*)(ws + WS_XN))
#define XBS ((bf16_t*)(ws + WS_XB))
#define Yb ((bf16_t*)(ws + WS_XN))
#define PROJ ((bf16_t*)(ws + WS_PROJ))
#define Hb ((bf16_t*)(ws + WS_PROJ))
#define nb (ws + WS_NSAW + j * NSAW_STRIDE)
#define mb (ws + WS_MLW + j * MLW_STRIDE)
#define KS ((bf16_t*)(ws + WS_EXT + EXT_KS))
#define KW ((bf16_t*)(ws + WS_EXT + EXT_KW))
#define VTS ((bf16_t*)(ws + WS_EXT + EXT_VTS))
#define VTW ((bf16_t*)(ws + WS_EXT + EXT_VTW))
#define KC ((bf16_t*)(ws + WS_EXT + EXT_KC))
#define VTC ((bf16_t*)(ws + WS_EXT + EXT_VTC))
#define CT ((bf16_t*)(ws + WS_EXT + EXT_CT))
#define NT ((float*)(ws + WS_EXT + EXT_NT))
#define CI ((float*)(ws + WS_EXT + EXT_CI))
#define MC ((float*)(ws + WS_EXT + EXT_MC))
#define bif (args.in[13] + j * 16)
    int ph = 0;
#define PHASE_BEGIN if (lo <= ph && ph < hi) { int bid = bid0, G = G0; asm volatile("" : "+s"(bid), "+s"(G)); const int NGW = G * NWAVES; int tid = wave0 * 64 + (int)__builtin_amdgcn_mbcnt_hi(~0u, __builtin_amdgcn_mbcnt_lo(~0u, 0u)); asm volatile("" : "+v"(tid)); const int lane = tid & 63; const int wave = __builtin_amdgcn_readfirstlane(tid >> 6); const int gw = bid * NWAVES + wave; unsigned char* ws = args.ws; asm volatile("" : "+s"(ws));
#define PHASE_END if (ph + 1 < hi) { if (hi == 0x7fffffff) grid.sync(); else xcd_barrier(xbar); } } ++ph;

    PHASE_BEGIN
    {
        LAS float* scr = (LAS float*)(lds + wave * 17408);
        for (int rep_ = 0; rep_ < REP_P0; ++rep_) {
        int rot = 0;
#pragma unroll 1
        for (int l = 0; l < 4; ++l) {
            bf16_t* wgu = (bf16_t*)(ws + WS_FFN + l * FFN_STRIDE); bf16_t* wd = (bf16_t*)(ws + WS_FFN + l * FFN_STRIDE + FFN_WD);
            tr_matrix(args.in[16] + (size_t)l * D_ * DFF, D_, DFF, wgu, 1, 0, scr, gw, NGW, lane, rot);
            tr_matrix(args.in[17] + (size_t)l * D_ * DFF, D_, DFF, wgu, 1, 128, scr, gw, NGW, lane, rot);
            tr_matrix(args.in[18] + (size_t)l * DFF * D_, DFF, D_, wd, 0, 0, scr, gw, NGW, lane, rot);
        }
#pragma unroll 1
        for (int j = 0; j < 2; ++j) {
            tr_matrix(args.in[3] + (size_t)j * D_ * NSA_IN, D_, NSA_IN, (bf16_t*)nb, 0, 0, scr, gw, NGW, lane, rot);
            tr_matrix(args.in[11] + (size_t)j * D_ * D_, D_, D_, (bf16_t*)(nb + NSAW_OUT), 0, 0, scr, gw, NGW, lane, rot);
            tr_matrix(args.in[8] + (size_t)(j * 2 + 0) * 4096 * 128, 4096, 128, (bf16_t*)(nb + NSAW_W1), 0, 0, scr, gw, NGW, lane, rot);
            tr_matrix(args.in[8] + (size_t)(j * 2 + 1) * 4096 * 128, 4096, 128, (bf16_t*)(nb + NSAW_W1) + 128 * 4096, 0, 0, scr, gw, NGW, lane, rot);
            tr_matrix(args.in[10] + (size_t)(j * 2 + 0) * 128 * 128, 128, 128, (bf16_t*)(nb + NSAW_W2), 0, 0, scr, gw, NGW, lane, rot);
            tr_matrix(args.in[10] + (size_t)(j * 2 + 1) * 128 * 128, 128, 128, (bf16_t*)(nb + NSAW_W2) + 128 * 128, 0, 0, scr, gw, NGW, lane, rot);
            tr_matrix(args.in[12] + (size_t)j * D_ * ML_IN, D_, ML_IN, (bf16_t*)mb, 0, 0, scr, gw, NGW, lane, rot);
            tr_matrix(args.in[15] + (size_t)j * D_ * D_, D_, D_, (bf16_t*)(mb + MLW_OUT), 0, 0, scr, gw, NGW, lane, rot);
        }
        }
        rmsnorm_phase(args.in[0], args.in[1], XN, nullptr, gw, NGW, lane);
    }
    PHASE_END

#pragma unroll 1
    for (int i = 0; i < 4; ++i) {
        const int j = i >> 1;
        if (i > 0) {
            PHASE_BEGIN
            rmsnorm_bf16_phase(XBS, args.in[1] + i * D_, XN, gw, NGW, lane);
            PHASE_END
        }
        if ((i & 1) == 0) {
            PHASE_BEGIN
            for (int tb = bid; tb < 256; tb += G) gate_gemm<3>(XN, (const bf16_t*)nb + (size_t)5120 * D_, PROJ, NSA_N, 5120, tb, lds, tid, wave, lane);
            { pg8::Gemm g{XN, (const bf16_t*)nb, S_, 5120, D_}; pg8::StaticOrder So; So.init(S_, 5120, G, bid); pg8::EpiStore E{PROJ, NSA_N};
              pg8::gemm_phase<pg8::EpiStore, pg8::StaticOrder, true, true>(lds, g, So, E, tid); }
            PHASE_END
            PHASE_BEGIN
            for (int tb = bid; tb < 256; tb += G) nsa_prep_unit(tb, PROJ, args.in[5] + j * 128, args.in[6] + j * 384, KS, KW, VTS, VTW, tid);
            for (int rep_ = 0; rep_ < REP_CMP; ++rep_)
            for (int task = bid; task < 256; task += G)
                nsa_compress_unit(task, PROJ, args.in[7] + (size_t)j * 2 * 32 * 128, (const bf16_t*)(nb + NSAW_W1), args.in[9] + j * 256, (const bf16_t*)(nb + NSAW_W2), args.in[6] + j * 384, KC, VTC, lds, tid, wave, lane);
            PHASE_END
            PHASE_BEGIN
            for (int rep_ = 0; rep_ < REP_ATTN; ++rep_)
            for (int task = bid; task < 1024; task += G) {
                const int k = task >> 8, bb = task & 255, xg = bb & 3, half = (bb >> 2) & 1, wi = bb >> 3;
                const int qb = half == 0 ? (k == 0 ? wi : k == 1 ? 127 - wi : k == 2 ? 128 + wi : 255 - wi) : (k == 0 ? 32 + wi : k == 1 ? 95 - wi : k == 2 ? 160 + wi : 223 - wi);
                nsa_attn_wg(qb, xg, PROJ, args.in[4] + j * 48, KC, VTC, KS, VTS, KW, VTW, Yb, lds, tid, wave, lane);
            }
            PHASE_END
            PHASE_BEGIN
            { pg8::Gemm g{Yb, (const bf16_t*)(nb + NSAW_OUT), S_, D_, D_}; pg8::StaticOrder So; So.init(S_, D_, G, bid); pg8::EpiResid E{i == 0 ? args.in[0] : (const float*)nullptr, XBS, nullptr, D_};
              pg8::gemm_phase<pg8::EpiResid, pg8::StaticOrder, true, true>(lds, g, So, E, tid); }
            PHASE_END
        } else {
            PHASE_BEGIN
            for (int tb = bid; tb < 256; tb += G) gate_gemm<1>(XN, (const bf16_t*)mb + (size_t)6144 * D_, PROJ, ML_N, 6144, tb, lds, tid, wave, lane);
            { pg8::Gemm g{XN, (const bf16_t*)mb, S_, 6144, D_}; pg8::StaticOrder So; So.init(S_, 6144, G, bid); pg8::EpiStore E{PROJ, ML_N};
              pg8::gemm_phase<pg8::EpiStore, pg8::StaticOrder, true, true>(lds, g, So, E, tid); }
            PHASE_END
            PHASE_BEGIN
            ml_local_phase(bid, G, PROJ, bif, CT, NT, CI, lds, tid, wave, lane);
            PHASE_END
            PHASE_BEGIN
            for (int u = bid; u < 256; u += G) ml_scan_unit(u, CT, NT, CI, MC, lds, tid);
            PHASE_END
            PHASE_BEGIN
            for (int rep_ = 0; rep_ < REP_MLO; ++rep_)
            for (int u = bid; u < 2048; u += G) ml_out_unit(u, PROJ, bif, args.in[14] + j * D_, CT, NT, MC, Yb, lds, tid, wave, lane);
            PHASE_END
            PHASE_BEGIN
            { pg8::Gemm g{Yb, (const bf16_t*)(mb + MLW_OUT), S_, D_, D_}; pg8::StaticOrder So; So.init(S_, D_, G, bid); pg8::EpiResid E{nullptr, XBS, nullptr, D_};
              pg8::gemm_phase<pg8::EpiResid, pg8::StaticOrder, true, true>(lds, g, So, E, tid); }
            PHASE_END
        }
        PHASE_BEGIN
        rmsnorm_bf16_phase(XBS, args.in[2] + i * D_, XN, gw, NGW, lane);
        PHASE_END
        PHASE_BEGIN
        for (int rep_ = 0; rep_ < REP_UP; ++rep_)
        { pg8::Gemm g{XN, (const bf16_t*)(ws + WS_FFN + i * FFN_STRIDE), S_, 2 * DFF, D_}; pg8::StaticOrder So; So.init(S_, 2 * DFF, G, bid); pg8::EpiSwiglu E{Hb, DFF};
          pg8::gemm_phase<pg8::EpiSwiglu, pg8::StaticOrder, true, true>(lds, g, So, E, tid); }
        PHASE_END
        PHASE_BEGIN
        { pg8::Gemm g{Hb, (const bf16_t*)(ws + WS_FFN + i * FFN_STRIDE + FFN_WD), S_, D_, DFF}; pg8::StaticOrder So; So.init(S_, D_, G, bid); pg8::EpiResid E{nullptr, XBS, i == 3 ? X : (float*)nullptr, D_};
          pg8::gemm_phase<pg8::EpiResid, pg8::StaticOrder, true, true>(lds, g, So, E, tid); }
        PHASE_END
    }
}

#ifndef ONE_LAUNCH
#define ONE_LAUNCH 0
#endif
extern "C" void kernel_launch(void* const* d_in, const int* in_sizes, int n_in, void* d_out, int out_size, void* d_ws, size_t ws_size, hipStream_t stream) {
    static int grid = 0;
    if (grid == 0) {
        if (n_in != 19 || out_size != S_ * D_ || ws_size < WS_END) { fprintf(stderr, "kernel_launch: unexpected shapes n_in %d out %d ws %zu\n", n_in, out_size, ws_size); grid = -1; return; }
        int dev = 0, cus = 0, per_cu = 0;
        hipGetDevice(&dev); hipDeviceGetAttribute(&cus, hipDeviceAttributeMultiprocessorCount, dev);
        if (hipFuncSetAttribute((const void*)fwd_kernel, hipFuncAttributeMaxDynamicSharedMemorySize, LDS_BYTES) != hipSuccess) { fprintf(stderr, "kernel_launch: hipFuncSetAttribute failed\n"); grid = -1; return; }
        if (hipOccupancyMaxActiveBlocksPerMultiprocessor(&per_cu, (const void*)fwd_kernel, NTHR, LDS_BYTES) != hipSuccess || per_cu < 1) { fprintf(stderr, "kernel_launch: occupancy query says %d\n", per_cu); per_cu = 1; }
        (void)hipGetLastError();
        grid = cus;
        if (grid != 256) fprintf(stderr, "kernel_launch: %d CUs\n", grid);
    }
    if (grid < 0) return;
    Args a{};
    for (int i = 0; i < 19; ++i) a.in[i] = (const float*)d_in[i];
    a.out = (float*)d_out; a.ws = (unsigned char*)d_ws;
#if ONE_LAUNCH
    if (hipMemsetAsync((char*)d_ws + WS_MISC, 0, 16384, stream) != hipSuccess) { fprintf(stderr, "kernel_launch: memset failed\n"); return; }
    a.ph_lo = 0; a.ph_hi = NPH;
    void* kargs[] = {&a};
    hipError_t e = hipLaunchCooperativeKernel((const void*)fwd_kernel, dim3(grid), dim3(NTHR), kargs, LDS_BYTES, stream);
    if (e != hipSuccess) fprintf(stderr, "cooperative launch failed: %s (grid %d)\n", hipGetErrorString(e), grid);
#else
    for (int p = 0; p < NPH; ++p) {
        a.ph_lo = p; a.ph_hi = p + 1;
        hipLaunchKernelGGL(fwd_kernel, dim3(grid), dim3(NTHR), LDS_BYTES, stream, a);
    }
#endif
}
```

```cpp
#include <hip/hip_runtime.h>
#include <hip/hip_cooperative_groups.h>
#include <cstdio>
#include <cstdint>
#define ONE_LAUNCH 1
namespace pg8 {
#define PG8_LAS __attribute__((address_space(3)))
typedef unsigned short bf16_t;
typedef short bf16x8 __attribute__((ext_vector_type(8)));
typedef float f32x4 __attribute__((ext_vector_type(4)));
typedef unsigned u32x4 __attribute__((ext_vector_type(4)));
constexpr int BM = 256, BK = 64, HALF = 128, HTB = HALF * BK * 2  , STAGE_BYTES = 8 * HTB, NXCD = 8, WGM = 2;

__host__ __device__ __forceinline__ int lds_byte(int r, int c) { const int st = (r >> 4) * 2 + (c >> 5), rr = r & 15, cc = c & 31, ob = rr * 64 + cc * 2; return st * 1024 + (ob ^ (((ob >> 9) & 1) << 5)); }
__host__ __device__ __forceinline__ void stage_rc(int b, int& R, int& C) { const int st = b / 1024, sb = b % 1024, swz = sb ^ (((sb >> 9) & 1) << 5); R = (st >> 1) * 16 + swz / 64; C = (st & 1) * 32 + (swz % 64) / 2; }
__host__ __device__ __forceinline__ int perm32(int rho) { const int n = rho >> 4, i = rho & 15; return 8 * (i >> 2) + 4 * n + (i & 3); }

struct Unit { int pm, pn; };
struct Gemm { const bf16_t* A; const bf16_t* Bt; int M, N, K; };

struct StaticOrder {
    int nM, nN, nwg, G, c;
    __host__ __device__ void init(int M, int N, int G_, int c_) { nM = M / BM; nN = N / BM; nwg = nM * nN; G = G_; c = c_; }
    __host__ __device__ bool next(int i, Unit& u) const {
        const long L = (long)i * G + c; if (L >= nwg) return false;
        int wgid = (int)L; { const int q = nwg / NXCD, r = nwg % NXCD, xcd = wgid % NXCD, off = wgid / NXCD; wgid = (xcd < r ? xcd * (q + 1) : r * (q + 1) + (xcd - r) * q) + off; }
        const int nig = WGM * nN, gid = wgid / nig, fm = gid * WGM, gsz = (nM - fm) < WGM ? (nM - fm) : WGM;
        u.pm = fm + ((wgid % nig) % gsz); u.pn = (wgid % nig) / gsz; return true;
    }
    __device__ __forceinline__ void a_ready(const Unit&) const {}
    __device__ __forceinline__ void done(const Unit&) const {}
};
__device__ __forceinline__ unsigned cvt_pk_bf16(float lo, float hi) { unsigned r; asm volatile("v_cvt_pk_bf16_f32 %0, %1, %2" : "=v"(r) : "v"(lo), "v"(hi)); return r; }
typedef float f32x2e __attribute__((ext_vector_type(2))); typedef unsigned u32x2e __attribute__((ext_vector_type(2))); typedef __bf16 bf16x2e __attribute__((ext_vector_type(2)));
__device__ __forceinline__ unsigned pk2(float lo, float hi) { f32x2e v = {lo, hi}; bf16x2e b = __builtin_convertvector(v, bf16x2e); return __builtin_bit_cast(unsigned, b); }
struct EpiStore {
    static constexpr bool PERM = true, AFTER_DRAIN = false;
    bf16_t* O; int ldc;
    __device__ __forceinline__ void operator()(const f32x4 (&acc)[2][2][4][2], const Unit& u, int wr, int wc, int fr, int fq) const {
        const int row0 = u.pm * BM + wr * 64 + fr, col0 = u.pn * BM + wc * 32 + 8 * fq;
#pragma unroll
        for (int ai = 0; ai < 2; ++ai)
#pragma unroll
            for (int m = 0; m < 4; ++m) { bf16_t* rowp = O + (size_t)(row0 + ai * HALF + m * 16) * ldc + col0;
#pragma unroll
                for (int bj = 0; bj < 2; ++bj) { const f32x4 v0 = acc[ai][bj][m][0], v1 = acc[ai][bj][m][1];
                    u32x4 w; w.x = pk2(v0[0], v0[1]); w.y = pk2(v0[2], v0[3]); w.z = pk2(v1[0], v1[1]); w.w = pk2(v1[2], v1[3]);
                    *(u32x4*)(rowp + bj * HALF) = w; } }
    }
};
struct EpiSwiglu {
    static constexpr bool PERM = true, AFTER_DRAIN = false;
    bf16_t* H; int ldc;
    __device__ __forceinline__ void operator()(const f32x4 (&acc)[2][2][4][2], const Unit& u, int wr, int wc, int fr, int fq) const {
        const int row0 = u.pm * BM + wr * 64 + fr, col0 = u.pn * HALF + wc * 32 + 8 * fq;
#pragma unroll
        for (int ai = 0; ai < 2; ++ai)
#pragma unroll
            for (int m = 0; m < 4; ++m) { bf16_t* rowp = H + (size_t)(row0 + ai * HALF + m * 16) * ldc + col0;
                float h[8];
#pragma unroll
                for (int n = 0; n < 2; ++n)
#pragma unroll
                    for (int e = 0; e < 4; ++e) { const float g = acc[ai][0][m][n][e], up = acc[ai][1][m][n][e];
                        h[n * 4 + e] = g * up * __builtin_amdgcn_rcpf(1.0f + __builtin_amdgcn_exp2f(-1.4426950408889634f * g)); }
                u32x4 w; w.x = pk2(h[0], h[1]); w.y = pk2(h[2], h[3]); w.z = pk2(h[4], h[5]); w.w = pk2(h[6], h[7]);
                *(u32x4*)rowp = w; }
    }
};
struct EpiResid {
    static constexpr bool PERM = true, AFTER_DRAIN = false;
    const float* Xf_in; bf16_t* Xb; float* Xf_out; int ldc;
    __device__ __forceinline__ void operator()(const f32x4 (&acc)[2][2][4][2], const Unit& u, int wr, int wc, int fr, int fq) const {
        const int row0 = u.pm * BM + wr * 64 + fr, col0 = u.pn * BM + wc * 32 + 8 * fq;
#pragma unroll
        for (int ai = 0; ai < 2; ++ai)
#pragma unroll
            for (int mp = 0; mp < 2; ++mp) {
                f32x4 pre[2][2][2];
#pragma unroll
                for (int mm = 0; mm < 2; ++mm) { const size_t off = (size_t)(row0 + ai * HALF + (2 * mp + mm) * 16) * ldc + col0;
#pragma unroll
                    for (int bj = 0; bj < 2; ++bj) {
                        if (Xf_in) { pre[mm][bj][0] = *(const f32x4*)(Xf_in + off + bj * HALF); pre[mm][bj][1] = *(const f32x4*)(Xf_in + off + bj * HALF + 4); }
                        else { const u32x4 w = *(const u32x4*)(Xb + off + bj * HALF);
                               pre[mm][bj][0] = (f32x4){__uint_as_float(w.x << 16), __uint_as_float(w.x & 0xffff0000u), __uint_as_float(w.y << 16), __uint_as_float(w.y & 0xffff0000u)};
                               pre[mm][bj][1] = (f32x4){__uint_as_float(w.z << 16), __uint_as_float(w.z & 0xffff0000u), __uint_as_float(w.w << 16), __uint_as_float(w.w & 0xffff0000u)}; } } }
#pragma unroll
                for (int mm = 0; mm < 2; ++mm) { const size_t off = (size_t)(row0 + ai * HALF + (2 * mp + mm) * 16) * ldc + col0;
#pragma unroll
                    for (int bj = 0; bj < 2; ++bj) { const f32x4 v0 = pre[mm][bj][0] + acc[ai][bj][2 * mp + mm][0], v1 = pre[mm][bj][1] + acc[ai][bj][2 * mp + mm][1];
                        if (!Xf_out) { u32x4 w; w.x = pk2(v0[0], v0[1]); w.y = pk2(v0[2], v0[3]); w.z = pk2(v1[0], v1[1]); w.w = pk2(v1[2], v1[3]); *(u32x4*)(Xb + off + bj * HALF) = w; }
                        if (Xf_out) { *(f32x4*)(Xf_out + off + bj * HALF) = v0; *(f32x4*)(Xf_out + off + bj * HALF + 4) = v1; } } }
                asm volatile("" ::: "memory");
            }
    }
};
template <class Epi, class Sched, bool ALIGN_EPI = false, bool SP2 = false>
__device__ __forceinline__ void gemm_phase(PG8_LAS unsigned char* lds, const Gemm g, const Sched& S, const Epi& E, int tid_in) {
    int tid_l = tid_in; asm volatile("" : "+v"(tid_l)); const int tid = tid_l, wid = __builtin_amdgcn_readfirstlane(tid >> 6), lane = tid & 63, wr = wid >> 2, wc = wid & 3, fr = lane & 15, fq = lane >> 4;
    const int K = g.K, nt = K / BK;
    unsigned voffA[2], voffB[2];
#pragma unroll
    for (int i = 0; i < 2; ++i) { int R, C; stage_rc(tid * 16 + i * 8192, R, C); const int Rb = Epi::PERM ? ((R & ~31) + perm32(R & 31)) : R;
        voffA[i] = (unsigned)(R * K + C) * 2u; voffB[i] = (unsigned)(Rb * K + C) * 2u; }
    const size_t kstep = (size_t)(BK * 2);
    const size_t hstep = (size_t)HALF * K * 2;
    const size_t tstep = 2 * hstep;
    const unsigned ldsw = (unsigned)wid * 1024u;
    const int aoff = lds_byte(wr * 64 + fr, fq * 8), boff = lds_byte(wc * 32 + fr, fq * 8);
#define PG8_SA(b, h) (((b) * 2 + (h)) * HTB)
#define PG8_SB(b, h) ((4 + (b) * 2 + (h)) * HTB)
#define PG8_STAGE(bufoff, gbase, voff) do { _Pragma("unroll") for (int _i = 0; _i < 2; ++_i) \
        __builtin_amdgcn_global_load_lds((const unsigned*)((const char*)(gbase) + (voff)[_i]), (PG8_LAS unsigned*)(lds + (bufoff) + ldsw + _i * 8192), 16, 0, 0); } while (0)
#define PG8_LDA(dst, b, h) do { _Pragma("unroll") for (int m = 0; m < 4; ++m) _Pragma("unroll") for (int k = 0; k < 2; ++k) dst[m][k] = *(const PG8_LAS bf16x8*)(lds + PG8_SA(b, h) + aoff + m * 2048 + k * 1024); } while (0)
#define PG8_LDB(dst, b, h) do { _Pragma("unroll") for (int n = 0; n < 2; ++n) _Pragma("unroll") for (int k = 0; k < 2; ++k) dst[n][k] = *(const PG8_LAS bf16x8*)(lds + PG8_SB(b, h) + boff + n * 2048 + k * 1024); } while (0)
#define PG8_MMA(ai, bj, At, Bt) do { __builtin_amdgcn_s_setprio(1); _Pragma("unroll") for (int m = 0; m < 4; ++m) _Pragma("unroll") for (int n = 0; n < 2; ++n) _Pragma("unroll") for (int k = 0; k < 2; ++k) \
        acc[ai][bj][m][n] = __builtin_amdgcn_mfma_f32_16x16x32_bf16(Bt[n][k], At[m][k], acc[ai][bj][m][n], 0, 0, 0); __builtin_amdgcn_s_setprio(0); } while (0)
#define PG8_WAIT_V(n) asm volatile("s_waitcnt vmcnt(" #n ")" ::: "memory")
#define PG8_WAIT_L(n) asm volatile("s_waitcnt lgkmcnt(" #n ")" ::: "memory")
#define PG8_BAR __builtin_amdgcn_s_barrier()
#define PG8_SCHED __builtin_amdgcn_sched_barrier(0)
    Unit cur, nxt; int ui = 0;
    if (!S.next(0, cur)) return;
    f32x4 acc[2][2][4][2];
#pragma unroll
    for (int a = 0; a < 2; ++a)
#pragma unroll
        for (int b = 0; b < 2; ++b)
#pragma unroll
            for (int m = 0; m < 4; ++m)
#pragma unroll
                for (int n = 0; n < 2; ++n) acc[a][b][m][n] = (f32x4){0.f, 0.f, 0.f, 0.f};
    bf16x8 At[4][2], B0[2][2], B1[2][2];
    const char* cA = (const char*)g.A + (size_t)cur.pm * tstep; const char* cB = (const char*)g.Bt + (size_t)cur.pn * tstep;
    S.a_ready(cur);
    if constexpr (SP2) {
        PG8_STAGE(PG8_SB(0, 0), cB, voffB); PG8_STAGE(PG8_SB(0, 1), cB + hstep, voffB); PG8_STAGE(PG8_SA(0, 0), cA, voffA); PG8_STAGE(PG8_SA(0, 1), cA + hstep, voffA);
        if (wr == 1) PG8_BAR;
        PG8_WAIT_V(2); PG8_BAR;
        PG8_STAGE(PG8_SB(1, 0), cB + kstep, voffB); PG8_STAGE(PG8_SA(1, 0), cA + kstep, voffA); PG8_STAGE(PG8_SB(1, 1), cB + hstep + kstep, voffB);
        PG8_WAIT_V(6); PG8_BAR;
    } else {
        PG8_STAGE(PG8_SB(0, 0), cB, voffB); PG8_STAGE(PG8_SA(0, 0), cA, voffA); PG8_STAGE(PG8_SB(0, 1), cB + hstep, voffB); PG8_STAGE(PG8_SA(0, 1), cA + hstep, voffA);
        if (wr == 1) PG8_BAR;
        PG8_WAIT_V(4); PG8_BAR;
        PG8_STAGE(PG8_SB(1, 0), cB + kstep, voffB); PG8_STAGE(PG8_SA(1, 0), cA + kstep, voffA); PG8_STAGE(PG8_SB(1, 1), cB + hstep + kstep, voffB);
        PG8_WAIT_V(6); PG8_BAR;
    }
    for (;;) {
        const bool has_next = S.next(ui + 1, nxt);
        const char* nA = has_next ? (const char*)g.A + (size_t)nxt.pm * tstep : cA; const char* nB = has_next ? (const char*)g.Bt + (size_t)nxt.pn * tstep : cB;
        for (int t = 0; t < nt; t += 2) {
            const bool last = (t == nt - 2);
            const char* a1 = cA + (size_t)(t + 1) * kstep;
            const char* a2 = last ? nA : cA + (size_t)(t + 2) * kstep; const char* b2 = last ? nB : cB + (size_t)(t + 2) * kstep;
            const char* a3 = a2 + kstep; const char* b3 = b2 + kstep;
            if (last && has_next) S.a_ready(nxt);
            if constexpr (SP2) {
            PG8_LDB(B0, 0, 0); PG8_LDB(B1, 0, 1); PG8_SCHED; PG8_LDA(At, 0, 0); PG8_STAGE(PG8_SA(1, 1), a1 + hstep, voffA);
            PG8_WAIT_V(8); PG8_WAIT_L(0); PG8_BAR; PG8_MMA(0, 0, At, B0); PG8_MMA(0, 1, At, B1); PG8_BAR; PG8_SCHED;
            PG8_LDA(At, 0, 1); PG8_STAGE(PG8_SB(0, 0), b2, voffB); PG8_STAGE(PG8_SB(0, 1), b2 + hstep, voffB); PG8_STAGE(PG8_SA(0, 0), a2, voffA);
            PG8_WAIT_V(8); PG8_WAIT_L(0); PG8_BAR; PG8_MMA(1, 0, At, B0); PG8_MMA(1, 1, At, B1); PG8_BAR; PG8_SCHED;
            PG8_LDB(B0, 1, 0); PG8_LDB(B1, 1, 1); PG8_SCHED; PG8_LDA(At, 1, 0); PG8_STAGE(PG8_SA(0, 1), a2 + hstep, voffA);
            PG8_WAIT_V(8); PG8_WAIT_L(0); PG8_BAR; PG8_MMA(0, 0, At, B0); PG8_MMA(0, 1, At, B1); PG8_BAR; PG8_SCHED;
            PG8_LDA(At, 1, 1); PG8_STAGE(PG8_SB(1, 0), b3, voffB); PG8_STAGE(PG8_SB(1, 1), b3 + hstep, voffB); PG8_STAGE(PG8_SA(1, 0), a3, voffA);
            PG8_WAIT_V(8); PG8_WAIT_L(0); PG8_BAR; PG8_MMA(1, 0, At, B0); PG8_MMA(1, 1, At, B1); PG8_BAR; PG8_SCHED;
            } else {
            PG8_LDB(B0, 0, 0); PG8_SCHED; PG8_LDA(At, 0, 0); PG8_STAGE(PG8_SA(1, 1), a1 + hstep, voffA);
            PG8_WAIT_L(8); PG8_BAR; PG8_WAIT_L(0); PG8_MMA(0, 0, At, B0); PG8_BAR; PG8_SCHED;
            PG8_LDB(B1, 0, 1); PG8_STAGE(PG8_SB(0, 0), b2, voffB);
            PG8_BAR; PG8_WAIT_L(0); PG8_MMA(0, 1, At, B1); PG8_BAR;
            PG8_LDA(At, 0, 1); PG8_STAGE(PG8_SA(0, 0), a2, voffA);
            PG8_BAR; PG8_WAIT_L(0); PG8_MMA(1, 0, At, B0); PG8_BAR; PG8_SCHED;
            PG8_STAGE(PG8_SB(0, 1), b2 + hstep, voffB);
            PG8_WAIT_V(6); PG8_BAR; PG8_MMA(1, 1, At, B1); PG8_BAR;
            PG8_LDB(B0, 1, 0); PG8_SCHED; PG8_LDA(At, 1, 0); PG8_STAGE(PG8_SA(0, 1), a2 + hstep, voffA);
            PG8_WAIT_L(8); PG8_BAR; PG8_WAIT_L(0); PG8_MMA(0, 0, At, B0); PG8_BAR; PG8_SCHED;
            PG8_LDB(B1, 1, 1); PG8_STAGE(PG8_SB(1, 0), b3, voffB);
            PG8_BAR; PG8_WAIT_L(0); PG8_MMA(0, 1, At, B1); PG8_BAR;
            PG8_LDA(At, 1, 1); PG8_STAGE(PG8_SA(1, 0), a3, voffA);
            PG8_BAR; PG8_WAIT_L(0); PG8_MMA(1, 0, At, B0); PG8_BAR; PG8_SCHED;
            PG8_STAGE(PG8_SB(1, 1), b3 + hstep, voffB);
            PG8_WAIT_V(6); PG8_BAR; PG8_MMA(1, 1, At, B1); PG8_BAR;
            }
        }
        if constexpr (ALIGN_EPI) { if (wr == 0) PG8_BAR; }
        if constexpr (!Epi::AFTER_DRAIN) { E(acc, cur, wr, wc, fr, fq); S.done(cur); }
        if (!has_next) break;
#pragma unroll
        for (int a = 0; a < 2; ++a)
#pragma unroll
            for (int b = 0; b < 2; ++b)
#pragma unroll
                for (int m = 0; m < 4; ++m)
#pragma unroll
                    for (int n = 0; n < 2; ++n) acc[a][b][m][n] = (f32x4){0.f, 0.f, 0.f, 0.f};
        cur = nxt; cA = nA; cB = nB; ++ui;
        if constexpr (ALIGN_EPI) { if (wr == 1) PG8_BAR; }
    }
    PG8_WAIT_V(0);
    if constexpr (!ALIGN_EPI) { if (wr == 0) PG8_BAR; }
    PG8_BAR;
    if constexpr (Epi::AFTER_DRAIN) { E.fused(acc, cur, wr, wc, fr, fq, lds, wid, lane); S.done(cur); }
#undef PG8_SA
#undef PG8_SB
#undef PG8_STAGE
#undef PG8_LDA
#undef PG8_LDB
#undef PG8_MMA
#undef PG8_WAIT_V
#undef PG8_WAIT_L
#undef PG8_BAR
#undef PG8_SCHED
}
}
namespace cg = cooperative_groups;
#define LAS __attribute__((address_space(3)))
typedef unsigned short bf16_t;
typedef short bf16x8 __attribute__((ext_vector_type(8)));
typedef float f32x4 __attribute__((ext_vector_type(4)));
typedef unsigned u32x4 __attribute__((ext_vector_type(4)));
typedef unsigned u32x2 __attribute__((ext_vector_type(2)));
#define MFMA16(a, b, c) __builtin_amdgcn_mfma_f32_16x16x32_bf16((a), (b), (c), 0, 0, 0)
using pg8::pk2;

constexpr int S_ = 16384, D_ = 2048, DFF = 5632;
constexpr int NSA_N = 5376, NSA_IN = 5168, ML_N = 6400, ML_IN = 6160;
constexpr float EPS = 1e-6f;
constexpr float QSCALE = 0.08838834764831845f * 1.4426950408889634f;
constexpr float NEG = -1e30f;
constexpr int NWAVES = 8, NTHR = 512, LDS_BYTES = 147456;
constexpr int NPH = 34;

constexpr size_t MiB = 1u << 20;
constexpr size_t WS_MISC = 0, WS_FFN = 1 * MiB, WS_NSAW = 265 * MiB, WS_MLW = 329 * MiB, WS_XN = 400 * MiB, WS_PROJ = 464 * MiB, WS_EXT = 664 * MiB, WS_XB = 800 * MiB, WS_END = 864 * MiB;
constexpr size_t FFN_STRIDE = 66 * MiB, FFN_WD = 44 * MiB;
constexpr size_t NSAW_STRIDE = 32 * MiB, NSAW_OUT = 21 * MiB, NSAW_W1 = 29 * MiB, NSAW_W2 = 31 * MiB;
constexpr size_t MLW_STRIDE = 34 * MiB, MLW_OUT = 25 * MiB;
constexpr size_t EXT_KS = 0, EXT_KW = 16 * MiB, EXT_VTS = 32 * MiB, EXT_VTW = 48 * MiB, EXT_KC = 64 * MiB, EXT_VTC = 65 * MiB;
constexpr size_t EXT_CT = 0, EXT_NT = 128 * MiB, EXT_CI = 129 * MiB, EXT_MC = 129 * MiB + 65536;

struct Args { const float* in[19]; float* out; unsigned char* ws; int ph_lo, ph_hi; };

__device__ __forceinline__ float bf2f(unsigned short b) { return __uint_as_float(((unsigned)b) << 16); }
__device__ __forceinline__ float bflo(unsigned w) { return __uint_as_float(w << 16); }
__device__ __forceinline__ float bfhi(unsigned w) { return __uint_as_float(w & 0xffff0000u); }
__device__ __forceinline__ float wave_sum(float v) {
#pragma unroll
    for (int o = 1; o < 64; o <<= 1) v += __shfl_xor(v, o);
    return v;
}
__device__ __forceinline__ float wave_max(float v) {
#pragma unroll
    for (int o = 1; o < 64; o <<= 1) v = fmaxf(v, __shfl_xor(v, o));
    return v;
}
__device__ __forceinline__ float quad_sum(float v) {
    v += __builtin_bit_cast(float, __builtin_amdgcn_mov_dpp(__builtin_bit_cast(int, v), 0xB1, 0xF, 0xF, true));
    v += __builtin_bit_cast(float, __builtin_amdgcn_mov_dpp(__builtin_bit_cast(int, v), 0x4E, 0xF, 0xF, true));
    return v;
}
__device__ __forceinline__ float fq_sum(float v) { v += __shfl_xor(v, 16); v += __shfl_xor(v, 32); return v; }
__device__ __forceinline__ float fq_max(float v) { v = fmaxf(v, __shfl_xor(v, 16)); v = fmaxf(v, __shfl_xor(v, 32)); return v; }
__device__ __forceinline__ float ex2(float x) { return __builtin_amdgcn_exp2f(x); }
__device__ __forceinline__ float sigmoidf_(float x) { return __builtin_amdgcn_rcpf(1.0f + ex2(-1.4426950408889634f * x)); }

__device__ __forceinline__ void tr_item(const float* __restrict__ W, int K, int N, bf16_t* __restrict__ WT, int mode, int off, LAS float* scr, int item, int lane) {
    const int nblk = (N + 63) >> 6, kb = item / nblk, nb = item - kb * nblk, k0 = 64 * kb, n0 = 64 * nb;
    const int c4 = (lane & 15) * 4, nn = n0 + c4;
    f32x4 v[16];
#pragma unroll
    for (int i = 0; i < 16; ++i) { const int kk = 4 * i + (lane >> 4); v[i] = nn < N ? *(const f32x4*)(W + (size_t)(k0 + kk) * N + nn) : (f32x4){0.f, 0.f, 0.f, 0.f}; }
#pragma unroll
    for (int i = 0; i < 16; ++i) { const int kk = 4 * i + (lane >> 4); LAS float* d = scr + kk * 65 + c4; d[0] = v[i].x; d[1] = v[i].y; d[2] = v[i].z; d[3] = v[i].w; }
    asm volatile("s_waitcnt lgkmcnt(0)" ::: "memory");
    const int c = lane & 7;
#pragma unroll
    for (int j = 0; j < 8; ++j) { const int nl = (lane >> 3) + 8 * j, n = n0 + nl; const LAS float* s = scr + (8 * c) * 65 + nl;
        u32x4 o; o.x = pk2(s[0 * 65], s[1 * 65]); o.y = pk2(s[2 * 65], s[3 * 65]); o.z = pk2(s[4 * 65], s[5 * 65]); o.w = pk2(s[6 * 65], s[7 * 65]);
        const int drow = mode ? ((n >> 7) * 256 + (n & 127) + off) : (n + off);
        if (n < N) *(u32x4*)(WT + (size_t)drow * K + k0 + 8 * c) = o; }
    asm volatile("s_waitcnt lgkmcnt(0)" ::: "memory");
}
__device__ __forceinline__ void tr_matrix(const float* W, int K, int N, bf16_t* WT, int mode, int off, LAS float* scr, int gw, int NGW, int lane, int& rot) {
    const int nblk = (N + 63) >> 6, nitems = (K >> 6) * nblk;
    int first = gw - rot; if (first < 0) first += NGW;
    for (int it = first; it < nitems; it += NGW) tr_item(W, K, N, WT, mode, off, scr, it, lane);
    rot = (rot + nitems) % NGW;
}
__device__ __forceinline__ void rmsnorm_phase(const float* __restrict__ x, const float* __restrict__ g, bf16_t* __restrict__ XN, float* xcopy, int gw, int NGW, int lane) {
    for (int m = gw; m < S_; m += NGW) {
        const f32x4* xr = (const f32x4*)(x + (size_t)m * D_) + lane;
        f32x4 v[8]; float s = 0.f;
#pragma unroll
        for (int j = 0; j < 8; ++j) { v[j] = xr[64 * j]; s += (v[j].x * v[j].x + v[j].y * v[j].y) + (v[j].z * v[j].z + v[j].w * v[j].w); }
        s = wave_sum(s);
        const float rs = 1.0f / sqrtf(s * (1.0f / D_) + EPS);
        if (xcopy) {
            f32x4* xc = (f32x4*)(xcopy + (size_t)m * D_) + lane;
#pragma unroll
            for (int j = 0; j < 8; ++j) xc[64 * j] = v[j];
        }
        u32x2* o8 = (u32x2*)(XN + (size_t)m * D_) + lane;
#pragma unroll
        for (int j = 0; j < 8; ++j) { const f32x4 gg = ((const f32x4*)g)[lane + 64 * j]; u32x2 w; w.x = pk2(v[j].x * rs * gg.x, v[j].y * rs * gg.y); w.y = pk2(v[j].z * rs * gg.z, v[j].w * rs * gg.w); o8[64 * j] = w; }
    }
}

template <int NT>
__device__ __forceinline__ void gate_gemm(const bf16_t* __restrict__ XNp, const bf16_t* __restrict__ Wt, bf16_t* __restrict__ OUT, int ld, int col0, int tb, LAS unsigned char* lds, int tid, int wave, int lane) {
    const int fr = lane & 15, fq = lane >> 4, rt = wave & 3, kh = wave >> 2;
    const bf16_t* ap = XNp + (size_t)(64 * tb + 16 * rt + fr) * D_ + kh * 1024 + 8 * fq;
    const bf16_t* bp = Wt + (size_t)fr * D_ + kh * 1024 + 8 * fq;
    f32x4 acc[NT];
#pragma unroll
    for (int nt = 0; nt < NT; ++nt) acc[nt] = (f32x4){0.f, 0.f, 0.f, 0.f};
    constexpr int KB = NT == 1 ? 16 : 8;
    for (int k0 = 0; k0 < 32; k0 += KB) {
        bf16x8 a[KB], b[KB][NT];
#pragma unroll
        for (int u = 0; u < KB; ++u) {
            a[u] = *(const bf16x8*)(ap + 32 * (k0 + u));
#pragma unroll
            for (int nt = 0; nt < NT; ++nt) b[u][nt] = *(const bf16x8*)(bp + (size_t)(16 * nt) * D_ + 32 * (k0 + u));
        }
#pragma unroll
        for (int u = 0; u < KB; ++u)
#pragma unroll
            for (int nt = 0; nt < NT; ++nt) acc[nt] = MFMA16(b[u][nt], a[u], acc[nt]);
    }
    LAS float* P = (LAS float*)lds;
#pragma unroll
    for (int nt = 0; nt < NT; ++nt) *(LAS f32x4*)(P + ((kh * 64 + 16 * rt + fr) * (NT * 16) + 16 * nt + 4 * fq)) = acc[nt];
    __syncthreads();
    for (int idx = tid; idx < 64 * NT * 16; idx += NTHR) {
        const int tok = idx / (NT * 16), n = idx - tok * (NT * 16);
        const float v = P[idx] + P[64 * NT * 16 + idx];
        OUT[(size_t)(64 * tb + tok) * ld + col0 + n] = (bf16_t)(pk2(v, v) & 0xffffu);
    }
    __syncthreads();
}

__device__ __forceinline__ void rmsnorm_bf16_phase(const bf16_t* __restrict__ x, const float* __restrict__ g, bf16_t* __restrict__ XN, int gw, int NGW, int lane) {
    for (int m = gw; m < S_; m += NGW) {
        const u32x4* xr = (const u32x4*)(x + (size_t)m * D_) + lane;
        u32x4 v[4]; float s = 0.f;
#pragma unroll
        for (int j = 0; j < 4; ++j) v[j] = xr[64 * j];
#pragma unroll
        for (int j = 0; j < 4; ++j) { const float a0 = bflo(v[j].x), a1 = bfhi(v[j].x), a2 = bflo(v[j].y), a3 = bfhi(v[j].y), a4 = bflo(v[j].z), a5 = bfhi(v[j].z), a6 = bflo(v[j].w), a7 = bfhi(v[j].w);
            s += ((a0 * a0 + a1 * a1) + (a2 * a2 + a3 * a3)) + ((a4 * a4 + a5 * a5) + (a6 * a6 + a7 * a7)); }
        s = wave_sum(s);
        const float rs = 1.0f / sqrtf(s * (1.0f / D_) + EPS);
        u32x4* o = (u32x4*)(XN + (size_t)m * D_) + lane;
#pragma unroll
        for (int j = 0; j < 4; ++j) { const f32x4 g0 = ((const f32x4*)g)[2 * (lane + 64 * j)], g1 = ((const f32x4*)g)[2 * (lane + 64 * j) + 1];
            u32x4 w; w.x = pk2(bflo(v[j].x) * rs * g0.x, bfhi(v[j].x) * rs * g0.y); w.y = pk2(bflo(v[j].y) * rs * g0.z, bfhi(v[j].y) * rs * g0.w);
            w.z = pk2(bflo(v[j].z) * rs * g1.x, bfhi(v[j].z) * rs * g1.y); w.w = pk2(bflo(v[j].w) * rs * g1.z, bfhi(v[j].w) * rs * g1.w); o[64 * j] = w; }
    }
}

__device__ __forceinline__ void nsa_prep_unit(int tb, bf16_t* PROJ, const float* qg, const float* kg, bf16_t* KS, bf16_t* KW, bf16_t* VTS, bf16_t* VTW, int tid) {
    const int sub = tid & 15;
    for (int it0 = 0; it0 < 48; it0 += 8) {
        u32x4 raw4[8];
#pragma unroll
        for (int u = 0; u < 8; ++u) {
            const int task = (it0 + u) * 32 + (tid >> 4), tok = task / 24, v = task - tok * 24, t = tb * 64 + tok;
            const int col = v < 16 ? v * 128 : v < 20 ? 2048 + (2 * 4 + (v - 16)) * 128 : 2048 + (4 * 4 + (v - 20)) * 128;
            raw4[u] = *(const u32x4*)(PROJ + (size_t)t * NSA_N + col + 8 * sub);
        }
#pragma unroll
        for (int u = 0; u < 8; ++u) {
            const int task = (it0 + u) * 32 + (tid >> 4), tok = task / 24, v = task - tok * 24, t = tb * 64 + tok;
            const float* gain; float gs = 1.0f; bf16_t* dst;
            if (v < 16) { gain = qg; gs = QSCALE; dst = PROJ + (size_t)t * NSA_N + v * 128; }
            else if (v < 20) { const int g = v - 16; gain = kg + 128; dst = KS + ((size_t)g * S_ + t) * 128; }
            else { const int g = v - 20; gain = kg + 256; dst = KW + ((size_t)g * S_ + t) * 128; }
            const u32x4 raw = raw4[u];
            float x[8] = {bflo(raw.x), bfhi(raw.x), bflo(raw.y), bfhi(raw.y), bflo(raw.z), bfhi(raw.z), bflo(raw.w), bfhi(raw.w)};
            float ss = 0.f;
#pragma unroll
            for (int e = 0; e < 8; ++e) ss += x[e] * x[e];
            ss += __shfl_xor(ss, 1); ss += __shfl_xor(ss, 2); ss += __shfl_xor(ss, 4); ss += __shfl_xor(ss, 8);
            const float rs = gs / sqrtf(ss * (1.0f / 128.0f) + EPS);
            const f32x4 g0 = *(const f32x4*)(gain + 8 * sub), g1 = *(const f32x4*)(gain + 8 * sub + 4);
            u32x4 o; o.x = pk2(x[0] * rs * g0.x, x[1] * rs * g0.y); o.y = pk2(x[2] * rs * g0.z, x[3] * rs * g0.w); o.z = pk2(x[4] * rs * g1.x, x[5] * rs * g1.y); o.w = pk2(x[6] * rs * g1.z, x[7] * rs * g1.w);
            *(u32x4*)(dst + 8 * sub) = o;
        }
    }
    for (int it0 = 0; it0 < 16; it0 += 4) {
        unsigned short e[4][8];
#pragma unroll
        for (int u = 0; u < 4; ++u) {
            const int task = (it0 + u) * 512 + tid, tile = task >> 10, rem = task & 1023, kc = rem >> 7, d = rem & 127, which = tile >> 2, g = tile & 3;
            const bf16_t* src = PROJ + (size_t)(tb * 64 + 8 * kc) * NSA_N + 2048 + ((which ? 5 : 3) * 4 + g) * 128 + d;
#pragma unroll
            for (int i = 0; i < 8; ++i) e[u][i] = src[(size_t)i * NSA_N];
        }
#pragma unroll
        for (int u = 0; u < 4; ++u) {
            const int task = (it0 + u) * 512 + tid, tile = task >> 10, rem = task & 1023, kc = rem >> 7, d = rem & 127, which = tile >> 2, g = tile & 3;
            u32x4 o; o.x = e[u][0] | ((unsigned)e[u][1] << 16); o.y = e[u][2] | ((unsigned)e[u][3] << 16); o.z = e[u][4] | ((unsigned)e[u][5] << 16); o.w = e[u][6] | ((unsigned)e[u][7] << 16);
            bf16_t* VT = which ? VTW : VTS;
            *(u32x4*)(VT + (((size_t)g * 256 + tb) * 128 + d) * 64 + 8 * kc) = o;
        }
    }
}

__device__ __forceinline__ float gelu_tanh(float x) {
    const float u = 0.7978845608028654f * (x + 0.044715f * x * x * x);
    const float t = 1.0f - 2.0f * __builtin_amdgcn_rcpf(1.0f + ex2(2.0f * 1.4426950408889634f * u));
    return 0.5f * x * (1.0f + t);
}
__device__ __forceinline__ void nsa_compress_unit(int task, const bf16_t* PROJ, const float* pos, const bf16_t* W1t, const float* b1, const bf16_t* W2t, const float* kg0,
                                                  bf16_t* KC, bf16_t* VTC, LAS unsigned char* lds, int tid, int wave, int lane) {
    const int kv = task >> 7, g = (task >> 5) & 3, ct = task & 31, c0 = 32 * ct, fr = lane & 15, fq = lane >> 4;
    LAS float* part = (LAS float*)lds;
    LAS bf16_t* hS = (LAS bf16_t*)(lds + 131072);
    const int crow0 = (c0 + fr) < 1023 ? (c0 + fr) : 1022, crow1 = (c0 + 16 + fr) < 1023 ? (c0 + 16 + fr) : 1022;
    const bf16_t* abase0 = PROJ + (size_t)(16 * crow0) * NSA_N + 2048 + (kv * 4 + g) * 128 + 8 * fq;
    const bf16_t* abase1 = PROJ + (size_t)(16 * crow1) * NSA_N + 2048 + (kv * 4 + g) * 128 + 8 * fq;
    const bf16_t* wbase = W1t + (size_t)kv * 128 * 4096 + (size_t)fr * 4096 + 8 * fq;
    const float* pbase = pos + (size_t)kv * 32 * 128 + 8 * fq;
    f32x4 acc[2][8];
#pragma unroll
    for (int r2 = 0; r2 < 2; ++r2)
#pragma unroll
        for (int i = 0; i < 8; ++i) acc[r2][i] = (f32x4){0.f, 0.f, 0.f, 0.f};
    for (int li = 0; li < 4; ++li) {
        const int l = 4 * wave + li;
#pragma unroll
        for (int dd = 0; dd < 4; ++dd) {
            const u32x4 raw0 = *(const u32x4*)(abase0 + (size_t)l * NSA_N + 32 * dd), raw1 = *(const u32x4*)(abase1 + (size_t)l * NSA_N + 32 * dd);
            const f32x4 p0 = *(const f32x4*)(pbase + l * 128 + 32 * dd), p1 = *(const f32x4*)(pbase + l * 128 + 32 * dd + 4);
            u32x4 a; a.x = pk2(bflo(raw0.x) + p0.x, bfhi(raw0.x) + p0.y); a.y = pk2(bflo(raw0.y) + p0.z, bfhi(raw0.y) + p0.w);
            a.z = pk2(bflo(raw0.z) + p1.x, bfhi(raw0.z) + p1.y); a.w = pk2(bflo(raw0.w) + p1.z, bfhi(raw0.w) + p1.w);
            u32x4 b; b.x = pk2(bflo(raw1.x) + p0.x, bfhi(raw1.x) + p0.y); b.y = pk2(bflo(raw1.y) + p0.z, bfhi(raw1.y) + p0.w);
            b.z = pk2(bflo(raw1.z) + p1.x, bfhi(raw1.z) + p1.y); b.w = pk2(bflo(raw1.w) + p1.z, bfhi(raw1.w) + p1.w);
            const bf16x8 af0 = __builtin_bit_cast(bf16x8, a), af1 = __builtin_bit_cast(bf16x8, b);
#pragma unroll
            for (int nt = 0; nt < 8; ++nt) { const bf16x8 bfr = *(const bf16x8*)(wbase + (size_t)nt * 16 * 4096 + l * 128 + 32 * dd); acc[0][nt] = MFMA16(bfr, af0, acc[0][nt]); acc[1][nt] = MFMA16(bfr, af1, acc[1][nt]); }
        }
    }
#pragma unroll
    for (int r2 = 0; r2 < 2; ++r2)
#pragma unroll
        for (int nt = 0; nt < 8; ++nt) *(LAS f32x4*)(part + (wave * 32 + 16 * r2 + fr) * 128 + 16 * nt + 4 * fq) = acc[r2][nt];
    __syncthreads();
    {
        const int c = tid >> 4, n8 = (tid & 15) * 8;
        f32x4 s0 = *(const f32x4*)(b1 + kv * 128 + n8), s1 = *(const f32x4*)(b1 + kv * 128 + n8 + 4);
#pragma unroll
        for (int w = 0; w < 8; ++w) { s0 = s0 + *(LAS f32x4*)(part + (w * 32 + c) * 128 + n8); s1 = s1 + *(LAS f32x4*)(part + (w * 32 + c) * 128 + n8 + 4); }
        u32x4 o; o.x = pk2(gelu_tanh(s0.x), gelu_tanh(s0.y)); o.y = pk2(gelu_tanh(s0.z), gelu_tanh(s0.w)); o.z = pk2(gelu_tanh(s1.x), gelu_tanh(s1.y)); o.w = pk2(gelu_tanh(s1.z), gelu_tanh(s1.w));
        *(LAS u32x4*)(hS + c * 136 + n8) = o;
    }
    __syncthreads();
    {
        f32x4 a2[2] = {(f32x4){0.f, 0.f, 0.f, 0.f}, (f32x4){0.f, 0.f, 0.f, 0.f}};
#pragma unroll
        for (int ks = 0; ks < 4; ++ks) {
            const bf16x8 wf = *(const bf16x8*)(W2t + (size_t)kv * 128 * 128 + (size_t)(16 * wave + fr) * 128 + 32 * ks + 8 * fq);
#pragma unroll
            for (int r2 = 0; r2 < 2; ++r2) { const bf16x8 hf = *(LAS bf16x8*)(hS + (16 * r2 + fr) * 136 + 32 * ks + 8 * fq); a2[r2] = MFMA16(wf, hf, a2[r2]); }
        }
#pragma unroll
        for (int r2 = 0; r2 < 2; ++r2) *(LAS f32x4*)(part + (16 * r2 + fr) * 128 + 16 * wave + 4 * fq) = a2[r2];
    }
    __syncthreads();
    if (kv == 0) {
        const int c = tid >> 4, sub = tid & 15;
        const f32x4 x0 = *(LAS f32x4*)(part + c * 128 + 8 * sub), x1 = *(LAS f32x4*)(part + c * 128 + 8 * sub + 4);
        float ss = (x0.x * x0.x + x0.y * x0.y) + (x0.z * x0.z + x0.w * x0.w) + (x1.x * x1.x + x1.y * x1.y) + (x1.z * x1.z + x1.w * x1.w);
        ss += __shfl_xor(ss, 1); ss += __shfl_xor(ss, 2); ss += __shfl_xor(ss, 4); ss += __shfl_xor(ss, 8);
        float rs = 1.0f / sqrtf(ss * (1.0f / 128.0f) + EPS);
        if (c0 + c >= 1023) rs = 0.f;
        const f32x4 g0 = *(const f32x4*)(kg0 + 8 * sub), g1 = *(const f32x4*)(kg0 + 8 * sub + 4);
        u32x4 o; o.x = pk2(x0.x * rs * g0.x, x0.y * rs * g0.y); o.y = pk2(x0.z * rs * g0.z, x0.w * rs * g0.w); o.z = pk2(x1.x * rs * g1.x, x1.y * rs * g1.y); o.w = pk2(x1.z * rs * g1.z, x1.w * rs * g1.w);
        *(u32x4*)(KC + ((size_t)g * 1024 + c0 + c) * 128 + 8 * sub) = o;
    } else {
        if (tid < 256) {
            const int d = tid & 127, hh = tid >> 7; float v[16];
#pragma unroll
            for (int c = 0; c < 16; ++c) v[c] = (c0 + 16 * hh + c < 1023) ? part[(16 * hh + c) * 128 + d] : 0.f;
            u32x4 o0, o1; o0.x = pk2(v[0], v[1]); o0.y = pk2(v[2], v[3]); o0.z = pk2(v[4], v[5]); o0.w = pk2(v[6], v[7]);
            o1.x = pk2(v[8], v[9]); o1.y = pk2(v[10], v[11]); o1.z = pk2(v[12], v[13]); o1.w = pk2(v[14], v[15]);
            bf16_t* dst = VTC + (((size_t)g * 16 + (ct >> 1)) * 128 + d) * 64 + 32 * (ct & 1) + 16 * hh;
            *(u32x4*)dst = o0; *(u32x4*)(dst + 8) = o1;
        }
    }
    __syncthreads();
}

__device__ __forceinline__ unsigned long long shfl_xor_u64(unsigned long long v, int m) {
    const unsigned lo = __shfl_xor((unsigned)v, m), hi = __shfl_xor((unsigned)(v >> 32), m);
    return ((unsigned long long)hi << 32) | lo;
}

struct QuadState { bf16x8 qf[4]; f32x4 o[8]; float l; };
constexpr int AT_STAGE = 32768, AT_V = 16384;
constexpr int AT_IMP = 2 * AT_STAGE;
constexpr int AT_SELM = AT_IMP + 65536;
static_assert(AT_SELM + 2048 + 512 <= LDS_BYTES, "attention LDS map");

template <bool WV>
__device__ __forceinline__ void at_dma(LAS unsigned char* st, const bf16_t* __restrict__ Kb, const bf16_t* __restrict__ Vb, int wave, int lane) {
#pragma unroll
    for (int i = 0; i < 2; ++i) {
        const int k = 2 * wave + i;
        const int rho = 4 * k + (lane >> 4), sg = lane & 15, key = (rho & 32) + ((rho >> 2) & 3) * 8 + ((rho >> 4) & 1) * 4 + (rho & 3);
        __builtin_amdgcn_global_load_lds((const unsigned*)(Kb + key * 128 + 8 * (sg ^ (rho & 15))), (LAS unsigned*)(st + 1024 * k), 16, 0, 0);
    }
    if (WV) {
#pragma unroll
        for (int i = 0; i < 2; ++i) {
            const int k = 2 * wave + i;
            const int d = 8 * k + (lane >> 3), sg = lane & 7;
            __builtin_amdgcn_global_load_lds((const unsigned*)(Vb + d * 64 + 8 * (sg ^ ((d >> 1) & 7))), (LAS unsigned*)(st + AT_V + 1024 * k), 16, 0, 0);
        }
    }
}
template <int MODE, bool DUAL>
__device__ __forceinline__ void at_block(const LAS unsigned char* st, QuadState& A, QuadState& B, bool domask, float biasA, float biasB, int pos0, int loA, int hiA, int loB, int hiB, float invlA, float invlB,
                                         float& carryA, float& carryB, LAS float* impA, LAS float* impB, int lane, int fr, int fq) {
    f32x4 sA[4], sB[4];
#pragma unroll
    for (int T = 0; T < 4; ++T) { sA[T] = (f32x4){biasA, biasA, biasA, biasA}; sB[T] = (f32x4){biasB, biasB, biasB, biasB}; }
    bf16x8 vpre[8];
    if (!DUAL && MODE != 0) {
#pragma unroll
        for (int dt = 0; dt < 8; ++dt) vpre[dt] = *(const LAS bf16x8*)(st + AT_V + (16 * dt + fr) * 128 + 16 * ((fq) ^ ((fr >> 1) & 7)));
    }
#pragma unroll
    for (int ks = 0; ks < 4; ++ks) {
        bf16x8 kf[4];
#pragma unroll
        for (int T = 0; T < 4; ++T) kf[T] = *(const LAS bf16x8*)(st + (32 * (T >> 1) + 16 * (T & 1) + fr) * 256 + 16 * ((4 * fq + ks) ^ fr));
#pragma unroll
        for (int T = 0; T < 4; ++T) { sA[T] = MFMA16(kf[T], A.qf[ks], sA[T]); if (DUAL) sB[T] = MFMA16(kf[T], B.qf[ks], sB[T]); }
        if (DUAL) __builtin_amdgcn_sched_barrier(0);
    }
    float la = 0.f, lb = 0.f;
    if (domask) {
#pragma unroll
        for (int T = 0; T < 4; ++T)
#pragma unroll
            for (int i = 0; i < 4; ++i) {
                const int pos = pos0 + 32 * (T >> 1) + 8 * fq + 4 * (T & 1) + i;
                if (!(pos >= loA && pos <= hiA)) sA[T][i] = NEG;
                if (DUAL) { if (!(pos >= loB && pos <= hiB)) sB[T][i] = NEG; }
            }
    }
#pragma unroll
    for (int T = 0; T < 4; ++T)
#pragma unroll
        for (int i = 0; i < 4; ++i) {
            float e = ex2(sA[T][i]); if (MODE == 2) e *= invlA; sA[T][i] = e; la += e;
            if (DUAL) { float f = ex2(sB[T][i]); if (MODE == 2) f *= invlB; sB[T][i] = f; lb += f; }
        }
    if (MODE != 2) { A.l += la; if (DUAL) B.l += lb; }
    if (MODE == 2) {
        const int src = (lane + 48) & 63;
        {
            const float r0 = __shfl(sA[1][3], src), r1 = __shfl(sA[3][3], src);
            const float pv0 = fq ? r0 : carryA, pv1 = fq ? r1 : r0; carryA = r1;
            float i00 = (sA[0][0] + sA[0][1]) + (sA[0][2] + sA[0][3]) + pv0, i01 = (sA[1][0] + sA[1][1]) + (sA[1][2] + sA[1][3]) + sA[0][3];
            float i10 = (sA[2][0] + sA[2][1]) + (sA[2][2] + sA[2][3]) + pv1, i11 = (sA[3][0] + sA[3][1]) + (sA[3][2] + sA[3][3]) + sA[2][3];
            i00 = quad_sum(i00); i01 = quad_sum(i01); i10 = quad_sum(i10); i11 = quad_sum(i11);
            if ((fr & 3) == 0) { impA[2 * fq] = i00; impA[2 * fq + 1] = i01; impA[8 + 2 * fq] = i10; impA[8 + 2 * fq + 1] = i11; }
        }
        if (DUAL) {
            const float r0 = __shfl(sB[1][3], src), r1 = __shfl(sB[3][3], src);
            const float pv0 = fq ? r0 : carryB, pv1 = fq ? r1 : r0; carryB = r1;
            float i00 = (sB[0][0] + sB[0][1]) + (sB[0][2] + sB[0][3]) + pv0, i01 = (sB[1][0] + sB[1][1]) + (sB[1][2] + sB[1][3]) + sB[0][3];
            float i10 = (sB[2][0] + sB[2][1]) + (sB[2][2] + sB[2][3]) + pv1, i11 = (sB[3][0] + sB[3][1]) + (sB[3][2] + sB[3][3]) + sB[2][3];
            i00 = quad_sum(i00); i01 = quad_sum(i01); i10 = quad_sum(i10); i11 = quad_sum(i11);
            if ((fr & 3) == 0) { impB[2 * fq] = i00; impB[2 * fq + 1] = i01; impB[8 + 2 * fq] = i10; impB[8 + 2 * fq + 1] = i11; }
        }
    }
    if (MODE != 0) {
        bf16x8 pfA[2], pfB[2];
#pragma unroll
        for (int u = 0; u < 2; ++u) {
            u32x4 w; w.x = pk2(sA[2 * u][0], sA[2 * u][1]); w.y = pk2(sA[2 * u][2], sA[2 * u][3]); w.z = pk2(sA[2 * u + 1][0], sA[2 * u + 1][1]); w.w = pk2(sA[2 * u + 1][2], sA[2 * u + 1][3]); pfA[u] = __builtin_bit_cast(bf16x8, w);
            if (DUAL) { u32x4 x; x.x = pk2(sB[2 * u][0], sB[2 * u][1]); x.y = pk2(sB[2 * u][2], sB[2 * u][3]); x.z = pk2(sB[2 * u + 1][0], sB[2 * u + 1][1]); x.w = pk2(sB[2 * u + 1][2], sB[2 * u + 1][3]); pfB[u] = __builtin_bit_cast(bf16x8, x); }
        }
#pragma unroll
        for (int u = 0; u < 2; ++u) {
#pragma unroll
            for (int dt = 0; dt < 8; ++dt) {
                const bf16x8 vf = (DUAL || u == 1) ? *(const LAS bf16x8*)(st + AT_V + (16 * dt + fr) * 128 + 16 * ((4 * u + fq) ^ ((fr >> 1) & 7))) : vpre[dt];
                A.o[dt] = MFMA16(vf, pfA[u], A.o[dt]); if (DUAL) B.o[dt] = MFMA16(vf, pfB[u], B.o[dt]);
                if (DUAL && (dt & 3) == 3) __builtin_amdgcn_sched_barrier(0);
            }
        }
    }
}
template <int MODE, bool SEL, int NST>
__device__ __forceinline__ void at_run(LAS unsigned char* lds, const bf16_t* Kg, const bf16_t* Vg, int first, int last, QuadState& A, QuadState& B, int loA, int hiA, int loB, int hiB,
                                       float invlA, float invlB, LAS float* impA, LAS float* impB, const LAS unsigned* uni, const LAS unsigned* selmA, const LAS unsigned* selmB,
                                       int tid, int lane, int fr, int fq, int nm_lo = 1, int nm_hi = 0) {
    constexpr bool WV = MODE != 0;
    constexpr int BPS = NST / 2;
    const int wave = __builtin_amdgcn_readfirstlane(tid >> 6);
    const int sb0 = first / BPS, sb1 = last / BPS;
    float carryA = 0.f, carryB = 0.f;
#define AT_DMA_SB(sb) do { _Pragma("unroll") for (int h_ = 0; h_ < BPS; ++h_) { const int blk_ = (sb) * BPS + h_; if (blk_ >= first && blk_ <= last) \
        at_dma<WV>(lds + ((((sb) & 1) * BPS + h_) * AT_STAGE), Kg + (size_t)blk_ * 8192, Vg + (size_t)blk_ * 8192, wave, lane); } } while (0)
    AT_DMA_SB(sb0);
    unsigned wa = 0u, wb = 0u;
    for (int sb = sb0; sb <= sb1; ++sb) {
        asm volatile("s_waitcnt vmcnt(0)" ::: "memory");
        __syncthreads();
        if (sb < sb1) AT_DMA_SB(sb + 1);
#pragma unroll
        for (int h = 0; h < BPS; ++h) {
            const int idx = sb * BPS + h;
            if (idx < first || idx > last) continue;
            const LAS unsigned char* st = lds + (((sb & 1) * BPS + h) * AT_STAGE);
            if (SEL) {
                if ((idx & 31) == 0 || idx == first) { wa = (unsigned)__builtin_amdgcn_readfirstlane((int)uni[idx >> 5]); wb = (unsigned)__builtin_amdgcn_readfirstlane((int)uni[8 + (idx >> 5)]); }
                const bool actA = (wa >> (idx & 31)) & 1u, actB = (wb >> (idx & 31)) & 1u;
                if (actA) { const float bA = ((selmA[idx >> 5] >> (idx & 31)) & 1u) ? 0.f : NEG; at_block<1, false>(st, A, A, idx == last, bA, bA, 64 * idx, 0, hiA, 0, hiA, 0.f, 0.f, carryA, carryA, nullptr, nullptr, lane, fr, fq); }
                if (actB) { const float bB = ((selmB[idx >> 5] >> (idx & 31)) & 1u) ? 0.f : NEG; at_block<1, false>(st, B, B, idx == last, bB, bB, 64 * idx, 0, hiB, 0, hiB, 0.f, 0.f, carryB, carryB, nullptr, nullptr, lane, fr, fq); }
            } else {
                at_block<MODE, true>(st, A, B, idx < nm_lo || idx > nm_hi, 0.f, 0.f, 64 * idx, loA, hiA, loB, hiB, invlA, invlB, carryA, carryB, impA + 16 * idx, impB + 16 * idx, lane, fr, fq);
            }
        }
    }
#undef AT_DMA_SB
    asm volatile("s_waitcnt vmcnt(0)" ::: "memory");
    __syncthreads();
}
__device__ __forceinline__ void y_accum(bf16_t* yp, const f32x4 (&o)[8], float sc, bool first) {
    u32x2 old[8];
    if (!first) {
#pragma unroll
        for (int dt = 0; dt < 8; ++dt) old[dt] = *(const u32x2*)(yp + 16 * dt);
    }
#pragma unroll
    for (int dt = 0; dt < 8; ++dt) {
        float a0 = o[dt][0] * sc, a1 = o[dt][1] * sc, a2 = o[dt][2] * sc, a3 = o[dt][3] * sc;
        if (!first) { a0 += bflo(old[dt].x); a1 += bfhi(old[dt].x); a2 += bflo(old[dt].y); a3 += bfhi(old[dt].y); }
        u32x2 w; w.x = pk2(a0, a1); w.y = pk2(a2, a3); *(u32x2*)(yp + 16 * dt) = w;
    }
}
__device__ __forceinline__ void nsa_attn_wg(int qb, int g, const bf16_t* PROJ, const float* bgate, const bf16_t* KC, const bf16_t* VTC, const bf16_t* KS, const bf16_t* VTS,
                                            const bf16_t* KW, const bf16_t* VTW, bf16_t* Y, LAS unsigned char* lds, int tid, int wave, int lane) {
    const int fr = lane & 15, fq = lane >> 4, a = fr >> 2, r = fr & 3, cur = qb;
    const int tlA = 8 * wave + a, tlB = tlA + 4, tA = 64 * qb + tlA, tB = 64 * qb + tlB;
    LAS float* IMP = (LAS float*)(lds + AT_IMP); LAS unsigned* SELM = (LAS unsigned*)(lds + AT_SELM); LAS unsigned* UNI = SELM + 512;
    QuadState A, B;
    {
        const bf16x8* qa = (const bf16x8*)(PROJ + (size_t)tA * NSA_N + (4 * g + r) * 128 + 32 * fq); const bf16x8* qbp = (const bf16x8*)(PROJ + (size_t)tB * NSA_N + (4 * g + r) * 128 + 32 * fq);
#pragma unroll
        for (int ks = 0; ks < 4; ++ks) { A.qf[ks] = qa[ks]; B.qf[ks] = qbp[ks]; }
    }
#define gpA (PROJ + (size_t)tA * NSA_N + 5120 + (4 * g + r) * 3)
#define gpB (PROJ + (size_t)tB * NSA_N + 5120 + (4 * g + r) * 3)
#define bg (bgate + (4 * g + r) * 3)
#define ypA (Y + (size_t)tA * D_ + (4 * g + r) * 128 + 4 * fq)
#define ypB (Y + (size_t)tB * D_ + (4 * g + r) * 128 + 4 * fq)
    {
        const int cmA = (tA - 31) >> 4, cmB = (tB - 31) >> 4, nb = ((4 * qb + 2) >> 6) + 1;
        const bf16_t* KCg = KC + (size_t)g * 1024 * 128; const bf16_t* VCg = VTC + (size_t)g * 16 * 8192;
        A.l = 0.f; B.l = 0.f;
        at_run<0, false, 2>(lds, KCg, VCg, 0, nb - 1, A, B, 0, cmA, 0, cmB, 0.f, 0.f, nullptr, nullptr, nullptr, nullptr, nullptr, tid, lane, fr, fq, 0, (4 * qb - 65) >> 6);
        const float lA = fq_sum(A.l), lB = fq_sum(B.l);
        const float invlA = lA > 0.f ? 1.0f / lA : 0.f, invlB = lB > 0.f ? 1.0f / lB : 0.f;
#pragma unroll
        for (int i = 0; i < 8; ++i) { A.o[i] = (f32x4){0.f, 0.f, 0.f, 0.f}; B.o[i] = (f32x4){0.f, 0.f, 0.f, 0.f}; }
        at_run<2, false, 2>(lds, KCg, VCg, 0, nb - 1, A, B, 0, cmA, 0, cmB, invlA, invlB, IMP + tlA * 256, IMP + tlB * 256, nullptr, nullptr, nullptr, tid, lane, fr, fq, 0, (4 * qb - 65) >> 6);
        y_accum(ypA, A.o, sigmoidf_(bf2f(gpA[0]) + bg[0]), true);
        y_accum(ypB, B.o, sigmoidf_(bf2f(gpB[0]) + bg[0]), true);
    }
    asm volatile("s_waitcnt lgkmcnt(0)" ::: "memory");
    {
        float val[8][4]; unsigned selb[8];
#pragma unroll
        for (int ta = 0; ta < 8; ++ta) {
            selb[ta] = 0u;
#pragma unroll
            for (int q = 0; q < 4; ++q) {
                const int j = lane + 64 * q;
                if ((j <= cur) && (j == 0 || j >= cur - 1 || cur <= 15)) selb[ta] |= 1u << q;
                val[ta][q] = (cur > 15 && j >= 1 && j <= cur - 2) ? IMP[(8 * wave + ta) * 256 + j] : -1.0f;
            }
        }
        if (cur > 15) {
            for (int it = 0; it < 13; ++it) {
                unsigned long long best[8];
#pragma unroll
                for (int ta = 0; ta < 8; ++ta) {
                    unsigned long long b = 0ull;
#pragma unroll
                    for (int q = 0; q < 4; ++q) if (val[ta][q] >= 0.f) { const unsigned long long k = ((unsigned long long)__float_as_uint(val[ta][q]) << 32) | (unsigned)(256 - (lane + 64 * q)); b = k > b ? k : b; }
                    best[ta] = b;
                }
#pragma unroll
                for (int m = 1; m < 64; m <<= 1) {
#pragma unroll
                    for (int ta = 0; ta < 8; ++ta) { const unsigned long long ot = shfl_xor_u64(best[ta], m); best[ta] = ot > best[ta] ? ot : best[ta]; }
                }
#pragma unroll
                for (int ta = 0; ta < 8; ++ta) {
                    const int jw = 256 - (int)(best[ta] & 0x1ffu);
#pragma unroll
                    for (int q = 0; q < 4; ++q) if (lane + 64 * q == jw) { val[ta][q] = -1.0f; selb[ta] |= 1u << q; }
                }
            }
        }
#pragma unroll
        for (int ta = 0; ta < 8; ++ta)
#pragma unroll
            for (int q = 0; q < 4; ++q) {
                const unsigned long long m = __ballot((selb[ta] >> q) & 1u);
                if (lane == 0) { SELM[(8 * wave + ta) * 8 + 2 * q] = (unsigned)m; SELM[(8 * wave + ta) * 8 + 2 * q + 1] = (unsigned)(m >> 32); }
            }
    }
    asm volatile("s_waitcnt lgkmcnt(0)" ::: "memory");
    if (lane < 16) {
        const int qd = lane >> 3, wd = lane & 7;
        UNI[16 * wave + lane] = SELM[(8 * wave + 4 * qd + 0) * 8 + wd] | SELM[(8 * wave + 4 * qd + 1) * 8 + wd] | SELM[(8 * wave + 4 * qd + 2) * 8 + wd] | SELM[(8 * wave + 4 * qd + 3) * 8 + wd];
    }
    asm volatile("s_waitcnt lgkmcnt(0)" ::: "memory");
    __syncthreads();
    {
#pragma unroll
        for (int i = 0; i < 8; ++i) { A.o[i] = (f32x4){0.f, 0.f, 0.f, 0.f}; B.o[i] = (f32x4){0.f, 0.f, 0.f, 0.f}; }
        A.l = 0.f; B.l = 0.f;
        at_run<1, true, 4>(lds, KS + (size_t)g * S_ * 128, VTS + (size_t)g * 256 * 8192, 0, cur, A, B, 0, tA, 0, tB, 0.f, 0.f, nullptr, nullptr, UNI + 16 * wave, SELM + tlA * 8, SELM + tlB * 8, tid, lane, fr, fq);
        const float lA = fq_sum(A.l), lB = fq_sum(B.l);
        y_accum(ypA, A.o, lA > 0.f ? sigmoidf_(bf2f(gpA[1]) + bg[1]) / lA : 0.f, false);
        y_accum(ypB, B.o, lB > 0.f ? sigmoidf_(bf2f(gpB[1]) + bg[1]) / lB : 0.f, false);
    }
    {
#pragma unroll
        for (int i = 0; i < 8; ++i) { A.o[i] = (f32x4){0.f, 0.f, 0.f, 0.f}; B.o[i] = (f32x4){0.f, 0.f, 0.f, 0.f}; }
        A.l = 0.f; B.l = 0.f;
        const int jlo = qb >= 8 ? qb - 8 : 0;
        at_run<1, false, 4>(lds, KW + (size_t)g * S_ * 128, VTW + (size_t)g * 256 * 8192, jlo, cur, A, B, tA - 511, tA, tB - 511, tB, 0.f, 0.f, nullptr, nullptr, nullptr, nullptr, nullptr, tid, lane, fr, fq, qb - 7, qb - 1);
        const float lA = fq_sum(A.l), lB = fq_sum(B.l);
        y_accum(ypA, A.o, lA > 0.f ? sigmoidf_(bf2f(gpA[2]) + bg[2]) / lA : 0.f, false);
        y_accum(ypB, B.o, lB > 0.f ? sigmoidf_(bf2f(gpB[2]) + bg[2]) / lB : 0.f, false);
    }
#undef gpA
#undef gpB
#undef bg
#undef ypA
#undef ypB
}

__device__ __forceinline__ float log_sigmoid(float x) { return fminf(x, 0.f) - log1pf(__expf(-fabsf(x))); }
__device__ __forceinline__ void ml_stage_load(const bf16_t* PROJ, int h, int c, bool do_k, int tid, u32x4 (&rk)[2], u32x4 (&rv)[4]) {
    if (do_k) {
#pragma unroll
        for (int i = 0; i < 2; ++i) { const int idx = tid + 512 * i, s = (idx & 3) + 4 * (idx >> 6), ch = (idx >> 2) & 15; rk[i] = *(const u32x4*)(PROJ + (size_t)(64 * c + s) * ML_N + 1024 + h * 128 + 8 * ch); }
    }
#pragma unroll
    for (int i = 0; i < 4; ++i) { const int i2 = tid + 512 * i, s = (i2 & 3) + 4 * (i2 >> 7), ch = (i2 >> 2) & 31; rv[i] = *(const u32x4*)(PROJ + (size_t)(64 * c + s) * ML_N + 2048 + h * 256 + 8 * ch); }
}
__device__ __forceinline__ void ml_stage_store(LAS bf16_t* kT, LAS bf16_t* vT, const LAS float* wS, bool do_k, int tid, const u32x4 (&rk)[2], const u32x4 (&rv)[4]) {
    if (do_k) {
#pragma unroll
        for (int i = 0; i < 2; ++i) {
            const int idx = tid + 512 * i, s = (idx & 3) + 4 * (idx >> 6), ch = (idx >> 2) & 15, col = (s + 8 * ch) & 63;
            const float w = wS[s] * 0.08838834764831845f;
            const unsigned ww[4] = {rk[i].x, rk[i].y, rk[i].z, rk[i].w};
#pragma unroll
            for (int e = 0; e < 4; ++e) { const unsigned pkd = pk2(bflo(ww[e]) * w, bfhi(ww[e]) * w); kT[(8 * ch + 2 * e) * 72 + col] = (bf16_t)(pkd & 0xffffu); kT[(8 * ch + 2 * e + 1) * 72 + col] = (bf16_t)(pkd >> 16); }
        }
    }
#pragma unroll
    for (int i = 0; i < 4; ++i) {
        const int i2 = tid + 512 * i, s = (i2 & 3) + 4 * (i2 >> 7), ch = (i2 >> 2) & 31, col = (s + 8 * ch) & 63;
        const unsigned ww[4] = {rv[i].x, rv[i].y, rv[i].z, rv[i].w};
#pragma unroll
        for (int e = 0; e < 4; ++e) { vT[(8 * ch + 2 * e) * 72 + col] = (bf16_t)(ww[e] & 0xffffu); vT[(8 * ch + 2 * e + 1) * 72 + col] = (bf16_t)(ww[e] >> 16); }
    }
}
__device__ __forceinline__ void ml_local_phase(int first, int step, const bf16_t* PROJ, const float* bif, bf16_t* CT, float* NT, float* CI, LAS unsigned char* lds, int tid, int wave, int lane) {
    const int fr = lane & 15, fq = lane >> 4;
    LAS bf16_t* kT = (LAS bf16_t*)lds;
    LAS bf16_t* vT = (LAS bf16_t*)(lds + 18432);
    LAS float* wS = (LAS float*)(lds + 18432 + 36864);
    u32x4 rk[2], rv[4]; unsigned short gi = 0, gf = 0;
    if (first < 2048) {
        ml_stage_load(PROJ, first >> 8, first & 255, true, tid, rk, rv);
        if (wave == 0) { const bf16_t* gp = PROJ + (size_t)(64 * (first & 255) + lane) * ML_N + 6144 + (first >> 8); gi = gp[0]; gf = gp[8]; }
    }
    for (int unit = first; unit < 2048; unit += step) {
        const int h = unit >> 8, c = unit & 255;
        if (wave == 0) {
            const float ig = bf2f(gi) + bif[h], lf = log_sigmoid(bf2f(gf) + bif[8 + h]);
            float b = lf;
#pragma unroll
            for (int o = 1; o < 64; o <<= 1) { const float u = __shfl_up(b, o); if (lane >= o) b += u; }
            const float blast = __shfl(b, 63), gs = blast - b + ig, gmax = wave_max(gs);
            wS[lane] = __expf(gs - gmax);
            if (lane == 0) { CI[(h * 256 + c) * 2] = blast; CI[(h * 256 + c) * 2 + 1] = gmax; }
        }
        __syncthreads();
        ml_stage_store(kT, vT, wS, true, tid, rk, rv);
        __syncthreads();
        const int un = unit + step;
        if (un < 2048) {
            ml_stage_load(PROJ, un >> 8, un & 255, true, tid, rk, rv);
            if (wave == 0) { const bf16_t* gp = PROJ + (size_t)(64 * (un & 255) + lane) * ML_N + 6144 + (un >> 8); gi = gp[0]; gf = gp[8]; }
        }
        f32x4 acc[16];
#pragma unroll
        for (int i = 0; i < 16; ++i) acc[i] = (f32x4){0.f, 0.f, 0.f, 0.f};
#pragma unroll
        for (int ks = 0; ks < 2; ++ks) {
            const bf16x8 af = *(LAS bf16x8*)(kT + (16 * wave + fr) * 72 + 8 * ((4 * ks + fq + 2 * wave + (fr >> 3)) & 7));
#pragma unroll
            for (int nt = 0; nt < 16; ++nt) { const bf16x8 bfr = *(LAS bf16x8*)(vT + (16 * nt + fr) * 72 + 8 * ((4 * ks + fq + 2 * nt + (fr >> 3)) & 7)); acc[nt] = MFMA16(af, bfr, acc[nt]); }
        }
        LAS bf16_t* tS = (LAS bf16_t*)(lds + 57344);
#pragma unroll
        for (int nt = 0; nt < 16; ++nt) { u32x2 w; w.x = pk2(acc[nt][0], acc[nt][1]); w.y = pk2(acc[nt][2], acc[nt][3]); *(LAS u32x2*)(tS + (16 * nt + fr) * 136 + 16 * wave + 4 * fq) = w; }
        if (tid < 128) { float s = 0.f; for (int i = 0; i < 64; ++i) s += bf2f(kT[tid * 72 + i]); NT[(size_t)(h * 256 + c) * 128 + tid] = s; }
        __syncthreads();
        {
            bf16_t* ct = CT + ((size_t)(h * 256 + c) * 256) * 128;
#pragma unroll
            for (int i = 0; i < 8; ++i) { const int q = tid + 512 * i, row = q >> 4, c16 = q & 15; *(u32x4*)(ct + (size_t)row * 128 + 8 * c16) = *(LAS u32x4*)(tS + row * 136 + 8 * c16); }
        }
    }
}
__device__ __forceinline__ void ml_scan_unit(int unit, bf16_t* CT, float* NT, const float* CI, float* MC, LAS unsigned char* lds, int tid) {
    const int h = unit >> 5, part = unit & 31;
    LAS float* cdS = (LAS float*)lds; LAS float* eS = cdS + 256; LAS float* blS = eS + 256; LAS float* gmS = blS + 256; LAS float* mS = gmS + 256;
    if (tid < 256) { blS[tid] = CI[(h * 256 + tid) * 2]; gmS[tid] = CI[(h * 256 + tid) * 2 + 1]; }
    __syncthreads();
    {
        float B = 0.f, Gm = 0.f;
        if (tid < 256) { B = blS[tid]; Gm = gmS[tid]; }
        for (int off = 1; off < 256; off <<= 1) {
            if (tid < 256) { cdS[tid] = B; eS[tid] = Gm; }
            __syncthreads();
            if (tid < 256 && tid >= off) { const float B1 = cdS[tid - off], G1 = eS[tid - off]; Gm = fmaxf(G1 + B, Gm); B = B1 + B; }
            __syncthreads();
        }
        if (tid < 256) mS[tid + 1] = fmaxf(NEG + B, Gm);
        if (tid == 0) mS[0] = NEG;
    }
    __syncthreads();
    if (tid < 256) {
        const float m = mS[tid], mn = mS[tid + 1];
        cdS[tid] = __expf(blS[tid] + m - mn); eS[tid] = __expf(gmS[tid] - mn);
        if (part == 0) MC[h * 256 + tid] = m;
    }
    __syncthreads();
    {
        unsigned* p = (unsigned*)(CT + (size_t)h * 256 * 32768) + part * 512 + tid;
        float r0 = 0.f, r1 = 0.f;
        unsigned d[16], dn[16];
#pragma unroll
        for (int i = 0; i < 16; ++i) d[i] = p[(size_t)i * 16384];
        for (int c0 = 0; c0 < 256; c0 += 16) {
            if (c0 + 16 < 256) {
#pragma unroll
                for (int i = 0; i < 16; ++i) dn[i] = p[(size_t)(c0 + 16 + i) * 16384];
            }
#pragma unroll
            for (int i = 0; i < 16; ++i) { p[(size_t)(c0 + i) * 16384] = pk2(r0, r1); const float cd = cdS[c0 + i], e = eS[c0 + i]; r0 = cd * r0 + e * bflo(d[i]); r1 = cd * r1 + e * bfhi(d[i]); }
#pragma unroll
            for (int i = 0; i < 16; ++i) d[i] = dn[i];
        }
    }
    if (part == 0 && tid < 128) {
        float* p = NT + (size_t)h * 256 * 128 + tid; float r = 0.f;
        for (int c0 = 0; c0 < 256; c0 += 16) {
            float d[16];
#pragma unroll
            for (int i = 0; i < 16; ++i) d[i] = p[(c0 + i) * 128];
#pragma unroll
            for (int i = 0; i < 16; ++i) { p[(c0 + i) * 128] = r; r = cdS[c0 + i] * r + eS[c0 + i] * d[i]; }
        }
    }
    __syncthreads();
}
__device__ __forceinline__ void ml_out_unit(int unit, const bf16_t* PROJ, const float* bif, const float* outg, const bf16_t* CT, const float* NT, const float* MC, bf16_t* Y,
                                            LAS unsigned char* lds, int tid, int wave, int lane) {
    const int h = unit >> 8, c = unit & 255, fr = lane & 15, fq = lane >> 4, tt = wave & 3, dvh = wave >> 2;
    LAS bf16_t* vT = (LAS bf16_t*)(lds + 18432);
    LAS float* dS = (LAS float*)(lds + 18432 + 36864);
    LAS float* pmS = dS + 64;
    LAS float* bS = pmS + 64;
    LAS float* nS = bS + 64;
    LAS float* ssS = nS + 128;
    u32x4 rk[2], rv[4];
    ml_stage_load(PROJ, h, c, false, tid, rk, rv);
    if (wave == 0) {
        const bf16_t* gp = PROJ + (size_t)(64 * c + lane) * ML_N + 6144 + h;
        const float ig = bf2f(gp[0]) + bif[h], lf = log_sigmoid(bf2f(gp[8]) + bif[8 + h]);
        float b = lf;
#pragma unroll
        for (int o = 1; o < 64; o <<= 1) { const float u = __shfl_up(b, o); if (lane >= o) b += u; }
        const float d = ig - b; float pm = d;
#pragma unroll
        for (int o = 1; o < 64; o <<= 1) { const float u = __shfl_up(pm, o); if (lane >= o) pm = fmaxf(pm, u); }
        dS[lane] = d; pmS[lane] = pm; bS[lane] = b;
    }
    if (tid >= 64 && tid < 192) nS[tid - 64] = NT[(size_t)(h * 256 + c) * 128 + tid - 64];
    const int trow = 16 * tt + fr;
    const float mc = MC[h * 256 + c];
    bf16x8 qf[4], kfr[4][4], ctf[4][4];
    {
        const bf16_t* qp = PROJ + (size_t)(64 * c + trow) * ML_N + h * 128 + 8 * fq;
#pragma unroll
        for (int ks = 0; ks < 4; ++ks) qf[ks] = *(const bf16x8*)(qp + 32 * ks);
#pragma unroll
        for (int T = 0; T < 4; ++T) {
            const int s_ = 32 * (T >> 1) + 8 * (fr >> 2) + 4 * (T & 1) + (fr & 3);
            const bf16_t* kp = PROJ + (size_t)(64 * c + s_) * ML_N + 1024 + h * 128 + 8 * fq;
#pragma unroll
            for (int ks = 0; ks < 4; ++ks) kfr[T][ks] = *(const bf16x8*)(kp + 32 * ks);
        }
    }
    const bf16_t* ctp = CT + ((size_t)(h * 256 + c) * 256 + 128 * dvh + fr) * 128 + 8 * fq;
#pragma unroll
    for (int dt = 0; dt < 4; ++dt)
#pragma unroll
        for (int ks = 0; ks < 4; ++ks) ctf[dt][ks] = *(const bf16x8*)(ctp + (size_t)(16 * dt) * 128 + 32 * ks);
    ml_stage_store(nullptr, vT, nullptr, false, tid, rk, rv);
    __syncthreads();
    const float Mt = fmaxf(mc, pmS[trow]), bt = bS[trow], dec = __expf(mc - Mt);
    float A[4][4]; float rsum = 0.f;
#pragma unroll
    for (int T = 0; T < 4; ++T) {
        f32x4 a = (f32x4){0.f, 0.f, 0.f, 0.f};
#pragma unroll
        for (int ks = 0; ks < 4; ++ks) a = MFMA16(kfr[T][ks], qf[ks], a);
#pragma unroll
        for (int i = 0; i < 4; ++i) { const int ss = 32 * (T >> 1) + 8 * fq + 4 * (T & 1) + i; const float v = ss <= trow ? __expf(dS[ss] - Mt) * a[i] * 0.08838834764831845f : 0.f; A[T][i] = v; rsum += v; }
    }
    bf16x8 ctg[4][4];
#pragma unroll
    for (int dt = 0; dt < 4; ++dt)
#pragma unroll
        for (int ks = 0; ks < 4; ++ks) ctg[dt][ks] = *(const bf16x8*)(ctp + (size_t)(16 * (dt + 4)) * 128 + 32 * ks);
    rsum = fq_sum(rsum);
    bf16x8 af[2];
#pragma unroll
    for (int u = 0; u < 2; ++u) { u32x4 w; w.x = pk2(A[2 * u][0], A[2 * u][1]); w.y = pk2(A[2 * u][2], A[2 * u][3]); w.z = pk2(A[2 * u + 1][0], A[2 * u + 1][1]); w.w = pk2(A[2 * u + 1][2], A[2 * u + 1][3]); af[u] = __builtin_bit_cast(bf16x8, w); }
    float qn = 0.f;
#pragma unroll
    for (int ks = 0; ks < 4; ++ks) { const u32x4 w = __builtin_bit_cast(u32x4, qf[ks]); const LAS float* np = nS + 32 * ks + 8 * fq;
        qn += bflo(w.x) * np[0] + bfhi(w.x) * np[1] + bflo(w.y) * np[2] + bfhi(w.y) * np[3] + bflo(w.z) * np[4] + bfhi(w.z) * np[5] + bflo(w.w) * np[6] + bfhi(w.w) * np[7]; }
    qn = fq_sum(qn);
    const float den = rsum + dec * qn, dnm = fmaxf(fabsf(den), __expf(-(bt + Mt))), inv = 1.0f / dnm;
    f32x4 acc[8];
    float ssq = 0.f;
#pragma unroll
    for (int dt = 0; dt < 8; ++dt) {
        f32x4 a = (f32x4){0.f, 0.f, 0.f, 0.f};
#pragma unroll
        for (int ks = 0; ks < 4; ++ks) a = MFMA16(dt < 4 ? ctf[dt][ks] : ctg[dt - 4 < 0 ? 0 : dt - 4][ks], qf[ks], a);
        a = a * dec;
#pragma unroll
        for (int u = 0; u < 2; ++u) a = MFMA16(*(LAS bf16x8*)(vT + (128 * dvh + 16 * dt + fr) * 72 + 8 * ((4 * u + fq + 2 * dt + (fr >> 3)) & 7)), af[u], a);
        a = a * inv;
        ssq += (a[0] * a[0] + a[1] * a[1]) + (a[2] * a[2] + a[3] * a[3]);
        acc[dt] = a;
    }
    ssq = fq_sum(ssq);
    if (fq == 0) ssS[wave * 16 + fr] = ssq;
    const size_t trg = (size_t)(64 * c + trow);
    f32x4 ggv[8]; u32x2 owv[8];
#pragma unroll
    for (int dt = 0; dt < 8; ++dt) { const int dv = 128 * dvh + 16 * dt + 4 * fq; ggv[dt] = *(const f32x4*)(outg + h * 256 + dv); owv[dt] = *(const u32x2*)(PROJ + trg * ML_N + 4096 + h * 256 + dv); }
    __syncthreads();
    const float tot = ssS[wave * 16 + fr] + ssS[(wave ^ 4) * 16 + fr];
    const float rs = 1.0f / sqrtf(tot * (1.0f / 256.0f) + EPS);
#pragma unroll
    for (int dt = 0; dt < 8; ++dt) {
        const int dv = 128 * dvh + 16 * dt + 4 * fq;
        const f32x4 gg = ggv[dt];
        const u32x2 ow = owv[dt];
        const float y0 = acc[dt][0] * rs * gg.x * sigmoidf_(bflo(ow.x)), y1 = acc[dt][1] * rs * gg.y * sigmoidf_(bfhi(ow.x));
        const float y2 = acc[dt][2] * rs * gg.z * sigmoidf_(bflo(ow.y)), y3 = acc[dt][3] * rs * gg.w * sigmoidf_(bfhi(ow.y));
        u32x2 w; w.x = pk2(y0, y1); w.y = pk2(y2, y3);
        *(u32x2*)(Y + trg * D_ + h * 256 + dv) = w;
    }
    __syncthreads();
}

#define GAS __attribute__((address_space(1)))
#define XB_TMO      128
#define XB_XCNT(j)  (256  + 64 * (j))
#define XB_XSUB(j)  (1280 + 64 * (j))
#define XB_XGEN(j)  (2304 + 64 * (j))
#define XB_TOP      3328
#define XB_TOPGEN   3392
#define XCD_BAR_WORDS 3456
#define XB_SPIN_CAP (1u << 18)

__device__ __forceinline__ unsigned xb_ld(unsigned* p)              { return __hip_atomic_load(p, __ATOMIC_RELAXED, __HIP_MEMORY_SCOPE_AGENT); }
__device__ __forceinline__ unsigned xb_add(unsigned* p, unsigned v) { return __hip_atomic_fetch_add(p, v, __ATOMIC_RELAXED, __HIP_MEMORY_SCOPE_AGENT); }
__device__ __forceinline__ unsigned xb_xcc_id() { return (unsigned)__builtin_amdgcn_s_getreg((3 << 11) | 20) & 0xFu; }
#define XB_SPIN(cond, bar) do { unsigned _sp = 0; while (cond) { __builtin_amdgcn_s_sleep(1); \
    if ((++_sp & 255u) == 0u) { if (xb_ld(&(bar)[XB_TMO])) break; if (_sp > XB_SPIN_CAP) { atomicAdd(&(bar)[XB_TMO], 1u); break; } } } } while (0)

struct XcdBarrier {
    unsigned* bar; unsigned x;
    volatile LAS unsigned* st;
};

__device__ __forceinline__ XcdBarrier xcd_barrier_post(unsigned* bar, volatile LAS unsigned* st) {
    XcdBarrier b; b.bar = bar; b.x = xb_xcc_id(); b.st = st;
    if (threadIdx.x == 0) (void)xb_add(&bar[XB_XCNT(b.x)], 1u);
    return b;
}
__device__ __forceinline__ void xcd_barrier_complete(unsigned* bar, unsigned x, unsigned& nloc, unsigned& nx) {
    const unsigned G = gridDim.x * gridDim.y * gridDim.z;
    unsigned sum, cnt, mine, sp = 0u;
    for (;;) {
        sum = 0u; cnt = 0u; mine = 0u;
#pragma unroll
        for (unsigned j = 0; j < 16; ++j) { const unsigned c = xb_ld(&bar[XB_XCNT(j)]); sum += c; cnt += (c > 0u) ? 1u : 0u; mine = (j == x) ? c : mine; }
        if (sum == G) break;
        __builtin_amdgcn_s_sleep(1);
        if ((++sp & 255u) == 0u) { if (xb_ld(&bar[XB_TMO])) break; if (sp > XB_SPIN_CAP) { atomicAdd(&bar[XB_TMO], 1u); break; } }
    }
    nloc = mine > 0u ? mine : 1u; nx = cnt > 0u ? cnt : 1u;
}

__device__ __forceinline__ void xcd_barrier(const XcdBarrier& b) {
    asm volatile("s_waitcnt vmcnt(0)" ::: "memory");
    __syncthreads();
    if (threadIdx.x == 0) {
        unsigned* bar = b.bar;
        __builtin_amdgcn_s_waitcnt(0);
        unsigned nloc = b.st[0], nx = b.st[1];
        if (nloc == 0u) { xcd_barrier_complete(bar, b.x, nloc, nx); b.st[0] = nloc; b.st[1] = nx; }
        const unsigned old = xb_add(&bar[XB_XSUB(b.x)], 1u);
        const unsigned gen = old / nloc;
        if (old + 1u == (gen + 1u) * nloc) {
            __builtin_amdgcn_fence(__ATOMIC_RELEASE, "agent");
            asm volatile("s_waitcnt vmcnt(0)" ::: "memory");
            const unsigned og = xb_add(&bar[XB_TOP], 1u);
            const unsigned tg = og / nx;
            if (og + 1u == (tg + 1u) * nx) xb_add(&bar[XB_TOPGEN], 1u);
            else XB_SPIN(xb_ld(&bar[XB_TOPGEN]) == tg, bar);
            __builtin_amdgcn_fence(__ATOMIC_ACQUIRE, "agent");
            xb_add(&bar[XB_XGEN(b.x)], 1u);
            asm volatile("s_waitcnt vmcnt(0)" ::: "memory");
        } else {
            XB_SPIN(xb_ld(&bar[XB_XGEN(b.x)]) == gen, bar);
            __builtin_amdgcn_fence(__ATOMIC_ACQUIRE, "agent");
            asm volatile("s_waitcnt vmcnt(0)" ::: "memory");
        }
    }
    __syncthreads();
}

#ifndef REP_UP
#define REP_UP 1
#endif
#ifndef REP_P0
#define REP_P0 1
#endif
#ifndef REP_CMP
#define REP_CMP 1
#endif
#ifndef REP_ATTN
#define REP_ATTN 1
#endif
#ifndef REP_MLL
#define REP_MLL 1
#endif
#ifndef REP_MLO
#define REP_MLO 1
#endif
__global__ void __launch_bounds__(NTHR, 2) fwd_kernel(Args args) {
    extern __shared__ __attribute__((aligned(16))) unsigned char lds_raw[];
    LAS unsigned char* lds = (LAS unsigned char*)lds_raw;
    cg::grid_group grid = cg::this_grid();
    volatile LAS unsigned* bar_st = (volatile LAS unsigned*)(lds + LDS_BYTES - 64);
    if (threadIdx.x == 0) { bar_st[0] = 0u; bar_st[1] = 0u; }
    __syncthreads();
    XcdBarrier xbar; xbar.bar = (unsigned*)(args.ws + WS_MISC); xbar.x = 0; xbar.st = nullptr;
    if (args.ph_hi - args.ph_lo > 1) xbar = xcd_barrier_post((unsigned*)(args.ws + WS_MISC), bar_st);
    const int wave0 = __builtin_amdgcn_readfirstlane((int)(threadIdx.x >> 6));
    const int G0 = gridDim.x, bid0 = blockIdx.x;
    const int lo = args.ph_lo, hi = args.ph_hi;
#define X (args.out)
#define XN ((bf16_t*)(ws + WS_XN))
#define XBS ((bf16_t*)(ws + WS_XB))
#define Yb ((bf16_t*)(ws + WS_XN))
#define PROJ ((bf16_t*)(ws + WS_PROJ))
#define Hb ((bf16_t*)(ws + WS_PROJ))
#define nb (ws + WS_NSAW + j * NSAW_STRIDE)
#define mb (ws + WS_MLW + j * MLW_STRIDE)
#define KS ((bf16_t*)(ws + WS_EXT + EXT_KS))
#define KW ((bf16_t*)(ws + WS_EXT + EXT_KW))
#define VTS ((bf16_t*)(ws + WS_EXT + EXT_VTS))
#define VTW ((bf16_t*)(ws + WS_EXT + EXT_VTW))
#define KC ((bf16_t*)(ws + WS_EXT + EXT_KC))
#define VTC ((bf16_t*)(ws + WS_EXT + EXT_VTC))
#define CT ((bf16_t*)(ws + WS_EXT + EXT_CT))
#define NT ((float*)(ws + WS_EXT + EXT_NT))
#define CI ((float*)(ws + WS_EXT + EXT_CI))
#define MC ((float*)(ws + WS_EXT + EXT_MC))
#define bif (args.in[13] + j * 16)
    int ph = 0;
#define PHASE_BEGIN if (lo <= ph && ph < hi) { int bid = bid0, G = G0; asm volatile("" : "+s"(bid), "+s"(G)); const int NGW = G * NWAVES; int tid = wave0 * 64 + (int)__builtin_amdgcn_mbcnt_hi(~0u, __builtin_amdgcn_mbcnt_lo(~0u, 0u)); asm volatile("" : "+v"(tid)); const int lane = tid & 63; const int wave = __builtin_amdgcn_readfirstlane(tid >> 6); const int gw = bid * NWAVES + wave; unsigned char* ws = args.ws; asm volatile("" : "+s"(ws));
#define PHASE_END if (ph + 1 < hi) { if (hi == 0x7fffffff) grid.sync(); else xcd_barrier(xbar); } } ++ph;

    PHASE_BEGIN
    {
        LAS float* scr = (LAS float*)(lds + wave * 17408);
        for (int rep_ = 0; rep_ < REP_P0; ++rep_) {
        int rot = 0;
#pragma unroll 1
        for (int l = 0; l < 4; ++l) {
            bf16_t* wgu = (bf16_t*)(ws + WS_FFN + l * FFN_STRIDE); bf16_t* wd = (bf16_t*)(ws + WS_FFN + l * FFN_STRIDE + FFN_WD);
            tr_matrix(args.in[16] + (size_t)l * D_ * DFF, D_, DFF, wgu, 1, 0, scr, gw, NGW, lane, rot);
            tr_matrix(args.in[17] + (size_t)l * D_ * DFF, D_, DFF, wgu, 1, 128, scr, gw, NGW, lane, rot);
            tr_matrix(args.in[18] + (size_t)l * DFF * D_, DFF, D_, wd, 0, 0, scr, gw, NGW, lane, rot);
        }
#pragma unroll 1
        for (int j = 0; j < 2; ++j) {
            tr_matrix(args.in[3] + (size_t)j * D_ * NSA_IN, D_, NSA_IN, (bf16_t*)nb, 0, 0, scr, gw, NGW, lane, rot);
            tr_matrix(args.in[11] + (size_t)j * D_ * D_, D_, D_, (bf16_t*)(nb + NSAW_OUT), 0, 0, scr, gw, NGW, lane, rot);
            tr_matrix(args.in[8] + (size_t)(j * 2 + 0) * 4096 * 128, 4096, 128, (bf16_t*)(nb + NSAW_W1), 0, 0, scr, gw, NGW, lane, rot);
            tr_matrix(args.in[8] + (size_t)(j * 2 + 1) * 4096 * 128, 4096, 128, (bf16_t*)(nb + NSAW_W1) + 128 * 4096, 0, 0, scr, gw, NGW, lane, rot);
            tr_matrix(args.in[10] + (size_t)(j * 2 + 0) * 128 * 128, 128, 128, (bf16_t*)(nb + NSAW_W2), 0, 0, scr, gw, NGW, lane, rot);
            tr_matrix(args.in[10] + (size_t)(j * 2 + 1) * 128 * 128, 128, 128, (bf16_t*)(nb + NSAW_W2) + 128 * 128, 0, 0, scr, gw, NGW, lane, rot);
            tr_matrix(args.in[12] + (size_t)j * D_ * ML_IN, D_, ML_IN, (bf16_t*)mb, 0, 0, scr, gw, NGW, lane, rot);
            tr_matrix(args.in[15] + (size_t)j * D_ * D_, D_, D_, (bf16_t*)(mb + MLW_OUT), 0, 0, scr, gw, NGW, lane, rot);
        }
        }
        rmsnorm_phase(args.in[0], args.in[1], XN, nullptr, gw, NGW, lane);
    }
    PHASE_END

#pragma unroll 1
    for (int i = 0; i < 4; ++i) {
        const int j = i >> 1;
        if (i > 0) {
            PHASE_BEGIN
            rmsnorm_bf16_phase(XBS, args.in[1] + i * D_, XN, gw, NGW, lane);
            PHASE_END
        }
        if ((i & 1) == 0) {
            PHASE_BEGIN
            for (int tb = bid; tb < 256; tb += G) gate_gemm<3>(XN, (const bf16_t*)nb + (size_t)5120 * D_, PROJ, NSA_N, 5120, tb, lds, tid, wave, lane);
            { pg8::Gemm g{XN, (const bf16_t*)nb, S_, 5120, D_}; pg8::StaticOrder So; So.init(S_, 5120, G, bid); pg8::EpiStore E{PROJ, NSA_N};
              pg8::gemm_phase<pg8::EpiStore, pg8::StaticOrder, true, true>(lds, g, So, E, tid); }
            PHASE_END
            PHASE_BEGIN
            for (int tb = bid; tb < 256; tb += G) nsa_prep_unit(tb, PROJ, args.in[5] + j * 128, args.in[6] + j * 384, KS, KW, VTS, VTW, tid);
            for (int rep_ = 0; rep_ < REP_CMP; ++rep_)
            for (int task = bid; task < 256; task += G)
                nsa_compress_unit(task, PROJ, args.in[7] + (size_t)j * 2 * 32 * 128, (const bf16_t*)(nb + NSAW_W1), args.in[9] + j * 256, (const bf16_t*)(nb + NSAW_W2), args.in[6] + j * 384, KC, VTC, lds, tid, wave, lane);
            PHASE_END
            PHASE_BEGIN
            for (int rep_ = 0; rep_ < REP_ATTN; ++rep_)
            for (int task = bid; task < 1024; task += G) {
                const int k = task >> 8, bb = task & 255, xg = bb & 3, half = (bb >> 2) & 1, wi = bb >> 3;
                const int qb = half == 0 ? (k == 0 ? wi : k == 1 ? 127 - wi : k == 2 ? 128 + wi : 255 - wi) : (k == 0 ? 32 + wi : k == 1 ? 95 - wi : k == 2 ? 160 + wi : 223 - wi);
                nsa_attn_wg(qb, xg, PROJ, args.in[4] + j * 48, KC, VTC, KS, VTS, KW, VTW, Yb, lds, tid, wave, lane);
            }
            PHASE_END
            PHASE_BEGIN
            { pg8::Gemm g{Yb, (const bf16_t*)(nb + NSAW_OUT), S_, D_, D_}; pg8::StaticOrder So; So.init(S_, D_, G, bid); pg8::EpiResid E{i == 0 ? args.in[0] : (const float*)nullptr, XBS, nullptr, D_};
              pg8::gemm_phase<pg8::EpiResid, pg8::StaticOrder, true, true>(lds, g, So, E, tid); }
            PHASE_END
        } else {
            PHASE_BEGIN
            for (int tb = bid; tb < 256; tb += G) gate_gemm<1>(XN, (const bf16_t*)mb + (size_t)6144 * D_, PROJ, ML_N, 6144, tb, lds, tid, wave, lane);
            { pg8::Gemm g{XN, (const bf16_t*)mb, S_, 6144, D_}; pg8::StaticOrder So; So.init(S_, 6144, G, bid); pg8::EpiStore E{PROJ, ML_N};
              pg8::gemm_phase<pg8::EpiStore, pg8::StaticOrder, true, true>(lds, g, So, E, tid); }
            PHASE_END
            PHASE_BEGIN
            ml_local_phase(bid, G, PROJ, bif, CT, NT, CI, lds, tid, wave, lane);
            PHASE_END
            PHASE_BEGIN
            for (int u = bid; u < 256; u += G) ml_scan_unit(u, CT, NT, CI, MC, lds, tid);
            PHASE_END
            PHASE_BEGIN
            for (int rep_ = 0; rep_ < REP_MLO; ++rep_)
            for (int u = bid; u < 2048; u += G) ml_out_unit(u, PROJ, bif, args.in[14] + j * D_, CT, NT, MC, Yb, lds, tid, wave, lane);
            PHASE_END
            PHASE_BEGIN
            { pg8::Gemm g{Yb, (const bf16_t*)(mb + MLW_OUT), S_, D_, D_}; pg8::StaticOrder So; So.init(S_, D_, G, bid); pg8::EpiResid E{nullptr, XBS, nullptr, D_};
              pg8::gemm_phase<pg8::EpiResid, pg8::StaticOrder, true, true>(lds, g, So, E, tid); }
            PHASE_END
        }
        PHASE_BEGIN
        rmsnorm_bf16_phase(XBS, args.in[2] + i * D_, XN, gw, NGW, lane);
        PHASE_END
        PHASE_BEGIN
        for (int rep_ = 0; rep_ < REP_UP; ++rep_)
        { pg8::Gemm g{XN, (const bf16_t*)(ws + WS_FFN + i * FFN_STRIDE), S_, 2 * DFF, D_}; pg8::StaticOrder So; So.init(S_, 2 * DFF, G, bid); pg8::EpiSwiglu E{Hb, DFF};
          pg8::gemm_phase<pg8::EpiSwiglu, pg8::StaticOrder, true, true>(lds, g, So, E, tid); }
        PHASE_END
        PHASE_BEGIN
        { pg8::Gemm g{Hb, (const bf16_t*)(ws + WS_FFN + i * FFN_STRIDE + FFN_WD), S_, D_, DFF}; pg8::StaticOrder So; So.init(S_, D_, G, bid); pg8::EpiResid E{nullptr, XBS, i == 3 ? X : (float*)nullptr, D_};
          pg8::gemm_phase<pg8::EpiResid, pg8::StaticOrder, true, true>(lds, g, So, E, tid); }
        PHASE_END
    }
}

#ifndef ONE_LAUNCH
#define ONE_LAUNCH 0
#endif
extern "C" void kernel_launch(void* const* d_in, const int* in_sizes, int n_in, void* d_out, int out_size, void* d_ws, size_t ws_size, hipStream_t stream) {
    static int grid = 0;
    if (grid == 0) {
        if (n_in != 19 || out_size != S_ * D_ || ws_size < WS_END) { fprintf(stderr, "kernel_launch: unexpected shapes n_in %d out %d ws %zu\n", n_in, out_size, ws_size); grid = -1; return; }
        int dev = 0, cus = 0, per_cu = 0;
        hipGetDevice(&dev); hipDeviceGetAttribute(&cus, hipDeviceAttributeMultiprocessorCount, dev);
        if (hipFuncSetAttribute((const void*)fwd_kernel, hipFuncAttributeMaxDynamicSharedMemorySize, LDS_BYTES) != hipSuccess) { fprintf(stderr, "kernel_launch: hipFuncSetAttribute failed\n"); grid = -1; return; }
        if (hipOccupancyMaxActiveBlocksPerMultiprocessor(&per_cu, (const void*)fwd_kernel, NTHR, LDS_BYTES) != hipSuccess || per_cu < 1) { fprintf(stderr, "kernel_launch: occupancy query says %d\n", per_cu); per_cu = 1; }
        (void)hipGetLastError();
        grid = cus;
        if (grid != 256) fprintf(stderr, "kernel_launch: %d CUs\n", grid);
    }
    if (grid < 0) return;
    Args a{};
    for (int i = 0; i < 19; ++i) a.in[i] = (const float*)d_in[i];
    a.out = (float*)d_out; a.ws = (unsigned char*)d_ws;
#if ONE_LAUNCH
    if (hipMemsetAsync((char*)d_ws + WS_MISC, 0, 16384, stream) != hipSuccess) { fprintf(stderr, "kernel_launch: memset failed\n"); return; }
    a.ph_lo = 0; a.ph_hi = NPH;
    void* kargs[] = {&a};
    hipError_t e = hipLaunchCooperativeKernel((const void*)fwd_kernel, dim3(grid), dim3(NTHR), kargs, LDS_BYTES, stream);
    if (e != hipSuccess) fprintf(stderr, "cooperative launch failed: %s (grid %d)\n", hipGetErrorString(e), grid);
#else
    for (int p = 0; p < NPH; ++p) {
        a.ph_lo = p; a.ph_hi = p + 1;
        hipLaunchKernelGGL(fwd_kernel, dim3(grid), dim3(NTHR), LDS_BYTES, stream, a);
    }
#endif
}
```

```cpp
#include <hip/hip_runtime.h>
#include <hip/hip_cooperative_groups.h>
#include <cstdio>
#include <cstdint>
#define ONE_LAUNCH 1
namespace pg8 {
#define PG8_LAS __attribute__((address_space(3)))
typedef unsigned short bf16_t;
typedef short bf16x8 __attribute__((ext_vector_type(8)));
typedef float f32x4 __attribute__((ext_vector_type(4)));
typedef unsigned u32x4 __attribute__((ext_vector_type(4)));
constexpr int BM = 256, BK = 64, HALF = 128, HTB = HALF * BK * 2  , STAGE_BYTES = 8 * HTB, NXCD = 8, WGM = 2;

__host__ __device__ __forceinline__ int lds_byte(int r, int c) { const int st = (r >> 4) * 2 + (c >> 5), rr = r & 15, cc = c & 31, ob = rr * 64 + cc * 2; return st * 1024 + (ob ^ (((ob >> 9) & 1) << 5)); }
__host__ __device__ __forceinline__ void stage_rc(int b, int& R, int& C) { const int st = b / 1024, sb = b % 1024, swz = sb ^ (((sb >> 9) & 1) << 5); R = (st >> 1) * 16 + swz / 64; C = (st & 1) * 32 + (swz % 64) / 2; }
__host__ __device__ __forceinline__ int perm32(int rho) { const int n = rho >> 4, i = rho & 15; return 8 * (i >> 2) + 4 * n + (i & 3); }

struct Unit { int pm, pn; };
struct Gemm { const bf16_t* A; const bf16_t* Bt; int M, N, K; };

struct StaticOrder {
    int nM, nN, nwg, G, c;
    __host__ __device__ void init(int M, int N, int G_, int c_) { nM = M / BM; nN = N / BM; nwg = nM * nN; G = G_; c = c_; }
    __host__ __device__ bool next(int i, Unit& u) const {
        const long L = (long)i * G + c; if (L >= nwg) return false;
        int wgid = (int)L; { const int q = nwg / NXCD, r = nwg % NXCD, xcd = wgid % NXCD, off = wgid / NXCD; wgid = (xcd < r ? xcd * (q + 1) : r * (q + 1) + (xcd - r) * q) + off; }
        const int nig = WGM * nN, gid = wgid / nig, fm = gid * WGM, gsz = (nM - fm) < WGM ? (nM - fm) : WGM;
        u.pm = fm + ((wgid % nig) % gsz); u.pn = (wgid % nig) / gsz; return true;
    }
    __device__ __forceinline__ void a_ready(const Unit&) const {}
    __device__ __forceinline__ void done(const Unit&) const {}
};
__device__ __forceinline__ unsigned cvt_pk_bf16(float lo, float hi) { unsigned r; asm volatile("v_cvt_pk_bf16_f32 %0, %1, %2" : "=v"(r) : "v"(lo), "v"(hi)); return r; }
typedef float f32x2e __attribute__((ext_vector_type(2))); typedef unsigned u32x2e __attribute__((ext_vector_type(2))); typedef __bf16 bf16x2e __attribute__((ext_vector_type(2)));
__device__ __forceinline__ unsigned pk2(float lo, float hi) { f32x2e v = {lo, hi}; bf16x2e b = __builtin_convertvector(v, bf16x2e); return __builtin_bit_cast(unsigned, b); }
struct EpiStore {
    static constexpr bool PERM = true, AFTER_DRAIN = false;
    bf16_t* O; int ldc;
    __device__ __forceinline__ void operator()(const f32x4 (&acc)[2][2][4][2], const Unit& u, int wr, int wc, int fr, int fq) const {
        const int row0 = u.pm * BM + wr * 64 + fr, col0 = u.pn * BM + wc * 32 + 8 * fq;
#pragma unroll
        for (int ai = 0; ai < 2; ++ai)
#pragma unroll
            for (int m = 0; m < 4; ++m) { bf16_t* rowp = O + (size_t)(row0 + ai * HALF + m * 16) * ldc + col0;
#pragma unroll
                for (int bj = 0; bj < 2; ++bj) { const f32x4 v0 = acc[ai][bj][m][0], v1 = acc[ai][bj][m][1];
                    u32x4 w; w.x = pk2(v0[0], v0[1]); w.y = pk2(v0[2], v0[3]); w.z = pk2(v1[0], v1[1]); w.w = pk2(v1[2], v1[3]);
                    *(u32x4*)(rowp + bj * HALF) = w; } }
    }
};
struct EpiSwiglu {
    static constexpr bool PERM = true, AFTER_DRAIN = false;
    bf16_t* H; int ldc;
    __device__ __forceinline__ void operator()(const f32x4 (&acc)[2][2][4][2], const Unit& u, int wr, int wc, int fr, int fq) const {
        const int row0 = u.pm * BM + wr * 64 + fr, col0 = u.pn * HALF + wc * 32 + 8 * fq;
#pragma unroll
        for (int ai = 0; ai < 2; ++ai)
#pragma unroll
            for (int m = 0; m < 4; ++m) { bf16_t* rowp = H + (size_t)(row0 + ai * HALF + m * 16) * ldc + col0;
                float h[8];
#pragma unroll
                for (int n = 0; n < 2; ++n)
#pragma unroll
                    for (int e = 0; e < 4; ++e) { const float g = acc[ai][0][m][n][e], up = acc[ai][1][m][n][e];
                        h[n * 4 + e] = g * up * __builtin_amdgcn_rcpf(1.0f + __builtin_amdgcn_exp2f(-1.4426950408889634f * g)); }
                u32x4 w; w.x = pk2(h[0], h[1]); w.y = pk2(h[2], h[3]); w.z = pk2(h[4], h[5]); w.w = pk2(h[6], h[7]);
                *(u32x4*)rowp = w; }
    }
};
struct EpiResid {
    static constexpr bool PERM = true, AFTER_DRAIN = false;
    const float* Xf_in; bf16_t* Xb; float* Xf_out; int ldc;
    __device__ __forceinline__ void operator()(const f32x4 (&acc)[2][2][4][2], const Unit& u, int wr, int wc, int fr, int fq) const {
        const int row0 = u.pm * BM + wr * 64 + fr, col0 = u.pn * BM + wc * 32 + 8 * fq;
#pragma unroll
        for (int ai = 0; ai < 2; ++ai)
#pragma unroll
            for (int mp = 0; mp < 2; ++mp) {
                f32x4 pre[2][2][2];
#pragma unroll
                for (int mm = 0; mm < 2; ++mm) { const size_t off = (size_t)(row0 + ai * HALF + (2 * mp + mm) * 16) * ldc + col0;
#pragma unroll
                    for (int bj = 0; bj < 2; ++bj) {
                        if (Xf_in) { pre[mm][bj][0] = *(const f32x4*)(Xf_in + off + bj * HALF); pre[mm][bj][1] = *(const f32x4*)(Xf_in + off + bj * HALF + 4); }
                        else { const u32x4 w = *(const u32x4*)(Xb + off + bj * HALF);
                               pre[mm][bj][0] = (f32x4){__uint_as_float(w.x << 16), __uint_as_float(w.x & 0xffff0000u), __uint_as_float(w.y << 16), __uint_as_float(w.y & 0xffff0000u)};
                               pre[mm][bj][1] = (f32x4){__uint_as_float(w.z << 16), __uint_as_float(w.z & 0xffff0000u), __uint_as_float(w.w << 16), __uint_as_float(w.w & 0xffff0000u)}; } } }
#pragma unroll
                for (int mm = 0; mm < 2; ++mm) { const size_t off = (size_t)(row0 + ai * HALF + (2 * mp + mm) * 16) * ldc + col0;
#pragma unroll
                    for (int bj = 0; bj < 2; ++bj) { const f32x4 v0 = pre[mm][bj][0] + acc[ai][bj][2 * mp + mm][0], v1 = pre[mm][bj][1] + acc[ai][bj][2 * mp + mm][1];
                        if (!Xf_out) { u32x4 w; w.x = pk2(v0[0], v0[1]); w.y = pk2(v0[2], v0[3]); w.z = pk2(v1[0], v1[1]); w.w = pk2(v1[2], v1[3]); *(u32x4*)(Xb + off + bj * HALF) = w; }
                        if (Xf_out) { *(f32x4*)(Xf_out + off + bj * HALF) = v0; *(f32x4*)(Xf_out + off + bj * HALF + 4) = v1; } } }
                asm volatile("" ::: "memory");
            }
    }
};
template <class Epi, class Sched, bool ALIGN_EPI = false, bool SP2 = false>
__device__ __forceinline__ void gemm_phase(PG8_LAS unsigned char* lds, const Gemm g, const Sched& S, const Epi& E, int tid_in) {
    int tid_l = tid_in; asm volatile("" : "+v"(tid_l)); const int tid = tid_l, wid = __builtin_amdgcn_readfirstlane(tid >> 6), lane = tid & 63, wr = wid >> 2, wc = wid & 3, fr = lane & 15, fq = lane >> 4;
    const int K = g.K, nt = K / BK;
    unsigned voffA[2], voffB[2];
#pragma unroll
    for (int i = 0; i < 2; ++i) { int R, C; stage_rc(tid * 16 + i * 8192, R, C); const int Rb = Epi::PERM ? ((R & ~31) + perm32(R & 31)) : R;
        voffA[i] = (unsigned)(R * K + C) * 2u; voffB[i] = (unsigned)(Rb * K + C) * 2u; }
    const size_t kstep = (size_t)(BK * 2);
    const size_t hstep = (size_t)HALF * K * 2;
    const size_t tstep = 2 * hstep;
    const unsigned ldsw = (unsigned)wid * 1024u;
    const int aoff = lds_byte(wr * 64 + fr, fq * 8), boff = lds_byte(wc * 32 + fr, fq * 8);
#define PG8_SA(b, h) (((b) * 2 + (h)) * HTB)
#define PG8_SB(b, h) ((4 + (b) * 2 + (h)) * HTB)
#define PG8_STAGE(bufoff, gbase, voff) do { _Pragma("unroll") for (int _i = 0; _i < 2; ++_i) \
        __builtin_amdgcn_global_load_lds((const unsigned*)((const char*)(gbase) + (voff)[_i]), (PG8_LAS unsigned*)(lds + (bufoff) + ldsw + _i * 8192), 16, 0, 0); } while (0)
#define PG8_LDA(dst, b, h) do { _Pragma("unroll") for (int m = 0; m < 4; ++m) _Pragma("unroll") for (int k = 0; k < 2; ++k) dst[m][k] = *(const PG8_LAS bf16x8*)(lds + PG8_SA(b, h) + aoff + m * 2048 + k * 1024); } while (0)
#define PG8_LDB(dst, b, h) do { _Pragma("unroll") for (int n = 0; n < 2; ++n) _Pragma("unroll") for (int k = 0; k < 2; ++k) dst[n][k] = *(const PG8_LAS bf16x8*)(lds + PG8_SB(b, h) + boff + n * 2048 + k * 1024); } while (0)
#define PG8_MMA(ai, bj, At, Bt) do { __builtin_amdgcn_s_setprio(1); _Pragma("unroll") for (int m = 0; m < 4; ++m) _Pragma("unroll") for (int n = 0; n < 2; ++n) _Pragma("unroll") for (int k = 0; k < 2; ++k) \
        acc[ai][bj][m][n] = __builtin_amdgcn_mfma_f32_16x16x32_bf16(Bt[n][k], At[m][k], acc[ai][bj][m][n], 0, 0, 0); __builtin_amdgcn_s_setprio(0); } while (0)
#define PG8_WAIT_V(n) asm volatile("s_waitcnt vmcnt(" #n ")" ::: "memory")
#define PG8_WAIT_L(n) asm volatile("s_waitcnt lgkmcnt(" #n ")" ::: "memory")
#define PG8_BAR __builtin_amdgcn_s_barrier()
#define PG8_SCHED __builtin_amdgcn_sched_barrier(0)
    Unit cur, nxt; int ui = 0;
    if (!S.next(0, cur)) return;
    f32x4 acc[2][2][4][2];
#pragma unroll
    for (int a = 0; a < 2; ++a)
#pragma unroll
        for (int b = 0; b < 2; ++b)
#pragma unroll
            for (int m = 0; m < 4; ++m)
#pragma unroll
                for (int n = 0; n < 2; ++n) acc[a][b][m][n] = (f32x4){0.f, 0.f, 0.f, 0.f};
    bf16x8 At[4][2], B0[2][2], B1[2][2];
    const char* cA = (const char*)g.A + (size_t)cur.pm * tstep; const char* cB = (const char*)g.Bt + (size_t)cur.pn * tstep;
    S.a_ready(cur);
    if constexpr (SP2) {
        PG8_STAGE(PG8_SB(0, 0), cB, voffB); PG8_STAGE(PG8_SB(0, 1), cB + hstep, voffB); PG8_STAGE(PG8_SA(0, 0), cA, voffA); PG8_STAGE(PG8_SA(0, 1), cA + hstep, voffA);
        if (wr == 1) PG8_BAR;
        PG8_WAIT_V(2); PG8_BAR;
        PG8_STAGE(PG8_SB(1, 0), cB + kstep, voffB); PG8_STAGE(PG8_SA(1, 0), cA + kstep, voffA); PG8_STAGE(PG8_SB(1, 1), cB + hstep + kstep, voffB);
        PG8_WAIT_V(6); PG8_BAR;
    } else {
        PG8_STAGE(PG8_SB(0, 0), cB, voffB); PG8_STAGE(PG8_SA(0, 0), cA, voffA); PG8_STAGE(PG8_SB(0, 1), cB + hstep, voffB); PG8_STAGE(PG8_SA(0, 1), cA + hstep, voffA);
        if (wr == 1) PG8_BAR;
        PG8_WAIT_V(4); PG8_BAR;
        PG8_STAGE(PG8_SB(1, 0), cB + kstep, voffB); PG8_STAGE(PG8_SA(1, 0), cA + kstep, voffA); PG8_STAGE(PG8_SB(1, 1), cB + hstep + kstep, voffB);
        PG8_WAIT_V(6); PG8_BAR;
    }
    for (;;) {
        const bool has_next = S.next(ui + 1, nxt);
        const char* nA = has_next ? (const char*)g.A + (size_t)nxt.pm * tstep : cA; const char* nB = has_next ? (const char*)g.Bt + (size_t)nxt.pn * tstep : cB;
        for (int t = 0; t < nt; t += 2) {
            const bool last = (t == nt - 2);
            const char* a1 = cA + (size_t)(t + 1) * kstep;
            const char* a2 = last ? nA : cA + (size_t)(t + 2) * kstep; const char* b2 = last ? nB : cB + (size_t)(t + 2) * kstep;
            const char* a3 = a2 + kstep; const char* b3 = b2 + kstep;
            if (last && has_next) S.a_ready(nxt);
            if constexpr (SP2) {
            PG8_LDB(B0, 0, 0); PG8_LDB(B1, 0, 1); PG8_SCHED; PG8_LDA(At, 0, 0); PG8_STAGE(PG8_SA(1, 1), a1 + hstep, voffA);
            PG8_WAIT_V(8); PG8_WAIT_L(0); PG8_BAR; PG8_MMA(0, 0, At, B0); PG8_MMA(0, 1, At, B1); PG8_BAR; PG8_SCHED;
            PG8_LDA(At, 0, 1); PG8_STAGE(PG8_SB(0, 0), b2, voffB); PG8_STAGE(PG8_SB(0, 1), b2 + hstep, voffB); PG8_STAGE(PG8_SA(0, 0), a2, voffA);
            PG8_WAIT_V(8); PG8_WAIT_L(0); PG8_BAR; PG8_MMA(1, 0, At, B0); PG8_MMA(1, 1, At, B1); PG8_BAR; PG8_SCHED;
            PG8_LDB(B0, 1, 0); PG8_LDB(B1, 1, 1); PG8_SCHED; PG8_LDA(At, 1, 0); PG8_STAGE(PG8_SA(0, 1), a2 + hstep, voffA);
            PG8_WAIT_V(8); PG8_WAIT_L(0); PG8_BAR; PG8_MMA(0, 0, At, B0); PG8_MMA(0, 1, At, B1); PG8_BAR; PG8_SCHED;
            PG8_LDA(At, 1, 1); PG8_STAGE(PG8_SB(1, 0), b3, voffB); PG8_STAGE(PG8_SB(1, 1), b3 + hstep, voffB); PG8_STAGE(PG8_SA(1, 0), a3, voffA);
            PG8_WAIT_V(8); PG8_WAIT_L(0); PG8_BAR; PG8_MMA(1, 0, At, B0); PG8_MMA(1, 1, At, B1); PG8_BAR; PG8_SCHED;
            } else {
            PG8_LDB(B0, 0, 0); PG8_SCHED; PG8_LDA(At, 0, 0); PG8_STAGE(PG8_SA(1, 1), a1 + hstep, voffA);
            PG8_WAIT_L(8); PG8_BAR; PG8_WAIT_L(0); PG8_MMA(0, 0, At, B0); PG8_BAR; PG8_SCHED;
            PG8_LDB(B1, 0, 1); PG8_STAGE(PG8_SB(0, 0), b2, voffB);
            PG8_BAR; PG8_WAIT_L(0); PG8_MMA(0, 1, At, B1); PG8_BAR;
            PG8_LDA(At, 0, 1); PG8_STAGE(PG8_SA(0, 0), a2, voffA);
            PG8_BAR; PG8_WAIT_L(0); PG8_MMA(1, 0, At, B0); PG8_BAR; PG8_SCHED;
            PG8_STAGE(PG8_SB(0, 1), b2 + hstep, voffB);
            PG8_WAIT_V(6); PG8_BAR; PG8_MMA(1, 1, At, B1); PG8_BAR;
            PG8_LDB(B0, 1, 0); PG8_SCHED; PG8_LDA(At, 1, 0); PG8_STAGE(PG8_SA(0, 1), a2 + hstep, voffA);
            PG8_WAIT_L(8); PG8_BAR; PG8_WAIT_L(0); PG8_MMA(0, 0, At, B0); PG8_BAR; PG8_SCHED;
            PG8_LDB(B1, 1, 1); PG8_STAGE(PG8_SB(1, 0), b3, voffB);
            PG8_BAR; PG8_WAIT_L(0); PG8_MMA(0, 1, At, B1); PG8_BAR;
            PG8_LDA(At, 1, 1); PG8_STAGE(PG8_SA(1, 0), a3, voffA);
            PG8_BAR; PG8_WAIT_L(0); PG8_MMA(1, 0, At, B0); PG8_BAR; PG8_SCHED;
            PG8_STAGE(PG8_SB(1, 1), b3 + hstep, voffB);
            PG8_WAIT_V(6); PG8_BAR; PG8_MMA(1, 1, At, B1); PG8_BAR;
            }
        }
        if constexpr (ALIGN_EPI) { if (wr == 0) PG8_BAR; }
        if constexpr (!Epi::AFTER_DRAIN) { E(acc, cur, wr, wc, fr, fq); S.done(cur); }
        if (!has_next) break;
#pragma unroll
        for (int a = 0; a < 2; ++a)
#pragma unroll
            for (int b = 0; b < 2; ++b)
#pragma unroll
                for (int m = 0; m < 4; ++m)
#pragma unroll
                    for (int n = 0; n < 2; ++n) acc[a][b][m][n] = (f32x4){0.f, 0.f, 0.f, 0.f};
        cur = nxt; cA = nA; cB = nB; ++ui;
        if constexpr (ALIGN_EPI) { if (wr == 1) PG8_BAR; }
    }
    PG8_WAIT_V(0);
    if constexpr (!ALIGN_EPI) { if (wr == 0) PG8_BAR; }
    PG8_BAR;
    if constexpr (Epi::AFTER_DRAIN) { E.fused(acc, cur, wr, wc, fr, fq, lds, wid, lane); S.done(cur); }
#undef PG8_SA
#undef PG8_SB
#undef PG8_STAGE
#undef PG8_LDA
#undef PG8_LDB
#undef PG8_MMA
#undef PG8_WAIT_V
#undef PG8_WAIT_L
#undef PG8_BAR
#undef PG8_SCHED
}
}
namespace cg = cooperative_groups;
#define LAS __attribute__((address_space(3)))
typedef unsigned short bf16_t;
typedef short bf16x8 __attribute__((ext_vector_type(8)));
typedef float f32x4 __attribute__((ext_vector_type(4)));
typedef unsigned u32x4 __attribute__((ext_vector_type(4)));
typedef unsigned u32x2 __attribute__((ext_vector_type(2)));
#define MFMA16(a, b, c) __builtin_amdgcn_mfma_f32_16x16x32_bf16((a), (b), (c), 0, 0, 0)
using pg8::pk2;

constexpr int S_ = 16384, D_ = 2048, DFF = 5632;
constexpr int NSA_N = 5376, NSA_IN = 5168, ML_N = 6400, ML_IN = 6160;
constexpr float EPS = 1e-6f;
constexpr float QSCALE = 0.08838834764831845f * 1.4426950408889634f;
constexpr float NEG = -1e30f;
constexpr int NWAVES = 8, NTHR = 512, LDS_BYTES = 147456;
constexpr int NPH = 34;

constexpr size_t MiB = 1u << 20;
constexpr size_t WS_MISC = 0, WS_FFN = 1 * MiB, WS_NSAW = 265 * MiB, WS_MLW = 329 * MiB, WS_XN = 400 * MiB, WS_PROJ = 464 * MiB, WS_EXT = 664 * MiB, WS_XB = 800 * MiB, WS_END = 864 * MiB;
constexpr size_t FFN_STRIDE = 66 * MiB, FFN_WD = 44 * MiB;
constexpr size_t NSAW_STRIDE = 32 * MiB, NSAW_OUT = 21 * MiB, NSAW_W1 = 29 * MiB, NSAW_W2 = 31 * MiB;
constexpr size_t MLW_STRIDE = 34 * MiB, MLW_OUT = 25 * MiB;
constexpr size_t EXT_KS = 0, EXT_KW = 16 * MiB, EXT_VTS = 32 * MiB, EXT_VTW = 48 * MiB, EXT_KC = 64 * MiB, EXT_VTC = 65 * MiB;
constexpr size_t EXT_CT = 0, EXT_NT = 128 * MiB, EXT_CI = 129 * MiB, EXT_MC = 129 * MiB + 65536;

struct Args { const float* in[19]; float* out; unsigned char* ws; int ph_lo, ph_hi; };

__device__ __forceinline__ float bf2f(unsigned short b) { return __uint_as_float(((unsigned)b) << 16); }
__device__ __forceinline__ float bflo(unsigned w) { return __uint_as_float(w << 16); }
__device__ __forceinline__ float bfhi(unsigned w) { return __uint_as_float(w & 0xffff0000u); }
__device__ __forceinline__ float wave_sum(float v) {
#pragma unroll
    for (int o = 1; o < 64; o <<= 1) v += __shfl_xor(v, o);
    return v;
}
__device__ __forceinline__ float wave_max(float v) {
#pragma unroll
    for (int o = 1; o < 64; o <<= 1) v = fmaxf(v, __shfl_xor(v, o));
    return v;
}
__device__ __forceinline__ float quad_sum(float v) {
    v += __builtin_bit_cast(float, __builtin_amdgcn_mov_dpp(__builtin_bit_cast(int, v), 0xB1, 0xF, 0xF, true));
    v += __builtin_bit_cast(float, __builtin_amdgcn_mov_dpp(__builtin_bit_cast(int, v), 0x4E, 0xF, 0xF, true));
    return v;
}
__device__ __forceinline__ float fq_sum(float v) { v += __shfl_xor(v, 16); v += __shfl_xor(v, 32); return v; }
__device__ __forceinline__ float fq_max(float v) { v = fmaxf(v, __shfl_xor(v, 16)); v = fmaxf(v, __shfl_xor(v, 32)); return v; }
__device__ __forceinline__ float ex2(float x) { return __builtin_amdgcn_exp2f(x); }
__device__ __forceinline__ float sigmoidf_(float x) { return __builtin_amdgcn_rcpf(1.0f + ex2(-1.4426950408889634f * x)); }

__device__ __forceinline__ void tr_item(const float* __restrict__ W, int K, int N, bf16_t* __restrict__ WT, int mode, int off, LAS float* scr, int item, int lane) {
    const int nblk = (N + 63) >> 6, kb = item / nblk, nb = item - kb * nblk, k0 = 64 * kb, n0 = 64 * nb;
    const int c4 = (lane & 15) * 4, nn = n0 + c4;
    f32x4 v[16];
#pragma unroll
    for (int i = 0; i < 16; ++i) { const int kk = 4 * i + (lane >> 4); v[i] = nn < N ? __builtin_nontemporal_load((const f32x4*)(W + (size_t)(k0 + kk) * N + nn)) : (f32x4){0.f, 0.f, 0.f, 0.f}; }
#pragma unroll
    for (int i = 0; i < 16; ++i) { const int kk = 4 * i + (lane >> 4); LAS float* d = scr + kk * 65 + c4; d[0] = v[i].x; d[1] = v[i].y; d[2] = v[i].z; d[3] = v[i].w; }
    asm volatile("s_waitcnt lgkmcnt(0)" ::: "memory");
    const int c = lane & 7;
#pragma unroll
    for (int j = 0; j < 8; ++j) { const int nl = (lane >> 3) + 8 * j, n = n0 + nl; const LAS float* s = scr + (8 * c) * 65 + nl;
        u32x4 o; o.x = pk2(s[0 * 65], s[1 * 65]); o.y = pk2(s[2 * 65], s[3 * 65]); o.z = pk2(s[4 * 65], s[5 * 65]); o.w = pk2(s[6 * 65], s[7 * 65]);
        const int drow = mode ? ((n >> 7) * 256 + (n & 127) + off) : (n + off);
        if (n < N) *(u32x4*)(WT + (size_t)drow * K + k0 + 8 * c) = o; }
    asm volatile("s_waitcnt lgkmcnt(0)" ::: "memory");
}
__device__ __forceinline__ void tr_matrix(const float* W, int K, int N, bf16_t* WT, int mode, int off, LAS float* scr, int gw, int NGW, int lane, int& rot) {
    const int nblk = (N + 63) >> 6, nitems = (K >> 6) * nblk;
    int first = gw - rot; if (first < 0) first += NGW;
    for (int it = first; it < nitems; it += NGW) tr_item(W, K, N, WT, mode, off, scr, it, lane);
    rot = (rot + nitems) % NGW;
}
__device__ __forceinline__ void rmsnorm_phase(const float* __restrict__ x, const float* __restrict__ g, bf16_t* __restrict__ XN, float* xcopy, int gw, int NGW, int lane) {
    for (int m = gw; m < S_; m += NGW) {
        const f32x4* xr = (const f32x4*)(x + (size_t)m * D_) + lane;
        f32x4 v[8]; float s = 0.f;
#pragma unroll
        for (int j = 0; j < 8; ++j) { v[j] = xr[64 * j]; s += (v[j].x * v[j].x + v[j].y * v[j].y) + (v[j].z * v[j].z + v[j].w * v[j].w); }
        s = wave_sum(s);
        const float rs = 1.0f / sqrtf(s * (1.0f / D_) + EPS);
        if (xcopy) {
            f32x4* xc = (f32x4*)(xcopy + (size_t)m * D_) + lane;
#pragma unroll
            for (int j = 0; j < 8; ++j) xc[64 * j] = v[j];
        }
        u32x2* o8 = (u32x2*)(XN + (size_t)m * D_) + lane;
#pragma unroll
        for (int j = 0; j < 8; ++j) { const f32x4 gg = ((const f32x4*)g)[lane + 64 * j]; u32x2 w; w.x = pk2(v[j].x * rs * gg.x, v[j].y * rs * gg.y); w.y = pk2(v[j].z * rs * gg.z, v[j].w * rs * gg.w); o8[64 * j] = w; }
    }
}

template <int NT>
__device__ __forceinline__ void gate_gemm(const bf16_t* __restrict__ XNp, const bf16_t* __restrict__ Wt, bf16_t* __restrict__ OUT, int ld, int col0, int tb, LAS unsigned char* lds, int tid, int wave, int lane) {
    const int fr = lane & 15, fq = lane >> 4, rt = wave & 3, kh = wave >> 2;
    const bf16_t* ap = XNp + (size_t)(64 * tb + 16 * rt + fr) * D_ + kh * 1024 + 8 * fq;
    const bf16_t* bp = Wt + (size_t)fr * D_ + kh * 1024 + 8 * fq;
    f32x4 acc[NT];
#pragma unroll
    for (int nt = 0; nt < NT; ++nt) acc[nt] = (f32x4){0.f, 0.f, 0.f, 0.f};
    constexpr int KB = NT == 1 ? 16 : 8;
    for (int k0 = 0; k0 < 32; k0 += KB) {
        bf16x8 a[KB], b[KB][NT];
#pragma unroll
        for (int u = 0; u < KB; ++u) {
            a[u] = *(const bf16x8*)(ap + 32 * (k0 + u));
#pragma unroll
            for (int nt = 0; nt < NT; ++nt) b[u][nt] = *(const bf16x8*)(bp + (size_t)(16 * nt) * D_ + 32 * (k0 + u));
        }
#pragma unroll
        for (int u = 0; u < KB; ++u)
#pragma unroll
            for (int nt = 0; nt < NT; ++nt) acc[nt] = MFMA16(b[u][nt], a[u], acc[nt]);
    }
    LAS float* P = (LAS float*)lds;
#pragma unroll
    for (int nt = 0; nt < NT; ++nt) *(LAS f32x4*)(P + ((kh * 64 + 16 * rt + fr) * (NT * 16) + 16 * nt + 4 * fq)) = acc[nt];
    __syncthreads();
    for (int idx = tid; idx < 64 * NT * 16; idx += NTHR) {
        const int tok = idx / (NT * 16), n = idx - tok * (NT * 16);
        const float v = P[idx] + P[64 * NT * 16 + idx];
        OUT[(size_t)(64 * tb + tok) * ld + col0 + n] = (bf16_t)(pk2(v, v) & 0xffffu);
    }
    __syncthreads();
}

__device__ __forceinline__ void rmsnorm_bf16_phase(const bf16_t* __restrict__ x, const float* __restrict__ g, bf16_t* __restrict__ XN, int gw, int NGW, int lane) {
    for (int m = gw; m < S_; m += NGW) {
        const u32x4* xr = (const u32x4*)(x + (size_t)m * D_) + lane;
        u32x4 v[4]; float s = 0.f;
#pragma unroll
        for (int j = 0; j < 4; ++j) v[j] = xr[64 * j];
#pragma unroll
        for (int j = 0; j < 4; ++j) { const float a0 = bflo(v[j].x), a1 = bfhi(v[j].x), a2 = bflo(v[j].y), a3 = bfhi(v[j].y), a4 = bflo(v[j].z), a5 = bfhi(v[j].z), a6 = bflo(v[j].w), a7 = bfhi(v[j].w);
            s += ((a0 * a0 + a1 * a1) + (a2 * a2 + a3 * a3)) + ((a4 * a4 + a5 * a5) + (a6 * a6 + a7 * a7)); }
        s = wave_sum(s);
        const float rs = 1.0f / sqrtf(s * (1.0f / D_) + EPS);
        u32x4* o = (u32x4*)(XN + (size_t)m * D_) + lane;
#pragma unroll
        for (int j = 0; j < 4; ++j) { const f32x4 g0 = ((const f32x4*)g)[2 * (lane + 64 * j)], g1 = ((const f32x4*)g)[2 * (lane + 64 * j) + 1];
            u32x4 w; w.x = pk2(bflo(v[j].x) * rs * g0.x, bfhi(v[j].x) * rs * g0.y); w.y = pk2(bflo(v[j].y) * rs * g0.z, bfhi(v[j].y) * rs * g0.w);
            w.z = pk2(bflo(v[j].z) * rs * g1.x, bfhi(v[j].z) * rs * g1.y); w.w = pk2(bflo(v[j].w) * rs * g1.z, bfhi(v[j].w) * rs * g1.w); o[64 * j] = w; }
    }
}

__device__ __forceinline__ void nsa_prep_unit(int tb, bf16_t* PROJ, const float* qg, const float* kg, bf16_t* KS, bf16_t* KW, bf16_t* VTS, bf16_t* VTW, int tid) {
    const int sub = tid & 15;
    for (int it0 = 0; it0 < 48; it0 += 8) {
        u32x4 raw4[8];
#pragma unroll
        for (int u = 0; u < 8; ++u) {
            const int task = (it0 + u) * 32 + (tid >> 4), tok = task / 24, v = task - tok * 24, t = tb * 64 + tok;
            const int col = v < 16 ? v * 128 : v < 20 ? 2048 + (2 * 4 + (v - 16)) * 128 : 2048 + (4 * 4 + (v - 20)) * 128;
            raw4[u] = *(const u32x4*)(PROJ + (size_t)t * NSA_N + col + 8 * sub);
        }
#pragma unroll
        for (int u = 0; u < 8; ++u) {
            const int task = (it0 + u) * 32 + (tid >> 4), tok = task / 24, v = task - tok * 24, t = tb * 64 + tok;
            const float* gain; float gs = 1.0f; bf16_t* dst;
            if (v < 16) { gain = qg; gs = QSCALE; dst = PROJ + (size_t)t * NSA_N + v * 128; }
            else if (v < 20) { const int g = v - 16; gain = kg + 128; dst = KS + ((size_t)g * S_ + t) * 128; }
            else { const int g = v - 20; gain = kg + 256; dst = KW + ((size_t)g * S_ + t) * 128; }
            const u32x4 raw = raw4[u];
            float x[8] = {bflo(raw.x), bfhi(raw.x), bflo(raw.y), bfhi(raw.y), bflo(raw.z), bfhi(raw.z), bflo(raw.w), bfhi(raw.w)};
            float ss = 0.f;
#pragma unroll
            for (int e = 0; e < 8; ++e) ss += x[e] * x[e];
            ss += __shfl_xor(ss, 1); ss += __shfl_xor(ss, 2); ss += __shfl_xor(ss, 4); ss += __shfl_xor(ss, 8);
            const float rs = gs / sqrtf(ss * (1.0f / 128.0f) + EPS);
            const f32x4 g0 = *(const f32x4*)(gain + 8 * sub), g1 = *(const f32x4*)(gain + 8 * sub + 4);
            u32x4 o; o.x = pk2(x[0] * rs * g0.x, x[1] * rs * g0.y); o.y = pk2(x[2] * rs * g0.z, x[3] * rs * g0.w); o.z = pk2(x[4] * rs * g1.x, x[5] * rs * g1.y); o.w = pk2(x[6] * rs * g1.z, x[7] * rs * g1.w);
            *(u32x4*)(dst + 8 * sub) = o;
        }
    }
    for (int it0 = 0; it0 < 16; it0 += 4) {
        unsigned short e[4][8];
#pragma unroll
        for (int u = 0; u < 4; ++u) {
            const int task = (it0 + u) * 512 + tid, tile = task >> 10, rem = task & 1023, kc = rem >> 7, d = rem & 127, which = tile >> 2, g = tile & 3;
            const bf16_t* src = PROJ + (size_t)(tb * 64 + 8 * kc) * NSA_N + 2048 + ((which ? 5 : 3) * 4 + g) * 128 + d;
#pragma unroll
            for (int i = 0; i < 8; ++i) e[u][i] = src[(size_t)i * NSA_N];
        }
#pragma unroll
        for (int u = 0; u < 4; ++u) {
            const int task = (it0 + u) * 512 + tid, tile = task >> 10, rem = task & 1023, kc = rem >> 7, d = rem & 127, which = tile >> 2, g = tile & 3;
            u32x4 o; o.x = e[u][0] | ((unsigned)e[u][1] << 16); o.y = e[u][2] | ((unsigned)e[u][3] << 16); o.z = e[u][4] | ((unsigned)e[u][5] << 16); o.w = e[u][6] | ((unsigned)e[u][7] << 16);
            bf16_t* VT = which ? VTW : VTS;
            *(u32x4*)(VT + (((size_t)g * 256 + tb) * 128 + d) * 64 + 8 * kc) = o;
        }
    }
}

__device__ __forceinline__ float gelu_tanh(float x) {
    const float u = 0.7978845608028654f * (x + 0.044715f * x * x * x);
    const float t = 1.0f - 2.0f * __builtin_amdgcn_rcpf(1.0f + ex2(2.0f * 1.4426950408889634f * u));
    return 0.5f * x * (1.0f + t);
}
__device__ __forceinline__ void nsa_compress_unit(int task, const bf16_t* PROJ, const float* pos, const bf16_t* W1t, const float* b1, const bf16_t* W2t, const float* kg0,
                                                  bf16_t* KC, bf16_t* VTC, LAS unsigned char* lds, int tid, int wave, int lane) {
    const int kv = task >> 7, g = (task >> 5) & 3, ct = task & 31, c0 = 32 * ct, fr = lane & 15, fq = lane >> 4;
    LAS float* part = (LAS float*)lds;
    LAS bf16_t* hS = (LAS bf16_t*)(lds + 131072);
    const int crow0 = (c0 + fr) < 1023 ? (c0 + fr) : 1022, crow1 = (c0 + 16 + fr) < 1023 ? (c0 + 16 + fr) : 1022;
    const bf16_t* abase0 = PROJ + (size_t)(16 * crow0) * NSA_N + 2048 + (kv * 4 + g) * 128 + 8 * fq;
    const bf16_t* abase1 = PROJ + (size_t)(16 * crow1) * NSA_N + 2048 + (kv * 4 + g) * 128 + 8 * fq;
    const bf16_t* wbase = W1t + (size_t)kv * 128 * 4096 + (size_t)fr * 4096 + 8 * fq;
    const float* pbase = pos + (size_t)kv * 32 * 128 + 8 * fq;
    f32x4 acc[2][8];
#pragma unroll
    for (int r2 = 0; r2 < 2; ++r2)
#pragma unroll
        for (int i = 0; i < 8; ++i) acc[r2][i] = (f32x4){0.f, 0.f, 0.f, 0.f};
    for (int li = 0; li < 4; ++li) {
        const int l = 4 * wave + li;
#pragma unroll
        for (int dd = 0; dd < 4; ++dd) {
            const u32x4 raw0 = *(const u32x4*)(abase0 + (size_t)l * NSA_N + 32 * dd), raw1 = *(const u32x4*)(abase1 + (size_t)l * NSA_N + 32 * dd);
            const f32x4 p0 = *(const f32x4*)(pbase + l * 128 + 32 * dd), p1 = *(const f32x4*)(pbase + l * 128 + 32 * dd + 4);
            u32x4 a; a.x = pk2(bflo(raw0.x) + p0.x, bfhi(raw0.x) + p0.y); a.y = pk2(bflo(raw0.y) + p0.z, bfhi(raw0.y) + p0.w);
            a.z = pk2(bflo(raw0.z) + p1.x, bfhi(raw0.z) + p1.y); a.w = pk2(bflo(raw0.w) + p1.z, bfhi(raw0.w) + p1.w);
            u32x4 b; b.x = pk2(bflo(raw1.x) + p0.x, bfhi(raw1.x) + p0.y); b.y = pk2(bflo(raw1.y) + p0.z, bfhi(raw1.y) + p0.w);
            b.z = pk2(bflo(raw1.z) + p1.x, bfhi(raw1.z) + p1.y); b.w = pk2(bflo(raw1.w) + p1.z, bfhi(raw1.w) + p1.w);
            const bf16x8 af0 = __builtin_bit_cast(bf16x8, a), af1 = __builtin_bit_cast(bf16x8, b);
#pragma unroll
            for (int nt = 0; nt < 8; ++nt) { const bf16x8 bfr = *(const bf16x8*)(wbase + (size_t)nt * 16 * 4096 + l * 128 + 32 * dd); acc[0][nt] = MFMA16(bfr, af0, acc[0][nt]); acc[1][nt] = MFMA16(bfr, af1, acc[1][nt]); }
        }
    }
#pragma unroll
    for (int r2 = 0; r2 < 2; ++r2)
#pragma unroll
        for (int nt = 0; nt < 8; ++nt) *(LAS f32x4*)(part + (wave * 32 + 16 * r2 + fr) * 128 + 16 * nt + 4 * fq) = acc[r2][nt];
    __syncthreads();
    {
        const int c = tid >> 4, n8 = (tid & 15) * 8;
        f32x4 s0 = *(const f32x4*)(b1 + kv * 128 + n8), s1 = *(const f32x4*)(b1 + kv * 128 + n8 + 4);
#pragma unroll
        for (int w = 0; w < 8; ++w) { s0 = s0 + *(LAS f32x4*)(part + (w * 32 + c) * 128 + n8); s1 = s1 + *(LAS f32x4*)(part + (w * 32 + c) * 128 + n8 + 4); }
        u32x4 o; o.x = pk2(gelu_tanh(s0.x), gelu_tanh(s0.y)); o.y = pk2(gelu_tanh(s0.z), gelu_tanh(s0.w)); o.z = pk2(gelu_tanh(s1.x), gelu_tanh(s1.y)); o.w = pk2(gelu_tanh(s1.z), gelu_tanh(s1.w));
        *(LAS u32x4*)(hS + c * 136 + n8) = o;
    }
    __syncthreads();
    {
        f32x4 a2[2] = {(f32x4){0.f, 0.f, 0.f, 0.f}, (f32x4){0.f, 0.f, 0.f, 0.f}};
#pragma unroll
        for (int ks = 0; ks < 4; ++ks) {
            const bf16x8 wf = *(const bf16x8*)(W2t + (size_t)kv * 128 * 128 + (size_t)(16 * wave + fr) * 128 + 32 * ks + 8 * fq);
#pragma unroll
            for (int r2 = 0; r2 < 2; ++r2) { const bf16x8 hf = *(LAS bf16x8*)(hS + (16 * r2 + fr) * 136 + 32 * ks + 8 * fq); a2[r2] = MFMA16(wf, hf, a2[r2]); }
        }
#pragma unroll
        for (int r2 = 0; r2 < 2; ++r2) *(LAS f32x4*)(part + (16 * r2 + fr) * 128 + 16 * wave + 4 * fq) = a2[r2];
    }
    __syncthreads();
    if (kv == 0) {
        const int c = tid >> 4, sub = tid & 15;
        const f32x4 x0 = *(LAS f32x4*)(part + c * 128 + 8 * sub), x1 = *(LAS f32x4*)(part + c * 128 + 8 * sub + 4);
        float ss = (x0.x * x0.x + x0.y * x0.y) + (x0.z * x0.z + x0.w * x0.w) + (x1.x * x1.x + x1.y * x1.y) + (x1.z * x1.z + x1.w * x1.w);
        ss += __shfl_xor(ss, 1); ss += __shfl_xor(ss, 2); ss += __shfl_xor(ss, 4); ss += __shfl_xor(ss, 8);
        float rs = 1.0f / sqrtf(ss * (1.0f / 128.0f) + EPS);
        if (c0 + c >= 1023) rs = 0.f;
        const f32x4 g0 = *(const f32x4*)(kg0 + 8 * sub), g1 = *(const f32x4*)(kg0 + 8 * sub + 4);
        u32x4 o; o.x = pk2(x0.x * rs * g0.x, x0.y * rs * g0.y); o.y = pk2(x0.z * rs * g0.z, x0.w * rs * g0.w); o.z = pk2(x1.x * rs * g1.x, x1.y * rs * g1.y); o.w = pk2(x1.z * rs * g1.z, x1.w * rs * g1.w);
        *(u32x4*)(KC + ((size_t)g * 1024 + c0 + c) * 128 + 8 * sub) = o;
    } else {
        if (tid < 256) {
            const int d = tid & 127, hh = tid >> 7; float v[16];
#pragma unroll
            for (int c = 0; c < 16; ++c) v[c] = (c0 + 16 * hh + c < 1023) ? part[(16 * hh + c) * 128 + d] : 0.f;
            u32x4 o0, o1; o0.x = pk2(v[0], v[1]); o0.y = pk2(v[2], v[3]); o0.z = pk2(v[4], v[5]); o0.w = pk2(v[6], v[7]);
            o1.x = pk2(v[8], v[9]); o1.y = pk2(v[10], v[11]); o1.z = pk2(v[12], v[13]); o1.w = pk2(v[14], v[15]);
            bf16_t* dst = VTC + (((size_t)g * 16 + (ct >> 1)) * 128 + d) * 64 + 32 * (ct & 1) + 16 * hh;
            *(u32x4*)dst = o0; *(u32x4*)(dst + 8) = o1;
        }
    }
    __syncthreads();
}

__device__ __forceinline__ unsigned long long shfl_xor_u64(unsigned long long v, int m) {
    const unsigned lo = __shfl_xor((unsigned)v, m), hi = __shfl_xor((unsigned)(v >> 32), m);
    return ((unsigned long long)hi << 32) | lo;
}

struct QuadState { bf16x8 qf[4]; f32x4 o[8]; float l; };
constexpr int AT_STAGE = 32768, AT_V = 16384;
constexpr int AT_IMP = 2 * AT_STAGE;
constexpr int AT_SELM = AT_IMP + 65536;
static_assert(AT_SELM + 2048 + 512 <= LDS_BYTES, "attention LDS map");

template <bool WV>
__device__ __forceinline__ void at_dma(LAS unsigned char* st, const bf16_t* __restrict__ Kb, const bf16_t* __restrict__ Vb, int wave, int lane) {
#pragma unroll
    for (int i = 0; i < 2; ++i) {
        const int k = 2 * wave + i;
        const int rho = 4 * k + (lane >> 4), sg = lane & 15, key = (rho & 32) + ((rho >> 2) & 3) * 8 + ((rho >> 4) & 1) * 4 + (rho & 3);
        __builtin_amdgcn_global_load_lds((const unsigned*)(Kb + key * 128 + 8 * (sg ^ (rho & 15))), (LAS unsigned*)(st + 1024 * k), 16, 0, 0);
    }
    if (WV) {
#pragma unroll
        for (int i = 0; i < 2; ++i) {
            const int k = 2 * wave + i;
            const int d = 8 * k + (lane >> 3), sg = lane & 7;
            __builtin_amdgcn_global_load_lds((const unsigned*)(Vb + d * 64 + 8 * (sg ^ ((d >> 1) & 7))), (LAS unsigned*)(st + AT_V + 1024 * k), 16, 0, 0);
        }
    }
}
template <int MODE, bool DUAL>
__device__ __forceinline__ void at_block(const LAS unsigned char* st, QuadState& A, QuadState& B, bool domask, float biasA, float biasB, int pos0, int loA, int hiA, int loB, int hiB, float invlA, float invlB,
                                         float& carryA, float& carryB, LAS float* impA, LAS float* impB, int lane, int fr, int fq) {
    f32x4 sA[4], sB[4];
#pragma unroll
    for (int T = 0; T < 4; ++T) { sA[T] = (f32x4){biasA, biasA, biasA, biasA}; sB[T] = (f32x4){biasB, biasB, biasB, biasB}; }
    bf16x8 vpre[8];
    if (!DUAL && MODE != 0) {
#pragma unroll
        for (int dt = 0; dt < 8; ++dt) vpre[dt] = *(const LAS bf16x8*)(st + AT_V + (16 * dt + fr) * 128 + 16 * ((fq) ^ ((fr >> 1) & 7)));
    }
#pragma unroll
    for (int ks = 0; ks < 4; ++ks) {
        bf16x8 kf[4];
#pragma unroll
        for (int T = 0; T < 4; ++T) kf[T] = *(const LAS bf16x8*)(st + (32 * (T >> 1) + 16 * (T & 1) + fr) * 256 + 16 * ((4 * fq + ks) ^ fr));
#pragma unroll
        for (int T = 0; T < 4; ++T) { sA[T] = MFMA16(kf[T], A.qf[ks], sA[T]); if (DUAL) sB[T] = MFMA16(kf[T], B.qf[ks], sB[T]); }
        if (DUAL) __builtin_amdgcn_sched_barrier(0);
    }
    float la = 0.f, lb = 0.f;
    if (domask) {
#pragma unroll
        for (int T = 0; T < 4; ++T)
#pragma unroll
            for (int i = 0; i < 4; ++i) {
                const int pos = pos0 + 32 * (T >> 1) + 8 * fq + 4 * (T & 1) + i;
                if (!(pos >= loA && pos <= hiA)) sA[T][i] = NEG;
                if (DUAL) { if (!(pos >= loB && pos <= hiB)) sB[T][i] = NEG; }
            }
    }
#pragma unroll
    for (int T = 0; T < 4; ++T)
#pragma unroll
        for (int i = 0; i < 4; ++i) {
            float e = ex2(sA[T][i]); if (MODE == 2) e *= invlA; sA[T][i] = e; la += e;
            if (DUAL) { float f = ex2(sB[T][i]); if (MODE == 2) f *= invlB; sB[T][i] = f; lb += f; }
        }
    if (MODE != 2) { A.l += la; if (DUAL) B.l += lb; }
    if (MODE == 2) {
        const int src = (lane + 48) & 63;
        {
            const float r0 = __shfl(sA[1][3], src), r1 = __shfl(sA[3][3], src);
            const float pv0 = fq ? r0 : carryA, pv1 = fq ? r1 : r0; carryA = r1;
            float i00 = (sA[0][0] + sA[0][1]) + (sA[0][2] + sA[0][3]) + pv0, i01 = (sA[1][0] + sA[1][1]) + (sA[1][2] + sA[1][3]) + sA[0][3];
            float i10 = (sA[2][0] + sA[2][1]) + (sA[2][2] + sA[2][3]) + pv1, i11 = (sA[3][0] + sA[3][1]) + (sA[3][2] + sA[3][3]) + sA[2][3];
            i00 = quad_sum(i00); i01 = quad_sum(i01); i10 = quad_sum(i10); i11 = quad_sum(i11);
            if ((fr & 3) == 0) { impA[2 * fq] = i00; impA[2 * fq + 1] = i01; impA[8 + 2 * fq] = i10; impA[8 + 2 * fq + 1] = i11; }
        }
        if (DUAL) {
            const float r0 = __shfl(sB[1][3], src), r1 = __shfl(sB[3][3], src);
            const float pv0 = fq ? r0 : carryB, pv1 = fq ? r1 : r0; carryB = r1;
            float i00 = (sB[0][0] + sB[0][1]) + (sB[0][2] + sB[0][3]) + pv0, i01 = (sB[1][0] + sB[1][1]) + (sB[1][2] + sB[1][3]) + sB[0][3];
            float i10 = (sB[2][0] + sB[2][1]) + (sB[2][2] + sB[2][3]) + pv1, i11 = (sB[3][0] + sB[3][1]) + (sB[3][2] + sB[3][3]) + sB[2][3];
            i00 = quad_sum(i00); i01 = quad_sum(i01); i10 = quad_sum(i10); i11 = quad_sum(i11);
            if ((fr & 3) == 0) { impB[2 * fq] = i00; impB[2 * fq + 1] = i01; impB[8 + 2 * fq] = i10; impB[8 + 2 * fq + 1] = i11; }
        }
    }
    if (MODE != 0) {
        bf16x8 pfA[2], pfB[2];
#pragma unroll
        for (int u = 0; u < 2; ++u) {
            u32x4 w; w.x = pk2(sA[2 * u][0], sA[2 * u][1]); w.y = pk2(sA[2 * u][2], sA[2 * u][3]); w.z = pk2(sA[2 * u + 1][0], sA[2 * u + 1][1]); w.w = pk2(sA[2 * u + 1][2], sA[2 * u + 1][3]); pfA[u] = __builtin_bit_cast(bf16x8, w);
            if (DUAL) { u32x4 x; x.x = pk2(sB[2 * u][0], sB[2 * u][1]); x.y = pk2(sB[2 * u][2], sB[2 * u][3]); x.z = pk2(sB[2 * u + 1][0], sB[2 * u + 1][1]); x.w = pk2(sB[2 * u + 1][2], sB[2 * u + 1][3]); pfB[u] = __builtin_bit_cast(bf16x8, x); }
        }
#pragma unroll
        for (int u = 0; u < 2; ++u) {
#pragma unroll
            for (int dt = 0; dt < 8; ++dt) {
                const bf16x8 vf = (DUAL || u == 1) ? *(const LAS bf16x8*)(st + AT_V + (16 * dt + fr) * 128 + 16 * ((4 * u + fq) ^ ((fr >> 1) & 7))) : vpre[dt];
                A.o[dt] = MFMA16(vf, pfA[u], A.o[dt]); if (DUAL) B.o[dt] = MFMA16(vf, pfB[u], B.o[dt]);
                if (DUAL && (dt & 3) == 3) __builtin_amdgcn_sched_barrier(0);
            }
        }
    }
}
template <int MODE, bool SEL, int NST>
__device__ __forceinline__ void at_run(LAS unsigned char* lds, const bf16_t* Kg, const bf16_t* Vg, int first, int last, QuadState& A, QuadState& B, int loA, int hiA, int loB, int hiB,
                                       float invlA, float invlB, LAS float* impA, LAS float* impB, const LAS unsigned* uni, const LAS unsigned* selmA, const LAS unsigned* selmB,
                                       int tid, int lane, int fr, int fq, int nm_lo = 1, int nm_hi = 0) {
    constexpr bool WV = MODE != 0;
    constexpr int BPS = NST / 2;
    const int wave = __builtin_amdgcn_readfirstlane(tid >> 6);
    const int sb0 = first / BPS, sb1 = last / BPS;
    float carryA = 0.f, carryB = 0.f;
#define AT_DMA_SB(sb) do { _Pragma("unroll") for (int h_ = 0; h_ < BPS; ++h_) { const int blk_ = (sb) * BPS + h_; if (blk_ >= first && blk_ <= last) \
        at_dma<WV>(lds + ((((sb) & 1) * BPS + h_) * AT_STAGE), Kg + (size_t)blk_ * 8192, Vg + (size_t)blk_ * 8192, wave, lane); } } while (0)
    AT_DMA_SB(sb0);
    unsigned wa = 0u, wb = 0u;
    for (int sb = sb0; sb <= sb1; ++sb) {
        asm volatile("s_waitcnt vmcnt(0)" ::: "memory");
        __syncthreads();
        if (sb < sb1) AT_DMA_SB(sb + 1);
#pragma unroll
        for (int h = 0; h < BPS; ++h) {
            const int idx = sb * BPS + h;
            if (idx < first || idx > last) continue;
            const LAS unsigned char* st = lds + (((sb & 1) * BPS + h) * AT_STAGE);
            if (SEL) {
                if ((idx & 31) == 0 || idx == first) { wa = (unsigned)__builtin_amdgcn_readfirstlane((int)uni[idx >> 5]); wb = (unsigned)__builtin_amdgcn_readfirstlane((int)uni[8 + (idx >> 5)]); }
                const bool actA = (wa >> (idx & 31)) & 1u, actB = (wb >> (idx & 31)) & 1u;
                if (actA) { const float bA = ((selmA[idx >> 5] >> (idx & 31)) & 1u) ? 0.f : NEG; at_block<1, false>(st, A, A, idx == last, bA, bA, 64 * idx, 0, hiA, 0, hiA, 0.f, 0.f, carryA, carryA, nullptr, nullptr, lane, fr, fq); }
                if (actB) { const float bB = ((selmB[idx >> 5] >> (idx & 31)) & 1u) ? 0.f : NEG; at_block<1, false>(st, B, B, idx == last, bB, bB, 64 * idx, 0, hiB, 0, hiB, 0.f, 0.f, carryB, carryB, nullptr, nullptr, lane, fr, fq); }
            } else {
                at_block<MODE, true>(st, A, B, idx < nm_lo || idx > nm_hi, 0.f, 0.f, 64 * idx, loA, hiA, loB, hiB, invlA, invlB, carryA, carryB, impA + 16 * idx, impB + 16 * idx, lane, fr, fq);
            }
        }
    }
#undef AT_DMA_SB
    asm volatile("s_waitcnt vmcnt(0)" ::: "memory");
    __syncthreads();
}
__device__ __forceinline__ void y_accum(bf16_t* yp, const f32x4 (&o)[8], float sc, bool first) {
    u32x2 old[8];
    if (!first) {
#pragma unroll
        for (int dt = 0; dt < 8; ++dt) old[dt] = *(const u32x2*)(yp + 16 * dt);
    }
#pragma unroll
    for (int dt = 0; dt < 8; ++dt) {
        float a0 = o[dt][0] * sc, a1 = o[dt][1] * sc, a2 = o[dt][2] * sc, a3 = o[dt][3] * sc;
        if (!first) { a0 += bflo(old[dt].x); a1 += bfhi(old[dt].x); a2 += bflo(old[dt].y); a3 += bfhi(old[dt].y); }
        u32x2 w; w.x = pk2(a0, a1); w.y = pk2(a2, a3); *(u32x2*)(yp + 16 * dt) = w;
    }
}
__device__ __forceinline__ void nsa_attn_wg(int qb, int g, const bf16_t* PROJ, const float* bgate, const bf16_t* KC, const bf16_t* VTC, const bf16_t* KS, const bf16_t* VTS,
                                            const bf16_t* KW, const bf16_t* VTW, bf16_t* Y, LAS unsigned char* lds, int tid, int wave, int lane) {
    const int fr = lane & 15, fq = lane >> 4, a = fr >> 2, r = fr & 3, cur = qb;
    const int tlA = 8 * wave + a, tlB = tlA + 4, tA = 64 * qb + tlA, tB = 64 * qb + tlB;
    LAS float* IMP = (LAS float*)(lds + AT_IMP); LAS unsigned* SELM = (LAS unsigned*)(lds + AT_SELM); LAS unsigned* UNI = SELM + 512;
    QuadState A, B;
    {
        const bf16x8* qa = (const bf16x8*)(PROJ + (size_t)tA * NSA_N + (4 * g + r) * 128 + 32 * fq); const bf16x8* qbp = (const bf16x8*)(PROJ + (size_t)tB * NSA_N + (4 * g + r) * 128 + 32 * fq);
#pragma unroll
        for (int ks = 0; ks < 4; ++ks) { A.qf[ks] = qa[ks]; B.qf[ks] = qbp[ks]; }
    }
#define gpA (PROJ + (size_t)tA * NSA_N + 5120 + (4 * g + r) * 3)
#define gpB (PROJ + (size_t)tB * NSA_N + 5120 + (4 * g + r) * 3)
#define bg (bgate + (4 * g + r) * 3)
#define ypA (Y + (size_t)tA * D_ + (4 * g + r) * 128 + 4 * fq)
#define ypB (Y + (size_t)tB * D_ + (4 * g + r) * 128 + 4 * fq)
    {
        const int cmA = (tA - 31) >> 4, cmB = (tB - 31) >> 4, nb = ((4 * qb + 2) >> 6) + 1;
        const bf16_t* KCg = KC + (size_t)g * 1024 * 128; const bf16_t* VCg = VTC + (size_t)g * 16 * 8192;
        A.l = 0.f; B.l = 0.f;
        at_run<0, false, 2>(lds, KCg, VCg, 0, nb - 1, A, B, 0, cmA, 0, cmB, 0.f, 0.f, nullptr, nullptr, nullptr, nullptr, nullptr, tid, lane, fr, fq, 0, (4 * qb - 65) >> 6);
        const float lA = fq_sum(A.l), lB = fq_sum(B.l);
        const float invlA = lA > 0.f ? 1.0f / lA : 0.f, invlB = lB > 0.f ? 1.0f / lB : 0.f;
#pragma unroll
        for (int i = 0; i < 8; ++i) { A.o[i] = (f32x4){0.f, 0.f, 0.f, 0.f}; B.o[i] = (f32x4){0.f, 0.f, 0.f, 0.f}; }
        at_run<2, false, 2>(lds, KCg, VCg, 0, nb - 1, A, B, 0, cmA, 0, cmB, invlA, invlB, IMP + tlA * 256, IMP + tlB * 256, nullptr, nullptr, nullptr, tid, lane, fr, fq, 0, (4 * qb - 65) >> 6);
        y_accum(ypA, A.o, sigmoidf_(bf2f(gpA[0]) + bg[0]), true);
        y_accum(ypB, B.o, sigmoidf_(bf2f(gpB[0]) + bg[0]), true);
    }
    asm volatile("s_waitcnt lgkmcnt(0)" ::: "memory");
    {
        float val[8][4]; unsigned selb[8];
#pragma unroll
        for (int ta = 0; ta < 8; ++ta) {
            selb[ta] = 0u;
#pragma unroll
            for (int q = 0; q < 4; ++q) {
                const int j = lane + 64 * q;
                if ((j <= cur) && (j == 0 || j >= cur - 1 || cur <= 15)) selb[ta] |= 1u << q;
                val[ta][q] = (cur > 15 && j >= 1 && j <= cur - 2) ? IMP[(8 * wave + ta) * 256 + j] : -1.0f;
            }
        }
        if (cur > 15) {
            for (int it = 0; it < 13; ++it) {
                unsigned long long best[8];
#pragma unroll
                for (int ta = 0; ta < 8; ++ta) {
                    unsigned long long b = 0ull;
#pragma unroll
                    for (int q = 0; q < 4; ++q) if (val[ta][q] >= 0.f) { const unsigned long long k = ((unsigned long long)__float_as_uint(val[ta][q]) << 32) | (unsigned)(256 - (lane + 64 * q)); b = k > b ? k : b; }
                    best[ta] = b;
                }
#pragma unroll
                for (int m = 1; m < 64; m <<= 1) {
#pragma unroll
                    for (int ta = 0; ta < 8; ++ta) { const unsigned long long ot = shfl_xor_u64(best[ta], m); best[ta] = ot > best[ta] ? ot : best[ta]; }
                }
#pragma unroll
                for (int ta = 0; ta < 8; ++ta) {
                    const int jw = 256 - (int)(best[ta] & 0x1ffu);
#pragma unroll
                    for (int q = 0; q < 4; ++q) if (lane + 64 * q == jw) { val[ta][q] = -1.0f; selb[ta] |= 1u << q; }
                }
            }
        }
#pragma unroll
        for (int ta = 0; ta < 8; ++ta)
#pragma unroll
            for (int q = 0; q < 4; ++q) {
                const unsigned long long m = __ballot((selb[ta] >> q) & 1u);
                if (lane == 0) { SELM[(8 * wave + ta) * 8 + 2 * q] = (unsigned)m; SELM[(8 * wave + ta) * 8 + 2 * q + 1] = (unsigned)(m >> 32); }
            }
    }
    asm volatile("s_waitcnt lgkmcnt(0)" ::: "memory");
    if (lane < 16) {
        const int qd = lane >> 3, wd = lane & 7;
        UNI[16 * wave + lane] = SELM[(8 * wave + 4 * qd + 0) * 8 + wd] | SELM[(8 * wave + 4 * qd + 1) * 8 + wd] | SELM[(8 * wave + 4 * qd + 2) * 8 + wd] | SELM[(8 * wave + 4 * qd + 3) * 8 + wd];
    }
    asm volatile("s_waitcnt lgkmcnt(0)" ::: "memory");
    __syncthreads();
    {
#pragma unroll
        for (int i = 0; i < 8; ++i) { A.o[i] = (f32x4){0.f, 0.f, 0.f, 0.f}; B.o[i] = (f32x4){0.f, 0.f, 0.f, 0.f}; }
        A.l = 0.f; B.l = 0.f;
        at_run<1, true, 4>(lds, KS + (size_t)g * S_ * 128, VTS + (size_t)g * 256 * 8192, 0, cur, A, B, 0, tA, 0, tB, 0.f, 0.f, nullptr, nullptr, UNI + 16 * wave, SELM + tlA * 8, SELM + tlB * 8, tid, lane, fr, fq);
        const float lA = fq_sum(A.l), lB = fq_sum(B.l);
        y_accum(ypA, A.o, lA > 0.f ? sigmoidf_(bf2f(gpA[1]) + bg[1]) / lA : 0.f, false);
        y_accum(ypB, B.o, lB > 0.f ? sigmoidf_(bf2f(gpB[1]) + bg[1]) / lB : 0.f, false);
    }
    {
#pragma unroll
        for (int i = 0; i < 8; ++i) { A.o[i] = (f32x4){0.f, 0.f, 0.f, 0.f}; B.o[i] = (f32x4){0.f, 0.f, 0.f, 0.f}; }
        A.l = 0.f; B.l = 0.f;
        const int jlo = qb >= 8 ? qb - 8 : 0;
        at_run<1, false, 4>(lds, KW + (size_t)g * S_ * 128, VTW + (size_t)g * 256 * 8192, jlo, cur, A, B, tA - 511, tA, tB - 511, tB, 0.f, 0.f, nullptr, nullptr, nullptr, nullptr, nullptr, tid, lane, fr, fq, qb - 7, qb - 1);
        const float lA = fq_sum(A.l), lB = fq_sum(B.l);
        y_accum(ypA, A.o, lA > 0.f ? sigmoidf_(bf2f(gpA[2]) + bg[2]) / lA : 0.f, false);
        y_accum(ypB, B.o, lB > 0.f ? sigmoidf_(bf2f(gpB[2]) + bg[2]) / lB : 0.f, false);
    }
#undef gpA
#undef gpB
#undef bg
#undef ypA
#undef ypB
}

__device__ __forceinline__ float log_sigmoid(float x) { return fminf(x, 0.f) - log1pf(__expf(-fabsf(x))); }
__device__ __forceinline__ void ml_stage_load(const bf16_t* PROJ, int h, int c, bool do_k, int tid, u32x4 (&rk)[2], u32x4 (&rv)[4]) {
    if (do_k) {
#pragma unroll
        for (int i = 0; i < 2; ++i) { const int idx = tid + 512 * i, s = (idx & 3) + 4 * (idx >> 6), ch = (idx >> 2) & 15; rk[i] = *(const u32x4*)(PROJ + (size_t)(64 * c + s) * ML_N + 1024 + h * 128 + 8 * ch); }
    }
#pragma unroll
    for (int i = 0; i < 4; ++i) { const int i2 = tid + 512 * i, s = (i2 & 3) + 4 * (i2 >> 7), ch = (i2 >> 2) & 31; rv[i] = *(const u32x4*)(PROJ + (size_t)(64 * c + s) * ML_N + 2048 + h * 256 + 8 * ch); }
}
__device__ __forceinline__ void ml_stage_store(LAS bf16_t* kT, LAS bf16_t* vT, const LAS float* wS, bool do_k, int tid, const u32x4 (&rk)[2], const u32x4 (&rv)[4]) {
    if (do_k) {
#pragma unroll
        for (int i = 0; i < 2; ++i) {
            const int idx = tid + 512 * i, s = (idx & 3) + 4 * (idx >> 6), ch = (idx >> 2) & 15, col = (s + 8 * ch) & 63;
            const float w = wS[s] * 0.08838834764831845f;
            const unsigned ww[4] = {rk[i].x, rk[i].y, rk[i].z, rk[i].w};
#pragma unroll
            for (int e = 0; e < 4; ++e) { const unsigned pkd = pk2(bflo(ww[e]) * w, bfhi(ww[e]) * w); kT[(8 * ch + 2 * e) * 72 + col] = (bf16_t)(pkd & 0xffffu); kT[(8 * ch + 2 * e + 1) * 72 + col] = (bf16_t)(pkd >> 16); }
        }
    }
#pragma unroll
    for (int i = 0; i < 4; ++i) {
        const int i2 = tid + 512 * i, s = (i2 & 3) + 4 * (i2 >> 7), ch = (i2 >> 2) & 31, col = (s + 8 * ch) & 63;
        const unsigned ww[4] = {rv[i].x, rv[i].y, rv[i].z, rv[i].w};
#pragma unroll
        for (int e = 0; e < 4; ++e) { vT[(8 * ch + 2 * e) * 72 + col] = (bf16_t)(ww[e] & 0xffffu); vT[(8 * ch + 2 * e + 1) * 72 + col] = (bf16_t)(ww[e] >> 16); }
    }
}
__device__ __forceinline__ void ml_local_phase(int first, int step, const bf16_t* PROJ, const float* bif, bf16_t* CT, float* NT, float* CI, LAS unsigned char* lds, int tid, int wave, int lane) {
    const int fr = lane & 15, fq = lane >> 4;
    LAS bf16_t* kT = (LAS bf16_t*)lds;
    LAS bf16_t* vT = (LAS bf16_t*)(lds + 18432);
    LAS float* wS = (LAS float*)(lds + 18432 + 36864);
    u32x4 rk[2], rv[4]; unsigned short gi = 0, gf = 0;
    if (first < 2048) {
        ml_stage_load(PROJ, first >> 8, first & 255, true, tid, rk, rv);
        if (wave == 0) { const bf16_t* gp = PROJ + (size_t)(64 * (first & 255) + lane) * ML_N + 6144 + (first >> 8); gi = gp[0]; gf = gp[8]; }
    }
    for (int unit = first; unit < 2048; unit += step) {
        const int h = unit >> 8, c = unit & 255;
        if (wave == 0) {
            const float ig = bf2f(gi) + bif[h], lf = log_sigmoid(bf2f(gf) + bif[8 + h]);
            float b = lf;
#pragma unroll
            for (int o = 1; o < 64; o <<= 1) { const float u = __shfl_up(b, o); if (lane >= o) b += u; }
            const float blast = __shfl(b, 63), gs = blast - b + ig, gmax = wave_max(gs);
            wS[lane] = __expf(gs - gmax);
            if (lane == 0) { CI[(h * 256 + c) * 2] = blast; CI[(h * 256 + c) * 2 + 1] = gmax; }
        }
        __syncthreads();
        ml_stage_store(kT, vT, wS, true, tid, rk, rv);
        __syncthreads();
        const int un = unit + step;
        if (un < 2048) {
            ml_stage_load(PROJ, un >> 8, un & 255, true, tid, rk, rv);
            if (wave == 0) { const bf16_t* gp = PROJ + (size_t)(64 * (un & 255) + lane) * ML_N + 6144 + (un >> 8); gi = gp[0]; gf = gp[8]; }
        }
        f32x4 acc[16];
#pragma unroll
        for (int i = 0; i < 16; ++i) acc[i] = (f32x4){0.f, 0.f, 0.f, 0.f};
#pragma unroll
        for (int ks = 0; ks < 2; ++ks) {
            const bf16x8 af = *(LAS bf16x8*)(kT + (16 * wave + fr) * 72 + 8 * ((4 * ks + fq + 2 * wave + (fr >> 3)) & 7));
#pragma unroll
            for (int nt = 0; nt < 16; ++nt) { const bf16x8 bfr = *(LAS bf16x8*)(vT + (16 * nt + fr) * 72 + 8 * ((4 * ks + fq + 2 * nt + (fr >> 3)) & 7)); acc[nt] = MFMA16(af, bfr, acc[nt]); }
        }
        LAS bf16_t* tS = (LAS bf16_t*)(lds + 57344);
#pragma unroll
        for (int nt = 0; nt < 16; ++nt) { u32x2 w; w.x = pk2(acc[nt][0], acc[nt][1]); w.y = pk2(acc[nt][2], acc[nt][3]); *(LAS u32x2*)(tS + (16 * nt + fr) * 136 + 16 * wave + 4 * fq) = w; }
        if (tid < 128) { float s = 0.f; for (int i = 0; i < 64; ++i) s += bf2f(kT[tid * 72 + i]); NT[(size_t)(h * 256 + c) * 128 + tid] = s; }
        __syncthreads();
        {
            bf16_t* ct = CT + ((size_t)(h * 256 + c) * 256) * 128;
#pragma unroll
            for (int i = 0; i < 8; ++i) { const int q = tid + 512 * i, row = q >> 4, c16 = q & 15; *(u32x4*)(ct + (size_t)row * 128 + 8 * c16) = *(LAS u32x4*)(tS + row * 136 + 8 * c16); }
        }
    }
}
__device__ __forceinline__ void ml_scan_unit(int unit, bf16_t* CT, float* NT, const float* CI, float* MC, LAS unsigned char* lds, int tid) {
    const int h = unit >> 5, part = unit & 31;
    LAS float* cdS = (LAS float*)lds; LAS float* eS = cdS + 256; LAS float* blS = eS + 256; LAS float* gmS = blS + 256; LAS float* mS = gmS + 256;
    if (tid < 256) { blS[tid] = CI[(h * 256 + tid) * 2]; gmS[tid] = CI[(h * 256 + tid) * 2 + 1]; }
    __syncthreads();
    {
        float B = 0.f, Gm = 0.f;
        if (tid < 256) { B = blS[tid]; Gm = gmS[tid]; }
        for (int off = 1; off < 256; off <<= 1) {
            if (tid < 256) { cdS[tid] = B; eS[tid] = Gm; }
            __syncthreads();
            if (tid < 256 && tid >= off) { const float B1 = cdS[tid - off], G1 = eS[tid - off]; Gm = fmaxf(G1 + B, Gm); B = B1 + B; }
            __syncthreads();
        }
        if (tid < 256) mS[tid + 1] = fmaxf(NEG + B, Gm);
        if (tid == 0) mS[0] = NEG;
    }
    __syncthreads();
    if (tid < 256) {
        const float m = mS[tid], mn = mS[tid + 1];
        cdS[tid] = __expf(blS[tid] + m - mn); eS[tid] = __expf(gmS[tid] - mn);
        if (part == 0) MC[h * 256 + tid] = m;
    }
    __syncthreads();
    {
        unsigned* p = (unsigned*)(CT + (size_t)h * 256 * 32768) + part * 512 + tid;
        float r0 = 0.f, r1 = 0.f;
        unsigned d[16], dn[16];
#pragma unroll
        for (int i = 0; i < 16; ++i) d[i] = p[(size_t)i * 16384];
        for (int c0 = 0; c0 < 256; c0 += 16) {
            if (c0 + 16 < 256) {
#pragma unroll
                for (int i = 0; i < 16; ++i) dn[i] = p[(size_t)(c0 + 16 + i) * 16384];
            }
#pragma unroll
            for (int i = 0; i < 16; ++i) { p[(size_t)(c0 + i) * 16384] = pk2(r0, r1); const float cd = cdS[c0 + i], e = eS[c0 + i]; r0 = cd * r0 + e * bflo(d[i]); r1 = cd * r1 + e * bfhi(d[i]); }
#pragma unroll
            for (int i = 0; i < 16; ++i) d[i] = dn[i];
        }
    }
    if (part == 0 && tid < 128) {
        float* p = NT + (size_t)h * 256 * 128 + tid; float r = 0.f;
        for (int c0 = 0; c0 < 256; c0 += 16) {
            float d[16];
#pragma unroll
            for (int i = 0; i < 16; ++i) d[i] = p[(c0 + i) * 128];
#pragma unroll
            for (int i = 0; i < 16; ++i) { p[(c0 + i) * 128] = r; r = cdS[c0 + i] * r + eS[c0 + i] * d[i]; }
        }
    }
    __syncthreads();
}
__device__ __forceinline__ void ml_out_unit(int unit, const bf16_t* PROJ, const float* bif, const float* outg, const bf16_t* CT, const float* NT, const float* MC, bf16_t* Y,
                                            LAS unsigned char* lds, int tid, int wave, int lane) {
    const int h = unit >> 8, c = unit & 255, fr = lane & 15, fq = lane >> 4, tt = wave & 3, dvh = wave >> 2;
    LAS bf16_t* vT = (LAS bf16_t*)(lds + 18432);
    LAS float* dS = (LAS float*)(lds + 18432 + 36864);
    LAS float* pmS = dS + 64;
    LAS float* bS = pmS + 64;
    LAS float* nS = bS + 64;
    LAS float* ssS = nS + 128;
    u32x4 rk[2], rv[4];
    ml_stage_load(PROJ, h, c, false, tid, rk, rv);
    if (wave == 0) {
        const bf16_t* gp = PROJ + (size_t)(64 * c + lane) * ML_N + 6144 + h;
        const float ig = bf2f(gp[0]) + bif[h], lf = log_sigmoid(bf2f(gp[8]) + bif[8 + h]);
        float b = lf;
#pragma unroll
        for (int o = 1; o < 64; o <<= 1) { const float u = __shfl_up(b, o); if (lane >= o) b += u; }
        const float d = ig - b; float pm = d;
#pragma unroll
        for (int o = 1; o < 64; o <<= 1) { const float u = __shfl_up(pm, o); if (lane >= o) pm = fmaxf(pm, u); }
        dS[lane] = d; pmS[lane] = pm; bS[lane] = b;
    }
    if (tid >= 64 && tid < 192) nS[tid - 64] = NT[(size_t)(h * 256 + c) * 128 + tid - 64];
    const int trow = 16 * tt + fr;
    const float mc = MC[h * 256 + c];
    bf16x8 qf[4], kfr[4][4], ctf[4][4];
    {
        const bf16_t* qp = PROJ + (size_t)(64 * c + trow) * ML_N + h * 128 + 8 * fq;
#pragma unroll
        for (int ks = 0; ks < 4; ++ks) qf[ks] = *(const bf16x8*)(qp + 32 * ks);
#pragma unroll
        for (int T = 0; T < 4; ++T) {
            const int s_ = 32 * (T >> 1) + 8 * (fr >> 2) + 4 * (T & 1) + (fr & 3);
            const bf16_t* kp = PROJ + (size_t)(64 * c + s_) * ML_N + 1024 + h * 128 + 8 * fq;
#pragma unroll
            for (int ks = 0; ks < 4; ++ks) kfr[T][ks] = *(const bf16x8*)(kp + 32 * ks);
        }
    }
    const bf16_t* ctp = CT + ((size_t)(h * 256 + c) * 256 + 128 * dvh + fr) * 128 + 8 * fq;
#pragma unroll
    for (int dt = 0; dt < 4; ++dt)
#pragma unroll
        for (int ks = 0; ks < 4; ++ks) ctf[dt][ks] = *(const bf16x8*)(ctp + (size_t)(16 * dt) * 128 + 32 * ks);
    ml_stage_store(nullptr, vT, nullptr, false, tid, rk, rv);
    __syncthreads();
    const float Mt = fmaxf(mc, pmS[trow]), bt = bS[trow], dec = __expf(mc - Mt);
    float A[4][4]; float rsum = 0.f;
#pragma unroll
    for (int T = 0; T < 4; ++T) {
        f32x4 a = (f32x4){0.f, 0.f, 0.f, 0.f};
#pragma unroll
        for (int ks = 0; ks < 4; ++ks) a = MFMA16(kfr[T][ks], qf[ks], a);
#pragma unroll
        for (int i = 0; i < 4; ++i) { const int ss = 32 * (T >> 1) + 8 * fq + 4 * (T & 1) + i; const float v = ss <= trow ? __expf(dS[ss] - Mt) * a[i] * 0.08838834764831845f : 0.f; A[T][i] = v; rsum += v; }
    }
    bf16x8 ctg[4][4];
#pragma unroll
    for (int dt = 0; dt < 4; ++dt)
#pragma unroll
        for (int ks = 0; ks < 4; ++ks) ctg[dt][ks] = *(const bf16x8*)(ctp + (size_t)(16 * (dt + 4)) * 128 + 32 * ks);
    rsum = fq_sum(rsum);
    bf16x8 af[2];
#pragma unroll
    for (int u = 0; u < 2; ++u) { u32x4 w; w.x = pk2(A[2 * u][0], A[2 * u][1]); w.y = pk2(A[2 * u][2], A[2 * u][3]); w.z = pk2(A[2 * u + 1][0], A[2 * u + 1][1]); w.w = pk2(A[2 * u + 1][2], A[2 * u + 1][3]); af[u] = __builtin_bit_cast(bf16x8, w); }
    float qn = 0.f;
#pragma unroll
    for (int ks = 0; ks < 4; ++ks) { const u32x4 w = __builtin_bit_cast(u32x4, qf[ks]); const LAS float* np = nS + 32 * ks + 8 * fq;
        qn += bflo(w.x) * np[0] + bfhi(w.x) * np[1] + bflo(w.y) * np[2] + bfhi(w.y) * np[3] + bflo(w.z) * np[4] + bfhi(w.z) * np[5] + bflo(w.w) * np[6] + bfhi(w.w) * np[7]; }
    qn = fq_sum(qn);
    const float den = rsum + dec * qn, dnm = fmaxf(fabsf(den), __expf(-(bt + Mt))), inv = 1.0f / dnm;
    f32x4 acc[8];
    float ssq = 0.f;
#pragma unroll
    for (int dt = 0; dt < 8; ++dt) {
        f32x4 a = (f32x4){0.f, 0.f, 0.f, 0.f};
#pragma unroll
        for (int ks = 0; ks < 4; ++ks) a = MFMA16(dt < 4 ? ctf[dt][ks] : ctg[dt - 4 < 0 ? 0 : dt - 4][ks], qf[ks], a);
        a = a * dec;
#pragma unroll
        for (int u = 0; u < 2; ++u) a = MFMA16(*(LAS bf16x8*)(vT + (128 * dvh + 16 * dt + fr) * 72 + 8 * ((4 * u + fq + 2 * dt + (fr >> 3)) & 7)), af[u], a);
        a = a * inv;
        ssq += (a[0] * a[0] + a[1] * a[1]) + (a[2] * a[2] + a[3] * a[3]);
        acc[dt] = a;
    }
    ssq = fq_sum(ssq);
    if (fq == 0) ssS[wave * 16 + fr] = ssq;
    const size_t trg = (size_t)(64 * c + trow);
    f32x4 ggv[8]; u32x2 owv[8];
#pragma unroll
    for (int dt = 0; dt < 8; ++dt) { const int dv = 128 * dvh + 16 * dt + 4 * fq; ggv[dt] = *(const f32x4*)(outg + h * 256 + dv); owv[dt] = *(const u32x2*)(PROJ + trg * ML_N + 4096 + h * 256 + dv); }
    __syncthreads();
    const float tot = ssS[wave * 16 + fr] + ssS[(wave ^ 4) * 16 + fr];
    const float rs = 1.0f / sqrtf(tot * (1.0f / 256.0f) + EPS);
#pragma unroll
    for (int dt = 0; dt < 8; ++dt) {
        const int dv = 128 * dvh + 16 * dt + 4 * fq;
        const f32x4 gg = ggv[dt];
        const u32x2 ow = owv[dt];
        const float y0 = acc[dt][0] * rs * gg.x * sigmoidf_(bflo(ow.x)), y1 = acc[dt][1] * rs * gg.y * sigmoidf_(bfhi(ow.x));
        const float y2 = acc[dt][2] * rs * gg.z * sigmoidf_(bflo(ow.y)), y3 = acc[dt][3] * rs * gg.w * sigmoidf_(bfhi(ow.y));
        u32x2 w; w.x = pk2(y0, y1); w.y = pk2(y2, y3);
        *(u32x2*)(Y + trg * D_ + h * 256 + dv) = w;
    }
}

#define GAS __attribute__((address_space(1)))
#define XB_TMO      128
#define XB_XCNT(j)  (256  + 64 * (j))
#define XB_XSUB(j)  (1280 + 64 * (j))
#define XB_XGEN(j)  (2304 + 64 * (j))
#define XB_TOP      3328
#define XB_TOPGEN   3392
#define XCD_BAR_WORDS 3456
#define XB_SPIN_CAP (1u << 18)

__device__ __forceinline__ unsigned xb_ld(unsigned* p)              { return __hip_atomic_load(p, __ATOMIC_RELAXED, __HIP_MEMORY_SCOPE_AGENT); }
__device__ __forceinline__ unsigned xb_add(unsigned* p, unsigned v) { return __hip_atomic_fetch_add(p, v, __ATOMIC_RELAXED, __HIP_MEMORY_SCOPE_AGENT); }
__device__ __forceinline__ unsigned xb_xcc_id() { return (unsigned)__builtin_amdgcn_s_getreg((3 << 11) | 20) & 0xFu; }
#define XB_SPIN(cond, bar) do { unsigned _sp = 0; while (cond) { __builtin_amdgcn_s_sleep(1); \
    if ((++_sp & 255u) == 0u) { if (xb_ld(&(bar)[XB_TMO])) break; if (_sp > XB_SPIN_CAP) { atomicAdd(&(bar)[XB_TMO], 1u); break; } } } } while (0)

struct XcdBarrier {
    unsigned* bar; unsigned x;
    volatile LAS unsigned* st;
};

__device__ __forceinline__ XcdBarrier xcd_barrier_post(unsigned* bar, volatile LAS unsigned* st) {
    XcdBarrier b; b.bar = bar; b.x = xb_xcc_id(); b.st = st;
    if (threadIdx.x == 0) (void)xb_add(&bar[XB_XCNT(b.x)], 1u);
    return b;
}
__device__ __forceinline__ void xcd_barrier_complete(unsigned* bar, unsigned x, unsigned& nloc, unsigned& nx) {
    const unsigned G = gridDim.x * gridDim.y * gridDim.z;
    unsigned sum, cnt, mine, sp = 0u;
    for (;;) {
        sum = 0u; cnt = 0u; mine = 0u;
#pragma unroll
        for (unsigned j = 0; j < 16; ++j) { const unsigned c = xb_ld(&bar[XB_XCNT(j)]); sum += c; cnt += (c > 0u) ? 1u : 0u; mine = (j == x) ? c : mine; }
        if (sum == G) break;
        __builtin_amdgcn_s_sleep(1);
        if ((++sp & 255u) == 0u) { if (xb_ld(&bar[XB_TMO])) break; if (sp > XB_SPIN_CAP) { atomicAdd(&bar[XB_TMO], 1u); break; } }
    }
    nloc = mine > 0u ? mine : 1u; nx = cnt > 0u ? cnt : 1u;
}

__device__ __forceinline__ void xcd_barrier(const XcdBarrier& b) {
    asm volatile("s_waitcnt vmcnt(0)" ::: "memory");
    __syncthreads();
    if (threadIdx.x == 0) {
        unsigned* bar = b.bar;
        __builtin_amdgcn_s_waitcnt(0);
        unsigned nloc = b.st[0], nx = b.st[1];
        if (nloc == 0u) { xcd_barrier_complete(bar, b.x, nloc, nx); b.st[0] = nloc; b.st[1] = nx; }
        const unsigned old = xb_add(&bar[XB_XSUB(b.x)], 1u);
        const unsigned gen = old / nloc;
        if (old + 1u == (gen + 1u) * nloc) {
            __builtin_amdgcn_fence(__ATOMIC_RELEASE, "agent");
            asm volatile("s_waitcnt vmcnt(0)" ::: "memory");
            const unsigned og = xb_add(&bar[XB_TOP], 1u);
            const unsigned tg = og / nx;
            if (og + 1u == (tg + 1u) * nx) xb_add(&bar[XB_TOPGEN], 1u);
            else XB_SPIN(xb_ld(&bar[XB_TOPGEN]) == tg, bar);
            __builtin_amdgcn_fence(__ATOMIC_ACQUIRE, "agent");
            xb_add(&bar[XB_XGEN(b.x)], 1u);
            asm volatile("s_waitcnt vmcnt(0)" ::: "memory");
        } else {
            XB_SPIN(xb_ld(&bar[XB_XGEN(b.x)]) == gen, bar);
            __builtin_amdgcn_fence(__ATOMIC_ACQUIRE, "agent");
            asm volatile("s_waitcnt vmcnt(0)" ::: "memory");
        }
    }
    __syncthreads();
}

#ifndef REP_UP
#define REP_UP 1
#endif
#ifndef REP_P0
#define REP_P0 1
#endif
#ifndef REP_CMP
#define REP_CMP 1
#endif
#ifndef REP_ATTN
#define REP_ATTN 1
#endif
#ifndef REP_MLL
#define REP_MLL 1
#endif
#ifndef REP_MLO
#define REP_MLO 1
#endif
__global__ void __launch_bounds__(NTHR, 2) fwd_kernel(Args args) {
    extern __shared__ __attribute__((aligned(16))) unsigned char lds_raw[];
    LAS unsigned char* lds = (LAS unsigned char*)lds_raw;
    cg::grid_group grid = cg::this_grid();
    volatile LAS unsigned* bar_st = (volatile LAS unsigned*)(lds + LDS_BYTES - 64);
    if (threadIdx.x == 0) { bar_st[0] = 0u; bar_st[1] = 0u; }
    __syncthreads();
    XcdBarrier xbar; xbar.bar = (unsigned*)(args.ws + WS_MISC); xbar.x = 0; xbar.st = nullptr;
    if (args.ph_hi - args.ph_lo > 1) xbar = xcd_barrier_post((unsigned*)(args.ws + WS_MISC), bar_st);
    const int wave0 = __builtin_amdgcn_readfirstlane((int)(threadIdx.x >> 6));
    const int G0 = gridDim.x, bid0 = blockIdx.x;
    const int lo = args.ph_lo, hi = args.ph_hi;
#define X (args.out)
#define XN ((bf16_t*)(ws + WS_XN))
#define XBS ((bf16_t*)(ws + WS_XB))
#define Yb ((bf16_t*)(ws + WS_XN))
#define PROJ ((bf16_t*)(ws + WS_PROJ))
#define Hb ((bf16_t*)(ws + WS_PROJ))
#define nb (ws + WS_NSAW + j * NSAW_STRIDE)
#define mb (ws + WS_MLW + j * MLW_STRIDE)
#define KS ((bf16_t*)(ws + WS_EXT + EXT_KS))
#define KW ((bf16_t*)(ws + WS_EXT + EXT_KW))
#define VTS ((bf16_t*)(ws + WS_EXT + EXT_VTS))
#define VTW ((bf16_t*)(ws + WS_EXT + EXT_VTW))
#define KC ((bf16_t*)(ws + WS_EXT + EXT_KC))
#define VTC ((bf16_t*)(ws + WS_EXT + EXT_VTC))
#define CT ((bf16_t*)(ws + WS_EXT + EXT_CT))
#define NT ((float*)(ws + WS_EXT + EXT_NT))
#define CI ((float*)(ws + WS_EXT + EXT_CI))
#define MC ((float*)(ws + WS_EXT + EXT_MC))
#define bif (args.in[13] + j * 16)
    int ph = 0;
#define PHASE_BEGIN if (lo <= ph && ph < hi) { int bid = bid0, G = G0; asm volatile("" : "+s"(bid), "+s"(G)); const int NGW = G * NWAVES; int tid = wave0 * 64 + (int)__builtin_amdgcn_mbcnt_hi(~0u, __builtin_amdgcn_mbcnt_lo(~0u, 0u)); asm volatile("" : "+v"(tid)); const int lane = tid & 63; const int wave = __builtin_amdgcn_readfirstlane(tid >> 6); const int gw = bid * NWAVES + wave; unsigned char* ws = args.ws; asm volatile("" : "+s"(ws));
#define PHASE_END if (ph + 1 < hi) { if (hi == 0x7fffffff) grid.sync(); else xcd_barrier(xbar); } } ++ph;

    PHASE_BEGIN
    {
        LAS float* scr = (LAS float*)(lds + wave * 17408);
        for (int rep_ = 0; rep_ < REP_P0; ++rep_) {
        int rot = 0;
#pragma unroll 1
        for (int l = 0; l < 4; ++l) {
            bf16_t* wgu = (bf16_t*)(ws + WS_FFN + l * FFN_STRIDE); bf16_t* wd = (bf16_t*)(ws + WS_FFN + l * FFN_STRIDE + FFN_WD);
            tr_matrix(args.in[16] + (size_t)l * D_ * DFF, D_, DFF, wgu, 1, 0, scr, gw, NGW, lane, rot);
            tr_matrix(args.in[17] + (size_t)l * D_ * DFF, D_, DFF, wgu, 1, 128, scr, gw, NGW, lane, rot);
            tr_matrix(args.in[18] + (size_t)l * DFF * D_, DFF, D_, wd, 0, 0, scr, gw, NGW, lane, rot);
        }
#pragma unroll 1
        for (int j = 0; j < 2; ++j) {
            tr_matrix(args.in[3] + (size_t)j * D_ * NSA_IN, D_, NSA_IN, (bf16_t*)nb, 0, 0, scr, gw, NGW, lane, rot);
            tr_matrix(args.in[11] + (size_t)j * D_ * D_, D_, D_, (bf16_t*)(nb + NSAW_OUT), 0, 0, scr, gw, NGW, lane, rot);
            tr_matrix(args.in[8] + (size_t)(j * 2 + 0) * 4096 * 128, 4096, 128, (bf16_t*)(nb + NSAW_W1), 0, 0, scr, gw, NGW, lane, rot);
            tr_matrix(args.in[8] + (size_t)(j * 2 + 1) * 4096 * 128, 4096, 128, (bf16_t*)(nb + NSAW_W1) + 128 * 4096, 0, 0, scr, gw, NGW, lane, rot);
            tr_matrix(args.in[10] + (size_t)(j * 2 + 0) * 128 * 128, 128, 128, (bf16_t*)(nb + NSAW_W2), 0, 0, scr, gw, NGW, lane, rot);
            tr_matrix(args.in[10] + (size_t)(j * 2 + 1) * 128 * 128, 128, 128, (bf16_t*)(nb + NSAW_W2) + 128 * 128, 0, 0, scr, gw, NGW, lane, rot);
            tr_matrix(args.in[12] + (size_t)j * D_ * ML_IN, D_, ML_IN, (bf16_t*)mb, 0, 0, scr, gw, NGW, lane, rot);
            tr_matrix(args.in[15] + (size_t)j * D_ * D_, D_, D_, (bf16_t*)(mb + MLW_OUT), 0, 0, scr, gw, NGW, lane, rot);
        }
        }
        rmsnorm_phase(args.in[0], args.in[1], XN, nullptr, gw, NGW, lane);
    }
    PHASE_END

#pragma unroll 1
    for (int i = 0; i < 4; ++i) {
        const int j = i >> 1;
        if (i > 0) {
            PHASE_BEGIN
            rmsnorm_bf16_phase(XBS, args.in[1] + i * D_, XN, gw, NGW, lane);
            PHASE_END
        }
        if ((i & 1) == 0) {
            PHASE_BEGIN
            for (int tb = bid; tb < 256; tb += G) gate_gemm<3>(XN, (const bf16_t*)nb + (size_t)5120 * D_, PROJ, NSA_N, 5120, tb, lds, tid, wave, lane);
            { pg8::Gemm g{XN, (const bf16_t*)nb, S_, 5120, D_}; pg8::StaticOrder So; So.init(S_, 5120, G, bid); pg8::EpiStore E{PROJ, NSA_N};
              pg8::gemm_phase<pg8::EpiStore, pg8::StaticOrder, true, true>(lds, g, So, E, tid); }
            PHASE_END
            PHASE_BEGIN
            for (int tb = bid; tb < 256; tb += G) nsa_prep_unit(tb, PROJ, args.in[5] + j * 128, args.in[6] + j * 384, KS, KW, VTS, VTW, tid);
            for (int rep_ = 0; rep_ < REP_CMP; ++rep_)
            for (int task = bid; task < 256; task += G)
                nsa_compress_unit(task, PROJ, args.in[7] + (size_t)j * 2 * 32 * 128, (const bf16_t*)(nb + NSAW_W1), args.in[9] + j * 256, (const bf16_t*)(nb + NSAW_W2), args.in[6] + j * 384, KC, VTC, lds, tid, wave, lane);
            PHASE_END
            PHASE_BEGIN
            for (int rep_ = 0; rep_ < REP_ATTN; ++rep_)
            for (int task = bid; task < 1024; task += G) {
                const int k = task >> 8, bb = task & 255, xg = bb & 3, half = (bb >> 2) & 1, wi = bb >> 3;
                const int qb = half == 0 ? (k == 0 ? wi : k == 1 ? 127 - wi : k == 2 ? 128 + wi : 255 - wi) : (k == 0 ? 32 + wi : k == 1 ? 95 - wi : k == 2 ? 160 + wi : 223 - wi);
                nsa_attn_wg(qb, xg, PROJ, args.in[4] + j * 48, KC, VTC, KS, VTS, KW, VTW, Yb, lds, tid, wave, lane);
            }
            PHASE_END
            PHASE_BEGIN
            { pg8::Gemm g{Yb, (const bf16_t*)(nb + NSAW_OUT), S_, D_, D_}; pg8::StaticOrder So; So.init(S_, D_, G, bid); pg8::EpiResid E{i == 0 ? args.in[0] : (const float*)nullptr, XBS, nullptr, D_};
              pg8::gemm_phase<pg8::EpiResid, pg8::StaticOrder, true, true>(lds, g, So, E, tid); }
            PHASE_END
        } else {
            PHASE_BEGIN
            for (int tb = bid; tb < 256; tb += G) gate_gemm<1>(XN, (const bf16_t*)mb + (size_t)6144 * D_, PROJ, ML_N, 6144, tb, lds, tid, wave, lane);
            { pg8::Gemm g{XN, (const bf16_t*)mb, S_, 6144, D_}; pg8::StaticOrder So; So.init(S_, 6144, G, bid); pg8::EpiStore E{PROJ, ML_N};
              pg8::gemm_phase<pg8::EpiStore, pg8::StaticOrder, true, true>(lds, g, So, E, tid); }
            PHASE_END
            PHASE_BEGIN
            ml_local_phase(bid, G, PROJ, bif, CT, NT, CI, lds, tid, wave, lane);
            PHASE_END
            PHASE_BEGIN
            for (int u = bid; u < 256; u += G) ml_scan_unit(u, CT, NT, CI, MC, lds, tid);
            PHASE_END
            PHASE_BEGIN
            for (int rep_ = 0; rep_ < REP_MLO; ++rep_)
            for (int u = bid; u < 2048; u += G) ml_out_unit(u, PROJ, bif, args.in[14] + j * D_, CT, NT, MC, Yb, lds, tid, wave, lane);
            PHASE_END
            PHASE_BEGIN
            { pg8::Gemm g{Yb, (const bf16_t*)(mb + MLW_OUT), S_, D_, D_}; pg8::StaticOrder So; So.init(S_, D_, G, bid); pg8::EpiResid E{nullptr, XBS, nullptr, D_};
              pg8::gemm_phase<pg8::EpiResid, pg8::StaticOrder, true, true>(lds, g, So, E, tid); }
            PHASE_END
        }
        PHASE_BEGIN
        rmsnorm_bf16_phase(XBS, args.in[2] + i * D_, XN, gw, NGW, lane);
        PHASE_END
        PHASE_BEGIN
        for (int rep_ = 0; rep_ < REP_UP; ++rep_)
        { pg8::Gemm g{XN, (const bf16_t*)(ws + WS_FFN + i * FFN_STRIDE), S_, 2 * DFF, D_}; pg8::StaticOrder So; So.init(S_, 2 * DFF, G, bid); pg8::EpiSwiglu E{Hb, DFF};
          pg8::gemm_phase<pg8::EpiSwiglu, pg8::StaticOrder, true, true>(lds, g, So, E, tid); }
        PHASE_END
        PHASE_BEGIN
        { pg8::Gemm g{Hb, (const bf16_t*)(ws + WS_FFN + i * FFN_STRIDE + FFN_WD), S_, D_, DFF}; pg8::StaticOrder So; So.init(S_, D_, G, bid); pg8::EpiResid E{nullptr, XBS, i == 3 ? X : (float*)nullptr, D_};
          pg8::gemm_phase<pg8::EpiResid, pg8::StaticOrder, true, true>(lds, g, So, E, tid); }
        PHASE_END
    }
}

#ifndef ONE_LAUNCH
#define ONE_LAUNCH 0
#endif
extern "C" void kernel_launch(void* const* d_in, const int* in_sizes, int n_in, void* d_out, int out_size, void* d_ws, size_t ws_size, hipStream_t stream) {
    static int grid = 0;
    if (grid == 0) {
        if (n_in != 19 || out_size != S_ * D_ || ws_size < WS_END) { fprintf(stderr, "kernel_launch: unexpected shapes n_in %d out %d ws %zu\n", n_in, out_size, ws_size); grid = -1; return; }
        int dev = 0, cus = 0, per_cu = 0;
        hipGetDevice(&dev); hipDeviceGetAttribute(&cus, hipDeviceAttributeMultiprocessorCount, dev);
        if (hipFuncSetAttribute((const void*)fwd_kernel, hipFuncAttributeMaxDynamicSharedMemorySize, LDS_BYTES) != hipSuccess) { fprintf(stderr, "kernel_launch: hipFuncSetAttribute failed\n"); grid = -1; return; }
        if (hipOccupancyMaxActiveBlocksPerMultiprocessor(&per_cu, (const void*)fwd_kernel, NTHR, LDS_BYTES) != hipSuccess || per_cu < 1) { fprintf(stderr, "kernel_launch: occupancy query says %d\n", per_cu); per_cu = 1; }
        (void)hipGetLastError();
        grid = cus;
        if (grid != 256) fprintf(stderr, "kernel_launch: %d CUs\n", grid);
    }
    if (grid < 0) return;
    Args a{};
    for (int i = 0; i < 19; ++i) a.in[i] = (const float*)d_in[i];
    a.out = (float*)d_out; a.ws = (unsigned char*)d_ws;
#if ONE_LAUNCH
    if (hipMemsetAsync((char*)d_ws + WS_MISC, 0, 16384, stream) != hipSuccess) { fprintf(stderr, "kernel_launch: memset failed\n"); return; }
    a.ph_lo = 0; a.ph_hi = NPH;
    void* kargs[] = {&a};
    hipError_t e = hipLaunchCooperativeKernel((const void*)fwd_kernel, dim3(grid), dim3(NTHR), kargs, LDS_BYTES, stream);
    if (e != hipSuccess) fprintf(stderr, "cooperative launch failed: %s (grid %d)\n", hipGetErrorString(e), grid);
#else
    for (int p = 0; p < NPH; ++p) {
        a.ph_lo = p; a.ph_hi = p + 1;
        hipLaunchKernelGGL(fwd_kernel, dim3(grid), dim3(NTHR), LDS_BYTES, stream, a);
    }
#endif
}
```
